# Optimizing an MI355X kernel written in HIP

```python
import jax, jax.numpy as jnp
from jax import lax
import numpy as np

D_MODEL = 2048
BATCH = 2
SEQ = 8192
DEPTH = 2

GRID_W = 64
Q_BLOCK = 128
NORM_EPS = 1e-6
ROPE_THETA = 500000.0
AXIAL_THETA = 10000.0
MLA_HEADS = 8
MLA_Q_LORA = 512
MLA_KV_LORA = 256
MLA_NOPE_DIM = 128
MLA_ROPE_DIM = 64
MLA_QK_DIM = MLA_NOPE_DIM + MLA_ROPE_DIM
MLA_V_DIM = 128
GQA_HEADS = 8
GQA_KV_HEADS = 2
GQA_HEAD_DIM = 128
SWA_HEADS = 32
SWA_KV_HEADS = 4
SWA_HEAD_DIM = 64
SWA_WINDOW = 128
SWA_ROT_DIM = SWA_HEAD_DIM // 4
D_FF = 4 * D_MODEL
EVEN_IN = MLA_Q_LORA + MLA_KV_LORA + MLA_ROPE_DIM + (GQA_HEADS + 2 * GQA_KV_HEADS) * GQA_HEAD_DIM
EVEN_OUT = MLA_HEADS * MLA_V_DIM + GQA_HEADS * GQA_HEAD_DIM
ODD_IN = (SWA_HEADS + 2 * SWA_KV_HEADS) * SWA_HEAD_DIM
ODD_OUT = SWA_HEADS * SWA_HEAD_DIM
N_EVEN = (DEPTH + 1) // 2
N_ODD = DEPTH // 2

kernel_name = 'hybrid_mla_gridgqa_swa_sqrelu_encoder'


def rms_norm(x, gain):
    xf = x.astype(jnp.float32)
    y = xf * lax.rsqrt(jnp.mean(xf * xf, axis=-1, keepdims=True) + NORM_EPS)
    return (y * gain.astype(jnp.float32)).astype(x.dtype)


def rope_table(pos, dim, theta):
    inv = jnp.float32(theta) ** (-jnp.arange(0, dim, 2, dtype=jnp.float32) / dim)
    ang = pos.astype(jnp.float32)[:, None] * inv[None, :]
    return jnp.cos(ang), jnp.sin(ang)


def apply_rope(x, cos, sin):
    half = x.shape[-1] // 2
    c = cos[None, :, None, :].astype(x.dtype)
    s = sin[None, :, None, :].astype(x.dtype)
    x1 = x[..., :half]
    x2 = x[..., half:]
    return jnp.concatenate([x1 * c - x2 * s, x2 * c + x1 * s], axis=-1)


def dense_block_attention(q, k, v, scale):
    B, S, Hq, dk = q.shape
    Hkv = k.shape[2]
    G = Hq // Hkv
    dv = v.shape[-1]
    nb = S // Q_BLOCK
    qb = jnp.swapaxes(q.reshape(B, nb, Q_BLOCK, Hkv, G, dk), 0, 1)

    def one_block(qblk):
        s = jnp.einsum('bqhgd,bkhd->bhgqk', qblk, k, preferred_element_type=jnp.float32) * scale
        p = jax.nn.softmax(s, axis=-1).astype(v.dtype)
        return jnp.einsum('bhgqk,bkhd->bqhgd', p, v)

    o = lax.map(one_block, qb)
    return jnp.swapaxes(o, 0, 1).reshape(B, S, Hq, dv)


def banded_window_attention(q, k, v, sink, scale):
    B, S, Hq, d = q.shape
    Hkv = k.shape[2]
    G = Hq // Hkv
    nb = S // Q_BLOCK
    span = Q_BLOCK + 2 * SWA_WINDOW
    pad = ((0, 0), (SWA_WINDOW, SWA_WINDOW), (0, 0), (0, 0))
    kp = jnp.pad(k, pad)
    vp = jnp.pad(v, pad)
    qb = jnp.swapaxes(q.reshape(B, nb, Q_BLOCK, Hkv, G, d), 0, 1)
    sink_b = sink.astype(jnp.float32).reshape(1, Hkv, G, 1, 1)
    offs_q = jnp.arange(Q_BLOCK)
    offs_k = jnp.arange(span) - SWA_WINDOW

    def one_block(args):
        i, qblk = args
        start = i * Q_BLOCK
        kblk = lax.dynamic_slice_in_dim(kp, start, span, axis=1)
        vblk = lax.dynamic_slice_in_dim(vp, start, span, axis=1)
        q_pos = start + offs_q
        k_pos = start + offs_k
        valid = (jnp.abs(q_pos[:, None] - k_pos[None, :]) <= SWA_WINDOW) & ((k_pos >= 0) & (k_pos < S))[None, :]
        s = jnp.einsum('bqhgd,bkhd->bhgqk', qblk, kblk, preferred_element_type=jnp.float32) * scale
        s = jnp.where(valid, s, -jnp.inf)
        m = jnp.maximum(jnp.max(s, axis=-1, keepdims=True), sink_b)
        p = jnp.exp(s - m)
        denom = jnp.sum(p, axis=-1, keepdims=True) + jnp.exp(sink_b - m)
        p = (p / denom).astype(v.dtype)
        return jnp.einsum('bhgqk,bkhd->bqhgd', p, vblk)

    o = lax.map(one_block, (jnp.arange(nb), qb))
    return jnp.swapaxes(o, 0, 1).reshape(B, S, Hq, d)


def even_mixer(h, w_in, q_lat_norm, kv_lat_norm, w_uq, w_ukv, q_norm, k_nope_norm, k_rope_norm,
               g_q_norm, g_k_norm, w_out, mla_cos, mla_sin, row_cos, row_sin, col_cos, col_sin):
    B, S, _ = h.shape
    proj = h @ w_in
    o1 = MLA_Q_LORA
    o2 = o1 + MLA_KV_LORA
    o3 = o2 + MLA_ROPE_DIM
    o4 = o3 + GQA_HEADS * GQA_HEAD_DIM
    o5 = o4 + GQA_KV_HEADS * GQA_HEAD_DIM
    c_q = proj[..., :o1]
    c_kv = proj[..., o1:o2]
    k_rope = proj[..., o2:o3]
    q_g = proj[..., o3:o4].reshape(B, S, GQA_HEADS, GQA_HEAD_DIM)
    k_g = proj[..., o4:o5].reshape(B, S, GQA_KV_HEADS, GQA_HEAD_DIM)
    v_g = proj[..., o5:].reshape(B, S, GQA_KV_HEADS, GQA_HEAD_DIM)

    q_a = (rms_norm(c_q, q_lat_norm) @ w_uq).reshape(B, S, MLA_HEADS, MLA_QK_DIM)
    q_a = rms_norm(q_a, q_norm)
    q_a = jnp.concatenate([q_a[..., :MLA_NOPE_DIM], apply_rope(q_a[..., MLA_NOPE_DIM:], mla_cos, mla_sin)], axis=-1)
    kv = (rms_norm(c_kv, kv_lat_norm) @ w_ukv).reshape(B, S, MLA_HEADS, MLA_NOPE_DIM + MLA_V_DIM)
    k_nope = rms_norm(kv[..., :MLA_NOPE_DIM], k_nope_norm)
    v_a = kv[..., MLA_NOPE_DIM:]
    k_r = apply_rope(rms_norm(k_rope, k_rope_norm)[:, :, None, :], mla_cos, mla_sin)
    k_a = jnp.concatenate([k_nope, jnp.broadcast_to(k_r, (B, S, MLA_HEADS, MLA_ROPE_DIM))], axis=-1)
    o_a = dense_block_attention(q_a, k_a, v_a, MLA_QK_DIM ** -0.5)

    half = GQA_HEAD_DIM // 2
    def axial(t):
        return jnp.concatenate([apply_rope(t[..., :half], row_cos, row_sin), apply_rope(t[..., half:], col_cos, col_sin)], axis=-1)
    q_g = axial(rms_norm(q_g, g_q_norm))
    k_g = axial(rms_norm(k_g, g_k_norm))
    o_g = dense_block_attention(q_g, k_g, v_g, GQA_HEAD_DIM ** -0.5)

    merged = jnp.concatenate([o_a.reshape(B, S, -1), o_g.reshape(B, S, -1)], axis=-1)
    return merged @ w_out


def odd_mixer(h, w_qkv, q_norm, k_norm, sink, w_out, swa_cos, swa_sin):
    B, S, _ = h.shape
    qkv = h @ w_qkv
    nq = SWA_HEADS * SWA_HEAD_DIM
    nk = SWA_KV_HEADS * SWA_HEAD_DIM
    q = rms_norm(qkv[..., :nq].reshape(B, S, SWA_HEADS, SWA_HEAD_DIM), q_norm)
    k = rms_norm(qkv[..., nq:nq + nk].reshape(B, S, SWA_KV_HEADS, SWA_HEAD_DIM), k_norm)
    v = qkv[..., nq + nk:].reshape(B, S, SWA_KV_HEADS, SWA_HEAD_DIM)
    q = jnp.concatenate([apply_rope(q[..., :SWA_ROT_DIM], swa_cos, swa_sin), q[..., SWA_ROT_DIM:]], axis=-1)
    k = jnp.concatenate([apply_rope(k[..., :SWA_ROT_DIM], swa_cos, swa_sin), k[..., SWA_ROT_DIM:]], axis=-1)
    o = banded_window_attention(q, k, v, sink, SWA_HEAD_DIM ** -0.5)
    return o.reshape(B, S, -1) @ w_out


def squared_relu_mlp(x, gain, w_up, w_down):
    h = rms_norm(x, gain) @ w_up
    return jnp.square(jax.nn.relu(h)) @ w_down


def _dense(k, shape):
    return jax.random.normal(k, shape, jnp.float32) * (shape[-2] ** -0.5)


def _gain(k, shape):
    return 1.0 + 0.02 * jax.random.normal(k, shape, jnp.float32)


def setup_inputs(seed: int = 0) -> dict:
    key = jax.random.key(seed)
    ks = jax.random.split(key, 22)
    return {
        'x': jax.random.normal(ks[0], (BATCH, SEQ, D_MODEL), jnp.float32),
        'even_norm': _gain(ks[1], (N_EVEN, D_MODEL)),
        'even_w_in': _dense(ks[2], (N_EVEN, D_MODEL, EVEN_IN)),
        'mla_q_lat_norm': _gain(ks[3], (N_EVEN, MLA_Q_LORA)),
        'mla_kv_lat_norm': _gain(ks[4], (N_EVEN, MLA_KV_LORA)),
        'mla_w_uq': _dense(ks[5], (N_EVEN, MLA_Q_LORA, MLA_HEADS * MLA_QK_DIM)),
        'mla_w_ukv': _dense(ks[6], (N_EVEN, MLA_KV_LORA, MLA_HEADS * (MLA_NOPE_DIM + MLA_V_DIM))),
        'mla_q_norm': _gain(ks[7], (N_EVEN, MLA_QK_DIM)),
        'mla_k_nope_norm': _gain(ks[8], (N_EVEN, MLA_NOPE_DIM)),
        'mla_k_rope_norm': _gain(ks[9], (N_EVEN, MLA_ROPE_DIM)),
        'gqa_q_norm': _gain(ks[10], (N_EVEN, GQA_HEAD_DIM)),
        'gqa_k_norm': _gain(ks[11], (N_EVEN, GQA_HEAD_DIM)),
        'even_w_out': _dense(ks[12], (N_EVEN, EVEN_OUT, D_MODEL)),
        'odd_norm': _gain(ks[13], (N_ODD, D_MODEL)),
        'odd_w_qkv': _dense(ks[14], (N_ODD, D_MODEL, ODD_IN)),
        'swa_q_norm': _gain(ks[15], (N_ODD, SWA_HEAD_DIM)),
        'swa_k_norm': _gain(ks[16], (N_ODD, SWA_HEAD_DIM)),
        'swa_sink': jax.random.normal(ks[17], (N_ODD, SWA_HEADS), jnp.float32),
        'odd_w_out': _dense(ks[18], (N_ODD, ODD_OUT, D_MODEL)),
        'mlp_norm': _gain(ks[19], (DEPTH, D_MODEL)),
        'mlp_w_up': _dense(ks[20], (DEPTH, D_MODEL, D_FF)),
        'mlp_w_down': _dense(ks[21], (DEPTH, D_FF, D_MODEL)),
    }


def reference(x, even_norm, even_w_in, mla_q_lat_norm, mla_kv_lat_norm, mla_w_uq, mla_w_ukv,
              mla_q_norm, mla_k_nope_norm, mla_k_rope_norm, gqa_q_norm, gqa_k_norm, even_w_out,
              odd_norm, odd_w_qkv, swa_q_norm, swa_k_norm, swa_sink, odd_w_out,
              mlp_norm, mlp_w_up, mlp_w_down):
    B, S, _ = x.shape
    rows = S // GRID_W
    pos = jnp.arange(S)
    row_pos = jnp.repeat(jnp.arange(rows), GRID_W)
    col_pos = jnp.tile(jnp.arange(GRID_W), rows)
    mla_cos, mla_sin = rope_table(pos, MLA_ROPE_DIM, ROPE_THETA)
    row_cos, row_sin = rope_table(row_pos, GQA_HEAD_DIM // 2, AXIAL_THETA)
    col_cos, col_sin = rope_table(col_pos, GQA_HEAD_DIM // 2, AXIAL_THETA)
    swa_cos, swa_sin = rope_table(pos, SWA_ROT_DIM, ROPE_THETA)
    for layer in range(DEPTH):
        i = layer // 2
        if layer % 2 == 0:
            x = x + even_mixer(rms_norm(x, even_norm[i]), even_w_in[i], mla_q_lat_norm[i], mla_kv_lat_norm[i],
                               mla_w_uq[i], mla_w_ukv[i], mla_q_norm[i], mla_k_nope_norm[i], mla_k_rope_norm[i],
                               gqa_q_norm[i], gqa_k_norm[i], even_w_out[i],
                               mla_cos, mla_sin, row_cos, row_sin, col_cos, col_sin)
        else:
            x = x + odd_mixer(rms_norm(x, odd_norm[i]), odd_w_qkv[i], swa_q_norm[i], swa_k_norm[i],
                              swa_sink[i], odd_w_out[i], swa_cos, swa_sin)
        x = x + squared_relu_mlp(x, mlp_norm[layer], mlp_w_up[layer], mlp_w_down[layer])
    return x
```

```cpp
#include <hip/hip_runtime.h>
#include <hip/hip_cooperative_groups.h>
#include <cstdio>
#include <cstdint>
#include <cmath>
#include <cstring>
namespace cg = cooperative_groups;

namespace pg8 {
#define PG8_LAS __attribute__((address_space(3)))
typedef unsigned short bf16_t;
typedef short bf16x8 __attribute__((ext_vector_type(8)));
typedef float f32x4 __attribute__((ext_vector_type(4)));
typedef unsigned u32x4 __attribute__((ext_vector_type(4)));
constexpr int BM = 256, BK = 64, HALF = 128, HTB = HALF * BK * 2  , STAGE_BYTES = 8 * HTB, NXCD = 8, WGM = 8;

__host__ __device__ __forceinline__ int lds_byte(int r, int c) { const int st = (r >> 4) * 2 + (c >> 5), rr = r & 15, cc = c & 31, ob = rr * 64 + cc * 2; return st * 1024 + (ob ^ (((ob >> 9) & 1) << 5)); }
__host__ __device__ __forceinline__ void stage_rc(int b, int& R, int& C) { const int st = b / 1024, sb = b % 1024, swz = sb ^ (((sb >> 9) & 1) << 5); R = (st >> 1) * 16 + swz / 64; C = (st & 1) * 32 + (swz % 64) / 2; }
__host__ __device__ __forceinline__ int perm32(int rho) { const int n = rho >> 4, i = rho & 15; return 8 * (i >> 2) + 4 * n + (i & 3); }

struct Unit { int pm, pn; };
struct Gemm { const bf16_t* A; const bf16_t* Bt; int M, N, K; };

struct StaticOrder {
    int nM, nN, nwg, G, c;
    __host__ __device__ void init(int M, int N, int G_, int c_) { nM = M / BM; nN = N / BM; nwg = nM * nN; G = G_; c = c_; }
    __host__ __device__ bool next(int i, Unit& u) const {
        const long L = (long)i * G + c; if (L >= nwg) return false;
        int wgid = (int)L; { const int q = nwg / NXCD, r = nwg % NXCD, xcd = wgid % NXCD, off = wgid / NXCD; wgid = (xcd < r ? xcd * (q + 1) : r * (q + 1) + (xcd - r) * q) + off; }
        const int nig = WGM * nN, gid = wgid / nig, fm = gid * WGM, gsz = (nM - fm) < WGM ? (nM - fm) : WGM;
        u.pm = fm + ((wgid % nig) % gsz); u.pn = (wgid % nig) / gsz; return true;
    }
    __device__ __forceinline__ void a_ready(const Unit&) const {}
    __device__ __forceinline__ void done(const Unit&) const {}
};

__device__ __forceinline__ unsigned cvt_pk_bf16(float lo, float hi) { unsigned r; asm volatile("v_cvt_pk_bf16_f32 %0, %1, %2" : "=v"(r) : "v"(lo), "v"(hi)); return r; }
typedef float f32x2 __attribute__((ext_vector_type(2)));
__device__ __forceinline__ f32x2 gelu_pk(f32x2 v) {
    const f32x2 av = __builtin_elementwise_abs(v), d = av * 0.2316418882f + 1.0f;
    f32x2 t; t.x = __builtin_amdgcn_rcpf(d.x); t.y = __builtin_amdgcn_rcpf(d.y);
    f32x2 q = t * 0.5307027145f + (-0.7265760135f); q = q * t + 0.7107068705f; q = q * t + (-0.142248368f); q = q * t + 0.127414796f; q = q * t;
    const f32x2 s = (v * v) * (-0.72134752044f);
    f32x2 e; e.x = __builtin_amdgcn_exp2f(s.x); e.y = __builtin_amdgcn_exp2f(s.y);
    const f32x2 m = v * (q * e), r = v - m;
    f32x2 o; o.x = v.x < 0.f ? m.x : r.x; o.y = v.y < 0.f ? m.y : r.y; return o;
}

template <int ACT  > struct EpiBf16 {
    static constexpr bool PERM = true, AFTER_DRAIN = false; static_assert(ACT == 0 || ACT == 1, "EpiBf16: ACT is 0 (none) or 1 (gelu_pk)");
    bf16_t* O; int ldc; const float* bias; int split_cols; size_t split_stride; float scale0;
    __device__ __forceinline__ void operator()(const f32x4 (&acc)[2][2][4][2], const Unit& u, int wr, int wc, int fr, int fq) const {
        const int row0 = u.pm * BM + wr * 64 + fr; int colt = u.pn * BM; bf16_t* base = O;
        float sc = 1.f; if (split_cols) { const int t = colt / split_cols; base += (size_t)t * split_stride; colt -= t * split_cols; if (t == 0) sc = scale0; }
        const int col0 = colt + wc * 32 + 8 * fq, bcol0 = u.pn * BM + wc * 32 + 8 * fq;
        f32x4 bv[2][2];
#pragma unroll
        for (int bj = 0; bj < 2; ++bj)
#pragma unroll
            for (int n = 0; n < 2; ++n) bv[bj][n] = bias ? *(const f32x4*)(bias + bcol0 + bj * HALF + 4 * n) : (f32x4){0.f, 0.f, 0.f, 0.f};
#pragma unroll
        for (int ai = 0; ai < 2; ++ai)
#pragma unroll
            for (int m = 0; m < 4; ++m) { bf16_t* rowp = base + (size_t)(row0 + ai * HALF + m * 16) * ldc + col0;
#pragma unroll
                for (int bj = 0; bj < 2; ++bj) { f32x4 v0 = acc[ai][bj][m][0] + bv[bj][0], v1 = acc[ai][bj][m][1] + bv[bj][1];
                    if (ACT == 1) { f32x2 a = gelu_pk((f32x2){v0[0], v0[1]}), b = gelu_pk((f32x2){v0[2], v0[3]}), c = gelu_pk((f32x2){v1[0], v1[1]}), d = gelu_pk((f32x2){v1[2], v1[3]});
                        v0 = (f32x4){a.x, a.y, b.x, b.y}; v1 = (f32x4){c.x, c.y, d.x, d.y}; }
                    v0 = v0 * sc; v1 = v1 * sc; u32x4 w; w.x = cvt_pk_bf16(v0[0], v0[1]); w.y = cvt_pk_bf16(v0[2], v0[3]); w.z = cvt_pk_bf16(v1[0], v1[1]); w.w = cvt_pk_bf16(v1[2], v1[3]);
                    *(u32x4*)(rowp + bj * HALF) = w; } }
    }
};

template <int ACT  > struct EpiB {
    static constexpr bool PERM = true, AFTER_DRAIN = false;
    bf16_t* O; int ldc; const float* rowss; float inv_n, eps;
    __device__ __forceinline__ void operator()(const f32x4 (&acc)[2][2][4][2], const Unit& u, int wr, int wc, int fr, int fq) const {
        const int row0 = u.pm * BM + wr * 64 + fr; const int col0 = u.pn * BM + wc * 32 + 8 * fq;
#pragma unroll
        for (int ai = 0; ai < 2; ++ai)
#pragma unroll
            for (int m = 0; m < 4; ++m) { bf16_t* rowp = O + (size_t)(row0 + ai * HALF + m * 16) * ldc + col0;
                const float rs = rowss ? 1.0f / sqrtf(rowss[row0 + ai * HALF + m * 16] * inv_n + eps) : 1.0f;
#pragma unroll
                for (int bj = 0; bj < 2; ++bj) { f32x4 v0 = acc[ai][bj][m][0] * rs, v1 = acc[ai][bj][m][1] * rs;
                    if (ACT == 2) {
#pragma unroll
                        for (int e = 0; e < 4; ++e) { float a = fmaxf(v0[e], 0.f), b = fmaxf(v1[e], 0.f); v0[e] = a * a; v1[e] = b * b; } }
                    u32x4 w; w.x = cvt_pk_bf16(v0[0], v0[1]); w.y = cvt_pk_bf16(v0[2], v0[3]); w.z = cvt_pk_bf16(v1[0], v1[1]); w.w = cvt_pk_bf16(v1[2], v1[3]);
                    *(u32x4*)(rowp + bj * HALF) = w; } }
    }
};
struct EpiRes {
    static constexpr bool PERM = true, AFTER_DRAIN = false;
    const float* base; float* out; int ldc;
    __device__ __forceinline__ void operator()(const f32x4 (&acc)[2][2][4][2], const Unit& u, int wr, int wc, int fr, int fq) const {
        const int row0 = u.pm * BM + wr * 64 + fr; const int col0 = u.pn * BM + wc * 32 + 8 * fq;
#pragma unroll
        for (int ai = 0; ai < 2; ++ai)
#pragma unroll
            for (int m = 0; m < 4; ++m) { const size_t off = (size_t)(row0 + ai * HALF + m * 16) * ldc + col0;
#pragma unroll
                for (int bj = 0; bj < 2; ++bj)
#pragma unroll
                    for (int n = 0; n < 2; ++n) { const f32x4 b = *(const f32x4*)(base + off + bj * HALF + 4 * n); *(f32x4*)(out + off + bj * HALF + 4 * n) = b + acc[ai][bj][m][n]; } }
    }
};
struct EpiResN {
    static constexpr bool PERM = true, AFTER_DRAIN = false;
    const float* base; float* out; bf16_t* xn; float* rowss; int ldc;
    __device__ __forceinline__ void operator()(const f32x4 (&acc)[2][2][4][2], const Unit& u, int wr, int wc, int fr, int fq) const {
        const int row0 = u.pm * BM + wr * 64 + fr; const int col0 = u.pn * BM + wc * 32 + 8 * fq;
#pragma unroll
        for (int ai = 0; ai < 2; ++ai)
#pragma unroll
            for (int m = 0; m < 4; ++m) { const int row = row0 + ai * HALF + m * 16; const size_t off = (size_t)row * ldc + col0; float ss = 0.f;
#pragma unroll
                for (int bj = 0; bj < 2; ++bj) { f32x4 o[2];
#pragma unroll
                    for (int n = 0; n < 2; ++n) { const f32x4 b = *(const f32x4*)(base + off + bj * HALF + 4 * n); o[n] = b + acc[ai][bj][m][n]; *(f32x4*)(out + off + bj * HALF + 4 * n) = o[n];
                        ss += (o[n][0] * o[n][0] + o[n][1] * o[n][1]) + (o[n][2] * o[n][2] + o[n][3] * o[n][3]); }
                    u32x4 w; w.x = cvt_pk_bf16(o[0][0], o[0][1]); w.y = cvt_pk_bf16(o[0][2], o[0][3]); w.z = cvt_pk_bf16(o[1][0], o[1][1]); w.w = cvt_pk_bf16(o[1][2], o[1][3]);
                    *(u32x4*)(xn + off + bj * HALF) = w; }
                ss += __shfl_xor(ss, 16); ss += __shfl_xor(ss, 32);
                if (fq == 0) atomicAdd(rowss + row, ss); }
    }
};

template <class Epi, class Sched, bool ALIGN_EPI = false, bool SP2 = false>
__device__ __forceinline__ void gemm_phase(PG8_LAS unsigned char* lds, const Gemm g, const Sched& S, const Epi& E) {
    int tid = threadIdx.x; asm volatile("" : "+v"(tid));
    const int wid = __builtin_amdgcn_readfirstlane(tid >> 6), lane = tid & 63, wr = wid >> 2, wc = wid & 3, fr = lane & 15, fq = lane >> 4;
    const int K = g.K, nt = K / BK;
    unsigned voffA[2], voffB[2];
#pragma unroll
    for (int i = 0; i < 2; ++i) { int R, C; stage_rc(tid * 16 + i * 8192, R, C); const int Rb = Epi::PERM ? ((R & ~31) + perm32(R & 31)) : R;
        voffA[i] = (unsigned)(R * K + C) * 2u; voffB[i] = (unsigned)(Rb * K + C) * 2u; }
    const size_t kstep = (size_t)(BK * 2);
    const size_t hstep = (size_t)HALF * K * 2;
    const size_t tstep = 2 * hstep;
    const unsigned ldsw = (unsigned)wid * 1024u;
    const int aoff = lds_byte(wr * 64 + fr, fq * 8), boff = lds_byte(wc * 32 + fr, fq * 8);
#define PG8_SA(b, h) (((b) * 2 + (h)) * HTB)
#define PG8_SB(b, h) ((4 + (b) * 2 + (h)) * HTB)
#define PG8_STAGE(bufoff, gbase, voff) do { _Pragma("unroll") for (int _i = 0; _i < 2; ++_i) \
        __builtin_amdgcn_global_load_lds((const unsigned*)((const char*)(gbase) + (voff)[_i]), (PG8_LAS unsigned*)(lds + (bufoff) + ldsw + _i * 8192), 16, 0, 0); } while (0)
#define PG8_LDA(dst, b, h) do { _Pragma("unroll") for (int m = 0; m < 4; ++m) _Pragma("unroll") for (int k = 0; k < 2; ++k) dst[m][k] = *(const PG8_LAS bf16x8*)(lds + PG8_SA(b, h) + aoff + m * 2048 + k * 1024); } while (0)
#define PG8_LDB(dst, b, h) do { _Pragma("unroll") for (int n = 0; n < 2; ++n) _Pragma("unroll") for (int k = 0; k < 2; ++k) dst[n][k] = *(const PG8_LAS bf16x8*)(lds + PG8_SB(b, h) + boff + n * 2048 + k * 1024); } while (0)
#define PG8_MMA(ai, bj, At, Bt) do { __builtin_amdgcn_s_setprio(1); _Pragma("unroll") for (int m = 0; m < 4; ++m) _Pragma("unroll") for (int n = 0; n < 2; ++n) _Pragma("unroll") for (int k = 0; k < 2; ++k) \
        acc[ai][bj][m][n] = __builtin_amdgcn_mfma_f32_16x16x32_bf16(Bt[n][k], At[m][k], acc[ai][bj][m][n], 0, 0, 0); __builtin_amdgcn_s_setprio(0); } while (0)
#define PG8_WAIT_V(n) asm volatile("s_waitcnt vmcnt(" #n ")" ::: "memory")
#define PG8_WAIT_L(n) asm volatile("s_waitcnt lgkmcnt(" #n ")" ::: "memory")
#define PG8_BAR __builtin_amdgcn_s_barrier()
#define PG8_SCHED __builtin_amdgcn_sched_barrier(0)
    Unit cur, nxt; int ui = 0;
    if (!S.next(0, cur)) return;
    f32x4 acc[2][2][4][2];
#pragma unroll
    for (int a = 0; a < 2; ++a)
#pragma unroll
        for (int b = 0; b < 2; ++b)
#pragma unroll
            for (int m = 0; m < 4; ++m)
#pragma unroll
                for (int n = 0; n < 2; ++n) acc[a][b][m][n] = (f32x4){0.f, 0.f, 0.f, 0.f};
    bf16x8 At[4][2], B0[2][2], B1[2][2];
    const char* cA = (const char*)g.A + (size_t)cur.pm * tstep; const char* cB = (const char*)g.Bt + (size_t)cur.pn * tstep;
    S.a_ready(cur);
    if constexpr (SP2) {
        PG8_STAGE(PG8_SB(0, 0), cB, voffB); PG8_STAGE(PG8_SB(0, 1), cB + hstep, voffB); PG8_STAGE(PG8_SA(0, 0), cA, voffA); PG8_STAGE(PG8_SA(0, 1), cA + hstep, voffA);
        if (wr == 1) PG8_BAR;
        PG8_WAIT_V(2); PG8_BAR;
        PG8_STAGE(PG8_SB(1, 0), cB + kstep, voffB); PG8_STAGE(PG8_SA(1, 0), cA + kstep, voffA); PG8_STAGE(PG8_SB(1, 1), cB + hstep + kstep, voffB);
        PG8_WAIT_V(6); PG8_BAR;
    } else {
        PG8_STAGE(PG8_SB(0, 0), cB, voffB); PG8_STAGE(PG8_SA(0, 0), cA, voffA); PG8_STAGE(PG8_SB(0, 1), cB + hstep, voffB); PG8_STAGE(PG8_SA(0, 1), cA + hstep, voffA);
        if (wr == 1) PG8_BAR;
        PG8_WAIT_V(4); PG8_BAR;
        PG8_STAGE(PG8_SB(1, 0), cB + kstep, voffB); PG8_STAGE(PG8_SA(1, 0), cA + kstep, voffA); PG8_STAGE(PG8_SB(1, 1), cB + hstep + kstep, voffB);
        PG8_WAIT_V(6); PG8_BAR;
    }
    for (;;) {
        const bool has_next = S.next(ui + 1, nxt);
        const char* nA = has_next ? (const char*)g.A + (size_t)nxt.pm * tstep : cA; const char* nB = has_next ? (const char*)g.Bt + (size_t)nxt.pn * tstep : cB;
        for (int t = 0; t < nt; t += 2) {
            const bool last = (t == nt - 2);
            const char* a1 = cA + (size_t)(t + 1) * kstep;
            const char* a2 = last ? nA : cA + (size_t)(t + 2) * kstep; const char* b2 = last ? nB : cB + (size_t)(t + 2) * kstep;
            const char* a3 = a2 + kstep; const char* b3 = b2 + kstep;
            if (last && has_next) S.a_ready(nxt);
            if constexpr (SP2) {
            PG8_LDB(B0, 0, 0); PG8_LDB(B1, 0, 1); PG8_SCHED; PG8_LDA(At, 0, 0); PG8_STAGE(PG8_SA(1, 1), a1 + hstep, voffA);
            PG8_WAIT_V(8); PG8_WAIT_L(0); PG8_BAR; PG8_MMA(0, 0, At, B0); PG8_MMA(0, 1, At, B1); PG8_BAR; PG8_SCHED;
            PG8_LDA(At, 0, 1); PG8_STAGE(PG8_SB(0, 0), b2, voffB); PG8_STAGE(PG8_SB(0, 1), b2 + hstep, voffB); PG8_STAGE(PG8_SA(0, 0), a2, voffA);
            PG8_WAIT_V(8); PG8_WAIT_L(0); PG8_BAR; PG8_MMA(1, 0, At, B0); PG8_MMA(1, 1, At, B1); PG8_BAR; PG8_SCHED;
            PG8_LDB(B0, 1, 0); PG8_LDB(B1, 1, 1); PG8_SCHED; PG8_LDA(At, 1, 0); PG8_STAGE(PG8_SA(0, 1), a2 + hstep, voffA);
            PG8_WAIT_V(8); PG8_WAIT_L(0); PG8_BAR; PG8_MMA(0, 0, At, B0); PG8_MMA(0, 1, At, B1); PG8_BAR; PG8_SCHED;
            PG8_LDA(At, 1, 1); PG8_STAGE(PG8_SB(1, 0), b3, voffB); PG8_STAGE(PG8_SB(1, 1), b3 + hstep, voffB); PG8_STAGE(PG8_SA(1, 0), a3, voffA);
            PG8_WAIT_V(8); PG8_WAIT_L(0); PG8_BAR; PG8_MMA(1, 0, At, B0); PG8_MMA(1, 1, At, B1); PG8_BAR; PG8_SCHED;
            } else {
            PG8_LDB(B0, 0, 0); PG8_SCHED; PG8_LDA(At, 0, 0); PG8_STAGE(PG8_SA(1, 1), a1 + hstep, voffA);
            PG8_WAIT_L(8); PG8_BAR; PG8_WAIT_L(0); PG8_MMA(0, 0, At, B0); PG8_BAR; PG8_SCHED;
            PG8_LDB(B1, 0, 1); PG8_STAGE(PG8_SB(0, 0), b2, voffB);
            PG8_BAR; PG8_WAIT_L(0); PG8_MMA(0, 1, At, B1); PG8_BAR;
            PG8_LDA(At, 0, 1); PG8_STAGE(PG8_SA(0, 0), a2, voffA);
            PG8_BAR; PG8_WAIT_L(0); PG8_MMA(1, 0, At, B0); PG8_BAR; PG8_SCHED;
            PG8_STAGE(PG8_SB(0, 1), b2 + hstep, voffB);
            PG8_WAIT_V(6); PG8_BAR; PG8_MMA(1, 1, At, B1); PG8_BAR;
            PG8_LDB(B0, 1, 0); PG8_SCHED; PG8_LDA(At, 1, 0); PG8_STAGE(PG8_SA(0, 1), a2 + hstep, voffA);
            PG8_WAIT_L(8); PG8_BAR; PG8_WAIT_L(0); PG8_MMA(0, 0, At, B0); PG8_BAR; PG8_SCHED;
            PG8_LDB(B1, 1, 1); PG8_STAGE(PG8_SB(1, 0), b3, voffB);
            PG8_BAR; PG8_WAIT_L(0); PG8_MMA(0, 1, At, B1); PG8_BAR;
            PG8_LDA(At, 1, 1); PG8_STAGE(PG8_SA(1, 0), a3, voffA);
            PG8_BAR; PG8_WAIT_L(0); PG8_MMA(1, 0, At, B0); PG8_BAR; PG8_SCHED;
            PG8_STAGE(PG8_SB(1, 1), b3 + hstep, voffB);
            PG8_WAIT_V(6); PG8_BAR; PG8_MMA(1, 1, At, B1); PG8_BAR;
            }
        }
        if constexpr (ALIGN_EPI) { if (wr == 0) PG8_BAR; }
        if constexpr (!Epi::AFTER_DRAIN) { E(acc, cur, wr, wc, fr, fq); S.done(cur); }
        if (!has_next) break;
#pragma unroll
        for (int a = 0; a < 2; ++a)
#pragma unroll
            for (int b = 0; b < 2; ++b)
#pragma unroll
                for (int m = 0; m < 4; ++m)
#pragma unroll
                    for (int n = 0; n < 2; ++n) acc[a][b][m][n] = (f32x4){0.f, 0.f, 0.f, 0.f};
        cur = nxt; cA = nA; cB = nB; ++ui;
        if constexpr (ALIGN_EPI) { if (wr == 1) PG8_BAR; }
    }
    PG8_WAIT_V(0);
    if constexpr (!ALIGN_EPI) { if (wr == 0) PG8_BAR; }
    PG8_BAR;
    if constexpr (Epi::AFTER_DRAIN) { E.fused(acc, cur, wr, wc, fr, fq, lds, wid, lane); S.done(cur); }
#undef PG8_SA
#undef PG8_SB
#undef PG8_STAGE
#undef PG8_LDA
#undef PG8_LDB
#undef PG8_MMA
#undef PG8_WAIT_V
#undef PG8_WAIT_L
#undef PG8_BAR
#undef PG8_SCHED
}
}

namespace att {
typedef unsigned short bf16;
using bf16x8 = __attribute__((ext_vector_type(8))) short;
using s16x4  = __attribute__((ext_vector_type(4))) short;
using f32x16 = __attribute__((ext_vector_type(16))) float;
using u32x4  = __attribute__((ext_vector_type(4))) unsigned;
constexpr int NW = 8, QBLK = 32, KVBLK = 64;
#define SBAR() __builtin_amdgcn_sched_barrier(0)
__device__ __forceinline__ int crow(int r, int hi) { return (r & 3) + 8 * (r >> 2) + 4 * hi; }
__device__ __forceinline__ unsigned cvtpk(float lo, float hi) { unsigned r; asm volatile("v_cvt_pk_bf16_f32 %0, %1, %2" : "=v"(r) : "v"(lo), "v"(hi)); return r; }
template <int DK> __device__ __forceinline__ int kswz(int row, int colB) { const int f = (DK == 128) ? ((row & 7) | ((row & 16) >> 1)) : ((row >> 1) & 7); return row * (DK * 2) + (colB ^ (f << 4)); }

__device__ __forceinline__ void partialSM(f32x16& p0, f32x16& p1, float& m_reg, float& mn, float& alpha, const float C, const float thr_raw) {
  float pmax = p0[0];
#pragma unroll
  for (int r = 1; r < 16; ++r) pmax = fmaxf(pmax, p0[r]);
#pragma unroll
  for (int r = 0; r < 16; ++r) pmax = fmaxf(pmax, p1[r]);
  { auto rr = __builtin_amdgcn_permlane32_swap(__float_as_uint(pmax), __float_as_uint(pmax), false, false);
    pmax = fmaxf(__uint_as_float(rr[0]), __uint_as_float(rr[1])); }
  if (__builtin_expect(__all(pmax - m_reg <= thr_raw), 1)) { mn = m_reg; alpha = 1.f; }
  else { mn = fmaxf(m_reg, pmax); alpha = __builtin_amdgcn_exp2f((m_reg - mn) * C); m_reg = mn; }
  float mnC = -mn * C;
#pragma unroll
  for (int r = 0; r < 16; ++r) p0[r] = fmaf(p0[r], C, mnC);
#pragma unroll
  for (int r = 0; r < 16; ++r) p1[r] = fmaf(p1[r], C, mnC);
#pragma unroll
  for (int r = 0; r < 16; ++r) p0[r] = __builtin_amdgcn_exp2f(p0[r]);
}
__device__ __forceinline__ void finishSM(f32x16& p0, f32x16& p1, float alpha, float& l_reg, bf16x8& pa0, bf16x8& pa1, bf16x8& pa2, bf16x8& pa3) {
#pragma unroll
  for (int r = 0; r < 16; ++r) p1[r] = __builtin_amdgcn_exp2f(p1[r]);
  float ps = 0;
#pragma unroll
  for (int r = 0; r < 16; ++r) ps += p0[r];
#pragma unroll
  for (int r = 0; r < 16; ++r) ps += p1[r];
  { auto rr = __builtin_amdgcn_permlane32_swap(__float_as_uint(ps), __float_as_uint(ps), false, false);
    ps = __uint_as_float(rr[0]) + __uint_as_float(rr[1]); }
  l_reg = l_reg * alpha + ps;
#define PK4(P, BASE, OUT) do { unsigned a0 = cvtpk(P[BASE + 0], P[BASE + 1]), a1 = cvtpk(P[BASE + 2], P[BASE + 3]);   \
    unsigned b0 = cvtpk(P[BASE + 4], P[BASE + 5]), b1 = cvtpk(P[BASE + 6], P[BASE + 7]);                              \
    auto r0 = __builtin_amdgcn_permlane32_swap(a0, b0, false, false); auto r1 = __builtin_amdgcn_permlane32_swap(a1, b1, false, false); \
    u32x4 w = {r0[0], r1[0], r0[1], r1[1]}; OUT = *reinterpret_cast<bf16x8*>(&w); } while (0)
  PK4(p0, 0, pa0); PK4(p0, 8, pa1); PK4(p1, 0, pa2); PK4(p1, 8, pa3);
#undef PK4
}
template <int DK, int GS> __device__ __forceinline__ void qkt(f32x16& p0, f32x16& p1, const char* Ks, const int (&kb)[4], const int (&kbx)[4], const bf16x8* qr) {
  constexpr int ND = DK / 16, NG = ND / GS;
  static_assert(ND % GS == 0, "group size");
  p0 = f32x16{}; p1 = f32x16{};
  bf16x8 fa[2][GS], fb[2][GS];
#define QK_RD(buf, g) do { _Pragma("unroll") for (int s_ = 0; s_ < GS; ++s_) { const int d0_ = (g) * GS + s_, e_ = d0_ & 3, gg_ = d0_ >> 2; \
      const int ko_ = (DK == 128) ? (gg_ ? kbx[e_] : kb[e_]) : (kb[e_] + gg_ * 128); \
      fa[buf][s_] = *reinterpret_cast<const bf16x8*>(Ks + ko_); fb[buf][s_] = *reinterpret_cast<const bf16x8*>(Ks + ko_ + 32 * DK * 2); } } while (0)
  QK_RD(0, 0);
#pragma unroll
  for (int g = 0; g < NG; ++g) {
    if (g + 1 < NG) { QK_RD((g + 1) & 1, g + 1); }
    SBAR();
#pragma unroll
    for (int s_ = 0; s_ < GS; ++s_) {
      p0 = __builtin_amdgcn_mfma_f32_32x32x16_bf16(fa[g & 1][s_], qr[g * GS + s_], p0, 0, 0, 0);
      p1 = __builtin_amdgcn_mfma_f32_32x32x16_bf16(fb[g & 1][s_], qr[g * GS + s_], p1, 0, 0, 0); }
    SBAR();
  }
#undef QK_RD
}
template <int NCB> __device__ __forceinline__ int v_st(int k, int c) { const int kk = (k & ~0xC) | ((k & 4) << 1) | ((k & 8) >> 1); return ((kk >> 3) * NCB + (c >> 5)) * 512 + ((kk & 7) * 32 + (c & 31)) * 2; }
__device__ __forceinline__ int v_rd_base(int lane) { return ((lane & 3) << 3) | (((lane >> 2) & 3) << 6) | (((lane >> 4) & 1) << 5) | (((lane >> 5) & 1) << 8); }
template <int OFF> __device__ __forceinline__ s16x4 tr_read(int vb) {
  s16x4 r; asm volatile("ds_read_b64_tr_b16 %0, %1 offset:%2" : "=&v"(r) : "v"(vb), "i"(OFF) : "memory"); return r;
}
template <int D0, int NCB> __device__ __forceinline__ void pv_one(f32x16& od, int vb, bf16x8 pa0, bf16x8 pa1, bf16x8 pa2, bf16x8 pa3) {
#define VOFF(ks, half) (D0 * 512 + (ks) * (1024 * NCB) + (half) * (512 * NCB))
  const s16x4 l0 = tr_read<VOFF(0, 0)>(vb), h0 = tr_read<VOFF(0, 1)>(vb), l1 = tr_read<VOFF(1, 0)>(vb), h1 = tr_read<VOFF(1, 1)>(vb);
  const s16x4 l2 = tr_read<VOFF(2, 0)>(vb), h2 = tr_read<VOFF(2, 1)>(vb), l3 = tr_read<VOFF(3, 0)>(vb), h3 = tr_read<VOFF(3, 1)>(vb);
#undef VOFF
  asm volatile("s_waitcnt lgkmcnt(0)" ::: "memory"); SBAR();
#define PK(L, H) (bf16x8){L[0], L[1], L[2], L[3], H[0], H[1], H[2], H[3]}
  od = __builtin_amdgcn_mfma_f32_32x32x16_bf16(pa0, PK(l0, h0), od, 0, 0, 0);
  od = __builtin_amdgcn_mfma_f32_32x32x16_bf16(pa1, PK(l1, h1), od, 0, 0, 0);
  od = __builtin_amdgcn_mfma_f32_32x32x16_bf16(pa2, PK(l2, h2), od, 0, 0, 0);
  od = __builtin_amdgcn_mfma_f32_32x32x16_bf16(pa3, PK(l3, h3), od, 0, 0, 0);
#undef PK
}
template <int NCB> __device__ __forceinline__ void pv_all(f32x16* o, int vb, bf16x8 pa0, bf16x8 pa1, bf16x8 pa2, bf16x8 pa3) {
  pv_one<0, NCB>(o[0], vb, pa0, pa1, pa2, pa3); pv_one<1, NCB>(o[1], vb, pa0, pa1, pa2, pa3);
  if constexpr (NCB == 4) { pv_one<2, NCB>(o[2], vb, pa0, pa1, pa2, pa3); pv_one<3, NCB>(o[3], vb, pa0, pa1, pa2, pa3); }
}

template <int DK, int DV, bool SWA, bool TWO, int GS>
__device__ __forceinline__ void attn_unit(const bf16* __restrict__ Qrow, const bf16* __restrict__ Kh, const bf16* __restrict__ Vh, bf16* __restrict__ Ow, const int ldo,
                                          const int kstart, const int NT, const int qpos, const int seq, const int win,
                                          const float m_init, const float l_init, const float C, const float thr_raw, char* lds) {
  constexpr int NCB = DV / 32, SHM_V = KVBLK * DV * 2, SHM_K = KVBLK * DK * 2, KCH = DK / 8, VCH = DV / 8, NKC = DK / 64, NVC = DV / 64;
  int tid = threadIdx.x; asm volatile("" : "+v"(tid));
  const int wid = tid >> 6, lane = tid & 63, r32 = lane & 31, hi = lane >> 5;
  char* V_lds = lds; char* K_lds = lds + 2 * SHM_V;
  float* ws = (float*)(lds + 2 * SHM_V + 2 * SHM_K) + wid * 64; float* li_l = ws; float* al_l = ws + 32;
  float m_reg = m_init, l_reg = l_init; f32x16 o[NCB]; bf16x8 qr[DK / 16];
#pragma unroll
  for (int d = 0; d < NCB; ++d) o[d] = f32x16{};
#pragma unroll
  for (int d0 = 0; d0 < DK / 16; ++d0) qr[d0] = *reinterpret_cast<const bf16x8*>(Qrow + d0 * 16 + hi * 8);
  unsigned koff[NKC], voff[NVC]; int kdst[NKC], vdst[NVC], krow0 = 0;
#pragma unroll
  for (int i = 0; i < NKC; ++i) { const int c = tid + 512 * i, row = c / KCH, col = (c % KCH) * 8; koff[i] = (unsigned)(row * DK + col) * 2u; kdst[i] = kswz<DK>(row, col * 2); if (i == 0) krow0 = row; }
#pragma unroll
  for (int i = 0; i < NVC; ++i) {
    const int sp = wid * NVC + i, kg = (NCB == 4) ? (sp >> 1) : sp, ch = (NCB == 4) ? (sp & 1) : 0, sel = lane >> 5, kk = 8 * kg + ((lane & 31) >> 2);
    const int row = (kk & ~0xC) | ((kk & 4) << 1) | ((kk & 8) >> 1), col = 64 * ch + 32 * sel + 8 * (lane & 3);
    voff[i] = (unsigned)(row * DV + col) * 2u; vdst[i] = v_st<NCB>(row, col); }
  const int vb0 = (int)(uintptr_t)V_lds + v_rd_base(lane);
  int kb[4], kbx[4];
#pragma unroll
  for (int e = 0; e < 4; ++e) { kb[e] = kswz<DK>(r32, (e * 16 + hi * 8) * 2); kbx[e] = kb[e] ^ 128; }
  bf16x8 ks[NKC], vs[NVC], ks2[NKC], vs2[NVC];
#define SLOADX(ks, vs, k0) do { if constexpr (SWA) { static_assert(!SWA || (NKC == 1 && NVC == 1 && DK == DV), "SWA path: one chunk per thread"); \
      const int kr_ = min(max((k0) + krow0, 0), seq - 1) - krow0; const char* Kt = (const char*)Kh + (long)kr_ * (DK * 2); const char* Vt = (const char*)Vh + (long)kr_ * (DV * 2); \
      vs[0] = *reinterpret_cast<const bf16x8*>(Vt + voff[0]); ks[0] = *reinterpret_cast<const bf16x8*>(Kt + koff[0]); } \
    else { const char* Kt = (const char*)Kh + (long)(k0) * (DK * 2); const char* Vt = (const char*)Vh + (long)(k0) * (DV * 2); \
      _Pragma("unroll") for (int i = 0; i < NVC; ++i) vs[i] = *reinterpret_cast<const bf16x8*>(Vt + voff[i]); \
      _Pragma("unroll") for (int i = 0; i < NKC; ++i) ks[i] = *reinterpret_cast<const bf16x8*>(Kt + koff[i]); } } while (0)
#define SWRITEX(ks, vs, b) do { _Pragma("unroll") for (int i = 0; i < NVC; ++i) *(bf16x8*)(V_lds + (b) * SHM_V + vdst[i]) = vs[i]; \
    _Pragma("unroll") for (int i = 0; i < NKC; ++i) *(bf16x8*)(K_lds + (b) * SHM_K + kdst[i]) = ks[i]; } while (0)
#define SLOAD(k0) SLOADX(ks, vs, k0)
#define SWRITE(b) SWRITEX(ks, vs, b)
#define SWAIT() asm volatile("s_waitcnt vmcnt(0)" ::: "memory")
#define RESC(a) do { if (__any((a) < 1.f)) { if (hi == 0) al_l[r32] = (a); asm volatile("s_waitcnt lgkmcnt(0)" ::: "memory"); \
    _Pragma("unroll") for (int d = 0; d < NCB; ++d) _Pragma("unroll") for (int r = 0; r < 16; ++r) o[d][r] *= al_l[crow(r, hi)]; } } while (0)
#define MASK(P0, P1, k0) do { if constexpr (SWA) { const int kb = (k0) + 4 * hi; \
    _Pragma("unroll") for (int r = 0; r < 16; ++r) { const int kv = kb + (r & 3) + 8 * (r >> 2); const int dq = qpos - kv; \
      if (!(dq <= win && dq >= -win && kv >= 0 && kv < seq)) P0[r] = -INFINITY; \
      const int kv2 = kv + 32, dq2 = qpos - kv2; if (!(dq2 <= win && dq2 >= -win && kv2 >= 0 && kv2 < seq)) P1[r] = -INFINITY; } } } while (0)
  f32x16 pA0, pA1, pB0, pB1; float mnA, mnB, alA, alB; bf16x8 pa0, pa1, pa2, pa3;
  if constexpr (TWO) {
  SLOAD(kstart); SWAIT(); SWRITE(0); __syncthreads();
  qkt<DK, GS>(pA0, pA1, K_lds, kb, kbx, qr); MASK(pA0, pA1, kstart); partialSM(pA0, pA1, m_reg, mnA, alA, C, thr_raw);
  SLOAD(kstart + KVBLK);
  SWAIT(); SWRITE(1); __syncthreads();
  for (int j = 1; j + 1 < NT; j += 2) {
    SBAR(); qkt<DK, GS>(pB0, pB1, K_lds + SHM_K, kb, kbx, qr);
    finishSM(pA0, pA1, alA, l_reg, pa0, pa1, pa2, pa3); SBAR();
    SLOAD(kstart + (j + 1) * KVBLK); SBAR();
    pv_all<NCB>(o, vb0, pa0, pa1, pa2, pa3); MASK(pB0, pB1, kstart + j * KVBLK); partialSM(pB0, pB1, m_reg, mnB, alB, C, thr_raw);
    __syncthreads(); SWAIT(); SWRITE(0);
    RESC(alB); __syncthreads();
    SBAR(); qkt<DK, GS>(pA0, pA1, K_lds, kb, kbx, qr);
    finishSM(pB0, pB1, alB, l_reg, pa0, pa1, pa2, pa3); SBAR();
    SLOAD(kstart + (j + 2) * KVBLK); SBAR();
    pv_all<NCB>(o, vb0 + SHM_V, pa0, pa1, pa2, pa3); MASK(pA0, pA1, kstart + (j + 1) * KVBLK); partialSM(pA0, pA1, m_reg, mnA, alA, C, thr_raw);
    __syncthreads(); SWAIT(); SWRITE(1);
    RESC(alA); __syncthreads();
  }
  SBAR(); qkt<DK, GS>(pB0, pB1, K_lds + SHM_K, kb, kbx, qr);
  finishSM(pA0, pA1, alA, l_reg, pa0, pa1, pa2, pa3); SBAR();
  pv_all<NCB>(o, vb0, pa0, pa1, pa2, pa3); MASK(pB0, pB1, kstart + (NT - 1) * KVBLK); partialSM(pB0, pB1, m_reg, mnB, alB, C, thr_raw);
  RESC(alB);
  finishSM(pB0, pB1, alB, l_reg, pa0, pa1, pa2, pa3); SBAR();
  pv_all<NCB>(o, vb0 + SHM_V, pa0, pa1, pa2, pa3);
  } else {
#define TILE(bsel, jj) do { SBAR(); qkt<DK, GS>(pA0, pA1, K_lds + (bsel) * SHM_K, kb, kbx, qr); MASK(pA0, pA1, kstart + (jj) * KVBLK); partialSM(pA0, pA1, m_reg, mnA, alA, C, thr_raw); \
      RESC(alA); finishSM(pA0, pA1, alA, l_reg, pa0, pa1, pa2, pa3); SBAR(); pv_all<NCB>(o, vb0 + (bsel) * SHM_V, pa0, pa1, pa2, pa3); SBAR(); } while (0)
    SLOADX(ks, vs, kstart); SBAR(); SLOADX(ks2, vs2, kstart + KVBLK); SBAR();
    SWRITEX(ks, vs, 0); SBAR();
    SLOADX(ks, vs, kstart + 2 * KVBLK); SBAR();
    __syncthreads();
    for (int j = 0; j < NT; j += 2) {
      TILE(0, j);
      SWRITEX(ks2, vs2, 1); SBAR();
      if (j + 3 < NT) { SLOADX(ks2, vs2, kstart + (j + 3) * KVBLK); } SBAR();
      __syncthreads();
      TILE(1, j + 1);
      if (j + 2 < NT) { SWRITEX(ks, vs, 0); SBAR(); if (j + 4 < NT) { SLOADX(ks, vs, kstart + (j + 4) * KVBLK); } SBAR(); }
      __syncthreads();
    }
#undef TILE
  }
  if (hi == 0) li_l[r32] = l_reg; asm volatile("s_waitcnt lgkmcnt(0)" ::: "memory");
  float rli[16];
#pragma unroll
  for (int r = 0; r < 16; ++r) rli[r] = __builtin_amdgcn_rcpf(li_l[crow(r, hi)]);
  __syncthreads();
  { bf16* stg = (bf16*)lds + wid * (QBLK * DV);
#pragma unroll
    for (int r = 0; r < 16; ++r) { const int orow = crow(r, hi);
#pragma unroll
      for (int d0 = 0; d0 < NCB; ++d0) stg[orow * DV + d0 * 32 + r32] = (bf16)(cvtpk(o[d0][r] * rli[r], 0.f) & 0xffffu); }
    asm volatile("s_waitcnt lgkmcnt(0)" ::: "memory");
#pragma unroll
    for (int i = 0; i < (QBLK * VCH) / 64; ++i) { const int idx = i * 64 + lane, row = idx / VCH, ch = idx % VCH;
      const u32x4 v = *(const u32x4*)(stg + row * DV + ch * 8); *(u32x4*)(Ow + (long)row * ldo + ch * 8) = v; } }
  __syncthreads();
#undef SLOAD
#undef SLOADX
#undef SWRITEX
#undef SWRITE
#undef SWAIT
#undef RESC
#undef MASK
}
template <int NT>
__device__ __forceinline__ void swa_unit(const bf16* __restrict__ Qrow, const bf16* __restrict__ Kh, const bf16* __restrict__ Vh, bf16* __restrict__ Ow, const int ldo,
                                         const int kstart, const int qpos, const int seq, const int win,
                                         const float m_init, const float C, const float thr_raw, char* lds) {
  constexpr int DK = 64, DV = 64, NCB = 2, SHM = KVBLK * 64 * 2, VCH = 8;
  int tid = threadIdx.x; asm volatile("" : "+v"(tid));
  const int wid = tid >> 6, lane = tid & 63, r32 = lane & 31, hi = lane >> 5;
  char* V_lds = lds; char* K_lds = lds + NT * SHM;
  float* ws = (float*)(lds + 2 * NT * SHM) + wid * 64; float* li_l = ws; float* al_l = ws + 32;
  float m_reg = m_init, l_reg = 1.f; f32x16 o[NCB]; bf16x8 qr[4];
  o[0] = f32x16{}; o[1] = f32x16{};
#pragma unroll
  for (int d0 = 0; d0 < 4; ++d0) qr[d0] = *reinterpret_cast<const bf16x8*>(Qrow + d0 * 16 + hi * 8);
  const int row = tid >> 3, col = (tid & 7) * 8;
  const int vkk = 8 * wid + ((lane & 31) >> 2), vrow = (vkk & ~0xC) | ((vkk & 4) << 1) | ((vkk & 8) >> 1), vcol = 32 * (lane >> 5) + 8 * (lane & 3);
  const int kdst = kswz<DK>(row, col * 2), vdst = v_st<NCB>(vrow, vcol);
  const int vb0 = (int)(uintptr_t)V_lds + v_rd_base(lane);
  int kb[4], kbx[4];
#pragma unroll
  for (int e = 0; e < 4; ++e) { kb[e] = kswz<DK>(r32, (e * 16 + hi * 8) * 2); kbx[e] = kb[e]; }
  bf16x8 ksr[NT], vsr[NT];
#pragma unroll
  for (int t = 0; t < NT; ++t) { const int kr = min(max(kstart + t * KVBLK + row, 0), seq - 1);
    const int vr = min(max(kstart + t * KVBLK + vrow, 0), seq - 1);
    ksr[t] = *reinterpret_cast<const bf16x8*>(Kh + (long)kr * DK + col); vsr[t] = *reinterpret_cast<const bf16x8*>(Vh + (long)vr * DV + vcol); }
#pragma unroll
  for (int t = 0; t < NT; ++t) { *(bf16x8*)(K_lds + t * SHM + kdst) = ksr[t]; *(bf16x8*)(V_lds + t * SHM + vdst) = vsr[t]; }
  __syncthreads();
  f32x16 p0, p1; float mn, al; bf16x8 pa0, pa1, pa2, pa3;
#pragma unroll
  for (int t = 0; t < NT; ++t) {
    const int k0 = kstart + t * KVBLK;
    SBAR(); qkt<DK, 2>(p0, p1, K_lds + t * SHM, kb, kbx, qr);
    { const int kbase = k0 + 4 * hi;
#pragma unroll
      for (int r = 0; r < 16; ++r) { const int kv = kbase + (r & 3) + 8 * (r >> 2); const int dq = qpos - kv;
        if (!(dq <= win && dq >= -win && kv >= 0 && kv < seq)) p0[r] = -INFINITY;
        const int kv2 = kv + 32, dq2 = qpos - kv2; if (!(dq2 <= win && dq2 >= -win && kv2 >= 0 && kv2 < seq)) p1[r] = -INFINITY; } }
    partialSM(p0, p1, m_reg, mn, al, C, thr_raw);
    if (__any(al < 1.f)) { if (hi == 0) al_l[r32] = al; asm volatile("s_waitcnt lgkmcnt(0)" ::: "memory");
#pragma unroll
      for (int d = 0; d < NCB; ++d)
#pragma unroll
        for (int r = 0; r < 16; ++r) o[d][r] *= al_l[crow(r, hi)]; }
    finishSM(p0, p1, al, l_reg, pa0, pa1, pa2, pa3); SBAR();
    pv_all<NCB>(o, vb0 + t * SHM, pa0, pa1, pa2, pa3);
  }
  if (hi == 0) li_l[r32] = l_reg; asm volatile("s_waitcnt lgkmcnt(0)" ::: "memory");
  float rli[16];
#pragma unroll
  for (int r = 0; r < 16; ++r) rli[r] = __builtin_amdgcn_rcpf(li_l[crow(r, hi)]);
  __syncthreads();
  { bf16* stg = (bf16*)lds + wid * (QBLK * DV);
#pragma unroll
    for (int r = 0; r < 16; ++r) { const int orow = crow(r, hi);
#pragma unroll
      for (int d0 = 0; d0 < NCB; ++d0) stg[orow * DV + d0 * 32 + r32] = (bf16)(cvtpk(o[d0][r] * rli[r], 0.f) & 0xffffu); }
    asm volatile("s_waitcnt lgkmcnt(0)" ::: "memory");
#pragma unroll
    for (int i = 0; i < (QBLK * VCH) / 64; ++i) { const int idx = i * 64 + lane, rw = idx / VCH, ch = idx % VCH;
      const u32x4 v = *(const u32x4*)(stg + rw * DV + ch * 8); *(u32x4*)(Ow + (long)rw * ldo + ch * 8) = v; } }
  __syncthreads();
}
#undef SBAR
}

#define LAS __attribute__((address_space(3)))
typedef unsigned short bf16;
typedef unsigned v4u __attribute__((ext_vector_type(4)));
typedef unsigned v2u __attribute__((ext_vector_type(2)));
typedef float f32x4 __attribute__((ext_vector_type(4)));
typedef float f32x2 __attribute__((ext_vector_type(2)));
constexpr int NWAVES = 8;
constexpr int BATCH = 2, SEQ = 8192, T = BATCH * SEQ, DM = 2048, DFF = 8192;
constexpr int EVEN_IN = 2368, EVEN_IN_P = 2560, ODD_IN = 2560;
constexpr float EPS = 1e-6f;
constexpr size_t MiB = 1u << 20;
constexpr size_t WS_WIN = 1 * MiB, WS_WUQ = 11 * MiB, WS_WUKV = 13 * MiB, WS_WOE = 14 * MiB, WS_WUP = 22 * MiB, WS_WDN = 54 * MiB;
constexpr size_t WS_WQKV = 487 * MiB, WS_WOO = 497 * MiB;
constexpr size_t WS_TMLA = 86 * MiB, WS_TAX = 88 * MiB, WS_TSWA = 92 * MiB;
constexpr size_t WS_XN = 93 * MiB;
constexpr size_t WS_ROWSS = 64 * 1024;
constexpr size_t AB = 157 * MiB;
constexpr size_t WS_MRG = AB;
constexpr size_t WS_U = AB;
constexpr size_t WS_PROJ = AB, WS_KVR = AB, WS_QAR = AB + 80 * MiB, WS_CQN = AB + 128 * MiB, WS_CKVN = AB + 144 * MiB, WS_KR = AB + 152 * MiB, WS_QG = AB + 154 * MiB,
                 WS_KG = AB + 186 * MiB, WS_VG = AB + 194 * MiB, WS_QA = AB + 202 * MiB, WS_KA = AB + 250 * MiB, WS_VA = AB + 298 * MiB;
constexpr size_t WS_SQ = AB + 80 * MiB, WS_SK = AB + 144 * MiB, WS_SV = AB + 152 * MiB;
constexpr size_t WS_END = AB + 330 * MiB;
static_assert(WS_END <= WS_WQKV && WS_WOO + 8 * MiB <= 512 * MiB && WS_U + 256 * MiB <= WS_WQKV, "workspace map");
constexpr size_t WS_NEED = 505 * MiB;
#ifdef PROBE_NOLDS
constexpr int LDS_BYTES = 0;
#else
constexpr int LDS_BYTES = 131072 + 1024;
#endif

__device__ __forceinline__ unsigned cvtpk2(float lo, float hi) { unsigned r; asm volatile("v_cvt_pk_bf16_f32 %0, %1, %2" : "=v"(r) : "v"(lo), "v"(hi)); return r; }
__device__ __forceinline__ float bflo(unsigned w) { return __uint_as_float(w << 16); }
__device__ __forceinline__ float bfhi(unsigned w) { return __uint_as_float(w & 0xffff0000u); }
__device__ __forceinline__ void ld8(const bf16* p, float (&v)[8]) { const v4u w = *(const v4u*)p; v[0] = bflo(w.x); v[1] = bfhi(w.x); v[2] = bflo(w.y); v[3] = bfhi(w.y); v[4] = bflo(w.z); v[5] = bfhi(w.z); v[6] = bflo(w.w); v[7] = bfhi(w.w); }
__device__ __forceinline__ void st8(bf16* p, const float (&v)[8]) { v4u w; w.x = cvtpk2(v[0], v[1]); w.y = cvtpk2(v[2], v[3]); w.z = cvtpk2(v[4], v[5]); w.w = cvtpk2(v[6], v[7]); *(v4u*)p = w; }
__device__ __forceinline__ void ld4(const bf16* p, float (&v)[4]) { const v2u w = *(const v2u*)p; v[0] = bflo(w.x); v[1] = bfhi(w.x); v[2] = bflo(w.y); v[3] = bfhi(w.y); }
__device__ __forceinline__ void st4(bf16* p, const float (&v)[4]) { v2u w; w.x = cvtpk2(v[0], v[1]); w.y = cvtpk2(v[2], v[3]); *(v2u*)p = w; }
template <int W> __device__ __forceinline__ float grp_sum(float v) {
#pragma unroll
  for (int o = 1; o < W; o <<= 1) v += __shfl_xor(v, o);
  return v;
}
__device__ __forceinline__ float sumsq8(const float (&v)[8]) { float s = 0.f;
#pragma unroll
  for (int j = 0; j < 8; ++j) s += v[j] * v[j];
  return s; }

#define XB_TMO      128
#define XB_XCNT(j)  (256  + 64 * (j))
#define XB_XSUB(j)  (1280 + 64 * (j))
#define XB_XGEN(j)  (2304 + 64 * (j))
#define XB_TOP      3328
#define XB_TOPGEN   3392
#define XCD_BAR_WORDS 3456
#define XB_SPIN_CAP (1u << 18)

__device__ __forceinline__ unsigned xb_ld(unsigned* p)              { return __hip_atomic_load(p, __ATOMIC_RELAXED, __HIP_MEMORY_SCOPE_AGENT); }
__device__ __forceinline__ unsigned xb_add(unsigned* p, unsigned v) { return __hip_atomic_fetch_add(p, v, __ATOMIC_RELAXED, __HIP_MEMORY_SCOPE_AGENT); }
__device__ __forceinline__ unsigned xb_xcc_id() { return (unsigned)__builtin_amdgcn_s_getreg((3 << 11) | 20) & 0xFu; }
#define XB_SPIN(cond, bar) do { unsigned _sp = 0; while (cond) { __builtin_amdgcn_s_sleep(1); \
    if ((++_sp & 255u) == 0u) { if (xb_ld(&(bar)[XB_TMO])) break; if (_sp > XB_SPIN_CAP) { atomicAdd(&(bar)[XB_TMO], 1u); break; } } } } while (0)

struct XcdBarrier {
    unsigned* bar; unsigned x;
    volatile LAS unsigned* st;
};

__device__ __forceinline__ XcdBarrier xcd_barrier_post(unsigned* bar, volatile LAS unsigned* st) {
    XcdBarrier b; b.bar = bar; b.x = xb_xcc_id(); b.st = st;
    if (threadIdx.x == 0) (void)xb_add(&bar[XB_XCNT(b.x)], 1u);
    return b;
}
__device__ __forceinline__ void xcd_barrier_complete(unsigned* bar, unsigned x, unsigned& nloc, unsigned& nx) {
    const unsigned G = gridDim.x * gridDim.y * gridDim.z;
    unsigned sum, cnt, mine, sp = 0u;
    for (;;) {
        sum = 0u; cnt = 0u; mine = 0u;
#pragma unroll
        for (unsigned j = 0; j < 16; ++j) { const unsigned c = xb_ld(&bar[XB_XCNT(j)]); sum += c; cnt += (c > 0u) ? 1u : 0u; mine = (j == x) ? c : mine; }
        if (sum == G) break;
        __builtin_amdgcn_s_sleep(1);
        if ((++sp & 255u) == 0u) { if (xb_ld(&bar[XB_TMO])) break; if (sp > XB_SPIN_CAP) { atomicAdd(&bar[XB_TMO], 1u); break; } }
    }
    nloc = mine > 0u ? mine : 1u; nx = cnt > 0u ? cnt : 1u;
}

__device__ __forceinline__ void xcd_barrier(const XcdBarrier& b) {
    asm volatile("s_waitcnt vmcnt(0)" ::: "memory");
    __syncthreads();
    if (threadIdx.x == 0) {
        unsigned* bar = b.bar;
        __builtin_amdgcn_s_waitcnt(0);
        unsigned nloc = b.st[0], nx = b.st[1];
        if (nloc == 0u) { xcd_barrier_complete(bar, b.x, nloc, nx); b.st[0] = nloc; b.st[1] = nx; }
        const unsigned old = xb_add(&bar[XB_XSUB(b.x)], 1u);
        const unsigned gen = old / nloc;
        if (old + 1u == (gen + 1u) * nloc) {
            __builtin_amdgcn_fence(__ATOMIC_RELEASE, "agent");
            asm volatile("s_waitcnt vmcnt(0)" ::: "memory");
            const unsigned og = xb_add(&bar[XB_TOP], 1u);
            const unsigned tg = og / nx;
            if (og + 1u == (tg + 1u) * nx) xb_add(&bar[XB_TOPGEN], 1u);
            else XB_SPIN(xb_ld(&bar[XB_TOPGEN]) == tg, bar);
            __builtin_amdgcn_fence(__ATOMIC_ACQUIRE, "agent");
            xb_add(&bar[XB_XGEN(b.x)], 1u);
            asm volatile("s_waitcnt vmcnt(0)" ::: "memory");
        } else {
            XB_SPIN(xb_ld(&bar[XB_XGEN(b.x)]) == gen, bar);
            __builtin_amdgcn_fence(__ATOMIC_ACQUIRE, "agent");
            asm volatile("s_waitcnt vmcnt(0)" ::: "memory");
        }
    }
    __syncthreads();
}

struct Args {
  const float* in[22]; float* out; unsigned char* ws;
  float inv_mla[32], inv_ax[32], inv_swa[8];
};

struct Ctx { int lane, wave, gw, NGW, G, vcu; unsigned char* ws; };

__device__ __forceinline__ void transpose_stream(const float* __restrict__ W, const int K, const int N, bf16* __restrict__ WT, LAS float* scr, const int first, const int items, const int stride, const int lane, const float* __restrict__ gain) {
  const int nblk = N / 32, half = lane >> 5, l31 = lane & 31;
  float cur[32], nxt[32];
  if (first >= items) return;
#define TS_LOAD(dst, item_) do { const int kb_ = (item_) / nblk, nb_ = (item_) % nblk; const float* p_ = W + (size_t)(64 * kb_ + half) * N + 32 * nb_ + l31; \
    _Pragma("unroll") for (int i = 0; i < 32; ++i) dst[i] = p_[(size_t)(2 * i) * N]; } while (0)
  TS_LOAD(cur, first);
  for (int it = first; it < items; it += stride) {
    const bool more = it + stride < items;
    if (more) TS_LOAD(nxt, it + stride);
    const int kb = it / nblk, nb = it % nblk, k0 = 64 * kb, n0 = 32 * nb;
    if (gain) {
#pragma unroll
      for (int i = 0; i < 32; ++i) cur[i] *= gain[k0 + 2 * i + half]; }
#pragma unroll
    for (int i = 0; i < 32; ++i) scr[(2 * i + half) * 33 + l31] = cur[i];
    asm volatile("s_waitcnt lgkmcnt(0)" ::: "memory");
    const int c = lane & 7;
#pragma unroll
    for (int j = 0; j < 4; ++j) { const int n = (lane >> 3) + 8 * j; const LAS float* s = scr + (8 * c) * 33 + n;
      v4u o; o.x = cvtpk2(s[0 * 33], s[1 * 33]); o.y = cvtpk2(s[2 * 33], s[3 * 33]); o.z = cvtpk2(s[4 * 33], s[5 * 33]); o.w = cvtpk2(s[6 * 33], s[7 * 33]);
      *(v4u*)(WT + (size_t)(n0 + n) * K + k0 + 8 * c) = o; }
    asm volatile("s_waitcnt lgkmcnt(0)" ::: "memory");
    if (more) {
#pragma unroll
      for (int i = 0; i < 32; ++i) cur[i] = nxt[i]; }
  }
#undef TS_LOAD
}
__device__ __forceinline__ void rms_row(const float* xrow, const float* gain, bf16* orow, int lane) {
  f32x4 v[8]; float s = 0.f;
#pragma unroll
  for (int j = 0; j < 8; ++j) { v[j] = *((const f32x4*)xrow + lane + 64 * j); s += (v[j].x * v[j].x + v[j].y * v[j].y) + (v[j].z * v[j].z + v[j].w * v[j].w); }
  const float rstd = 1.0f / sqrtf(grp_sum<64>(s) * (1.f / DM) + EPS);
#pragma unroll
  for (int j = 0; j < 8; ++j) { const f32x4 g = *((const f32x4*)gain + lane + 64 * j); v2u w; w.x = cvtpk2(v[j].x * rstd * g.x, v[j].y * rstd * g.y); w.y = cvtpk2(v[j].z * rstd * g.z, v[j].w * rstd * g.w);
    *((v2u*)orow + lane + 64 * j) = w; }
}
__device__ __forceinline__ void norm_phase(const Ctx& c, const float* x, const float* gain, bf16* xn) {
  for (int m = c.gw; m < T; m += c.NGW) rms_row(x + (size_t)m * DM, gain, xn + (size_t)m * DM, c.lane);
}
__device__ __forceinline__ f32x2 sincos_rev(float ang) {
  double fr = (double)ang * 0.15915494309189533577; fr -= rint(fr); const float f = (float)fr;
  return (f32x2){__builtin_amdgcn_cosf(f), __builtin_amdgcn_sinf(f)};
}

__device__ __forceinline__ void prologue(const Ctx& c, const Args& a, LAS unsigned char* lds) {
  LAS float* scr = (LAS float*)(lds + c.wave * 16384);
  unsigned char* ws = c.ws;
  int base = 0;
#define DO_W(inidx, K_, N_, off, srcoff, gain_) do { const int items = ((K_) / 64) * ((N_) / 32); const float* W = a.in[inidx] + (srcoff); bf16* WT = (bf16*)(ws + (off)); \
    const int first = (c.gw - (base % c.NGW) + c.NGW) % c.NGW; \
    transpose_stream(W, (K_), (N_), WT, scr, first, items, c.NGW, c.lane, (gain_)); \
    base += items; } while (0)
  DO_W(2, DM, EVEN_IN, WS_WIN, 0, nullptr); DO_W(5, 512, 1536, WS_WUQ, 0, nullptr); DO_W(6, 256, 2048, WS_WUKV, 0, nullptr); DO_W(12, DM, DM, WS_WOE, 0, nullptr);
  DO_W(20, DM, DFF, WS_WUP, 0, a.in[19]); DO_W(21, DFF, DM, WS_WDN, 0, nullptr);
  DO_W(14, DM, ODD_IN, WS_WQKV, 0, a.in[13]); DO_W(18, DM, DM, WS_WOO, 0, nullptr);
#undef DO_W
  { v4u* z = (v4u*)((bf16*)(ws + WS_WIN) + (size_t)EVEN_IN * DM); const int n16 = (EVEN_IN_P - EVEN_IN) * DM / 8;
    for (int i = c.gw * 64 + c.lane; i < n16; i += c.NGW * 64) z[i] = (v4u){0u, 0u, 0u, 0u}; }
  { f32x2* tm = (f32x2*)(ws + WS_TMLA); f32x2* ta = (f32x2*)(ws + WS_TAX); f32x2* tsw = (f32x2*)(ws + WS_TSWA);
    const int gt = c.gw * 64 + c.lane, NT_ = c.NGW * 64;
    for (int i = gt; i < SEQ * 32; i += NT_) { const int s = i >> 5, f = i & 31; tm[i] = sincos_rev((float)s * a.inv_mla[f]); }
    for (int i = gt; i < SEQ * 64; i += NT_) { const int s = i >> 6, f = i & 63; const int pos = (f < 32) ? (s >> 6) : (s & 63); ta[i] = sincos_rev((float)pos * a.inv_ax[f & 31]); }
    for (int i = gt; i < SEQ * 8; i += NT_) { const int s = i >> 3, f = i & 7; tsw[i] = sincos_rev((float)s * a.inv_swa[f]); } }
  norm_phase(c, a.in[0], a.in[1], (bf16*)(ws + WS_XN));
}

__device__ __forceinline__ void convert_layer1(const Ctx& c, const Args& a, LAS unsigned char* lds) {
  LAS float* scr = (LAS float*)(lds + c.wave * 16384);
  unsigned char* ws = c.ws;
  int base = 0;
#define DO_W(inidx, K_, N_, off, srcoff, gain_) do { const int items = ((K_) / 64) * ((N_) / 32); const float* W = a.in[inidx] + (srcoff); bf16* WT = (bf16*)(ws + (off)); \
    const int first = (c.gw - (base % c.NGW) + c.NGW) % c.NGW; \
    transpose_stream(W, (K_), (N_), WT, scr, first, items, c.NGW, c.lane, (gain_)); \
    base += items; } while (0)
  DO_W(20, DM, DFF, WS_WUP, (size_t)DM * DFF, a.in[19] + DM); DO_W(21, DFF, DM, WS_WDN, (size_t)DM * DFF, nullptr);
#undef DO_W
}
__device__ __forceinline__ void post_proj(const Ctx& c, const Args& a) {
  unsigned char* ws = c.ws; const int l = c.lane;
  const bf16* PROJ = (const bf16*)(ws + WS_PROJ);
  bf16* CQN = (bf16*)(ws + WS_CQN); bf16* CKVN = (bf16*)(ws + WS_CKVN); bf16* KR = (bf16*)(ws + WS_KR);
  bf16* QG = (bf16*)(ws + WS_QG); bf16* KG = (bf16*)(ws + WS_KG); bf16* VG = (bf16*)(ws + WS_VG);
  const f32x2* tm = (const f32x2*)(ws + WS_TMLA); const f32x2* ta = (const f32x2*)(ws + WS_TAX);
  const float* g_qlat = a.in[3]; const float* g_kvlat = a.in[4]; const float* g_krope = a.in[9]; const float* g_gq = a.in[10]; const float* g_gk = a.in[11];
  for (int t = c.gw; t < T; t += c.NGW) {
    const int b = t / SEQ, s = t % SEQ; const bf16* pr = PROJ + (size_t)t * EVEN_IN_P;
    float v[8], o[8];
    { ld8(pr + 8 * l, v); const float rstd = 1.0f / sqrtf(grp_sum<64>(sumsq8(v)) * (1.f / 512) + EPS);
#pragma unroll
      for (int j = 0; j < 8; ++j) o[j] = v[j] * rstd * g_qlat[8 * l + j];
      st8(CQN + (size_t)t * 512 + 8 * l, o); }
    { const bool act = l < 40; if (act) ld8(pr + 512 + 8 * l, v); else {
#pragma unroll
        for (int j = 0; j < 8; ++j) v[j] = 0.f; }
      float ss = grp_sum<8>(sumsq8(v)); const float ss8 = ss; ss += __shfl_xor(ss, 8); ss += __shfl_xor(ss, 16);
      if (l < 32) { const float rstd = 1.0f / sqrtf(ss * (1.f / 256) + EPS);
#pragma unroll
        for (int j = 0; j < 8; ++j) o[j] = v[j] * rstd * g_kvlat[8 * l + j];
        st8(CKVN + (size_t)t * 256 + 8 * l, o); }
      const int lr = l & 7; const float rstd8 = 1.0f / sqrtf(ss8 * (1.f / 64) + EPS); float nv[8], pv_[8];
#pragma unroll
      for (int j = 0; j < 8; ++j) nv[j] = v[j] * rstd8 * g_krope[(8 * lr + j) & 63];
#pragma unroll
      for (int j = 0; j < 8; ++j) pv_[j] = __shfl_xor(nv[j], 4);
      if (l >= 32 && l < 40) {
#pragma unroll
        for (int j = 0; j < 8; ++j) { const f32x2 cs = tm[s * 32 + 8 * (lr & 3) + j]; o[j] = (lr & 4) ? (nv[j] * cs.x + pv_[j] * cs.y) : (nv[j] * cs.x - pv_[j] * cs.y); }
        st8(KR + (size_t)t * 64 + 8 * lr, o); } }
#pragma unroll
    for (int pass = 0; pass < 3; ++pass) {
      const int hl = l >> 4, ll = l & 15;
      ld8(pr + 832 + pass * 512 + 8 * l, v);
      const float rstd = 1.0f / sqrtf(grp_sum<16>(sumsq8(v)) * (1.f / 128) + EPS);
      const float* g = (pass < 2) ? g_gq : g_gk; float nv[8], pv_[8];
#pragma unroll
      for (int j = 0; j < 8; ++j) nv[j] = v[j] * rstd * g[8 * ll + j];
#pragma unroll
      for (int j = 0; j < 8; ++j) pv_[j] = __shfl_xor(nv[j], 4);
#pragma unroll
      for (int j = 0; j < 8; ++j) { const f32x2 cs = ta[s * 64 + ((ll & 8) ? 32 : 0) + 8 * (ll & 3) + j]; o[j] = (ll & 4) ? (nv[j] * cs.x + pv_[j] * cs.y) : (nv[j] * cs.x - pv_[j] * cs.y); }
      if (pass < 2) st8(QG + ((size_t)(b * 8 + pass * 4 + hl) * SEQ + s) * 128 + 8 * ll, o);
      else if (hl < 2) st8(KG + ((size_t)(b * 2 + hl) * SEQ + s) * 128 + 8 * ll, o);
      else st8(VG + ((size_t)(b * 2 + (hl - 2)) * SEQ + s) * 128 + 8 * ll, v);
    }
  }
}
__device__ __forceinline__ void post_mla(const Ctx& c, const Args& a) {
  unsigned char* ws = c.ws; const int l = c.lane, hl = l >> 4, ll = l & 15;
  const bf16* QAR = (const bf16*)(ws + WS_QAR); const bf16* KVR = (const bf16*)(ws + WS_KVR); const bf16* KR = (const bf16*)(ws + WS_KR);
  bf16* QA = (bf16*)(ws + WS_QA); bf16* KA = (bf16*)(ws + WS_KA); bf16* VA = (bf16*)(ws + WS_VA);
  const f32x2* tm = (const f32x2*)(ws + WS_TMLA);
  const float* g_q = a.in[7]; const float* g_kn = a.in[8];
  for (int t = c.gw; t < T; t += c.NGW) {
    const int b = t / SEQ, s = t % SEQ;
#pragma unroll
    for (int pass = 0; pass < 2; ++pass) {
      const int h = pass * 4 + hl;
      {
        const bf16* q = QAR + (size_t)t * 1536 + h * 192; float v[8], r[4], o[8], ro[4];
        ld8(q + 8 * ll, v); ld4(q + 128 + 4 * ll, r);
        float ss = sumsq8(v) + (r[0] * r[0] + r[1] * r[1]) + (r[2] * r[2] + r[3] * r[3]);
        const float rstd = 1.0f / sqrtf(grp_sum<16>(ss) * (1.f / 192) + EPS);
#pragma unroll
        for (int j = 0; j < 8; ++j) o[j] = v[j] * rstd * g_q[8 * ll + j];
        float nr[4], pr_[4];
#pragma unroll
        for (int j = 0; j < 4; ++j) nr[j] = r[j] * rstd * g_q[128 + 4 * ll + j];
#pragma unroll
        for (int j = 0; j < 4; ++j) pr_[j] = __shfl_xor(nr[j], 8);
#pragma unroll
        for (int j = 0; j < 4; ++j) { const f32x2 cs = tm[s * 32 + 4 * (ll & 7) + j]; ro[j] = (ll & 8) ? (nr[j] * cs.x + pr_[j] * cs.y) : (nr[j] * cs.x - pr_[j] * cs.y); }
        bf16* qo = QA + ((size_t)(b * 8 + h) * SEQ + s) * 192; st8(qo + 8 * ll, o); st4(qo + 128 + 4 * ll, ro); }
      {
        const bf16* kv = KVR + (size_t)t * 2048 + h * 256; float v[8], o[8];
        ld8(kv + 8 * ll, v);
        const float rstd = 1.0f / sqrtf(grp_sum<16>(sumsq8(v)) * (1.f / 128) + EPS);
#pragma unroll
        for (int j = 0; j < 8; ++j) o[j] = v[j] * rstd * g_kn[8 * ll + j];
        bf16* ko = KA + ((size_t)(b * 8 + h) * SEQ + s) * 192; st8(ko + 8 * ll, o);
        *(v2u*)(ko + 128 + 4 * ll) = *(const v2u*)(KR + (size_t)t * 64 + 4 * ll);
        *(v4u*)(VA + ((size_t)(b * 8 + h) * SEQ + s) * 128 + 8 * ll) = *(const v4u*)(kv + 128 + 8 * ll); }
    }
  }
}
__device__ __forceinline__ void post_qkv(const Ctx& c, const Args& a) {
  unsigned char* ws = c.ws; const int l = c.lane, hl = l >> 3, ll = l & 7;
  const bf16* QKV = (const bf16*)(ws + WS_PROJ);
  bf16* SQ = (bf16*)(ws + WS_SQ); bf16* SK = (bf16*)(ws + WS_SK); bf16* SV = (bf16*)(ws + WS_SV);
  const f32x2* tsw = (const f32x2*)(ws + WS_TSWA);
  const float* g_q = a.in[15]; const float* g_k = a.in[16];
  for (int t = c.gw; t < T; t += c.NGW) {
    const int b = t / SEQ, s = t % SEQ; const bf16* pr = QKV + (size_t)t * ODD_IN;
#pragma unroll
    for (int pass = 0; pass < 5; ++pass) {
      float v[8], o[8], nv[8], pv_[8];
      ld8(pr + pass * 512 + 8 * l, v);
      const float rstd = 1.0f / sqrtf(grp_sum<8>(sumsq8(v)) * (1.f / 64) + EPS);
      const float* g = (pass < 4) ? g_q : g_k;
#pragma unroll
      for (int j = 0; j < 8; ++j) nv[j] = v[j] * rstd * g[8 * ll + j];
#pragma unroll
      for (int j = 0; j < 8; ++j) pv_[j] = __shfl_xor(nv[j], 1);
#pragma unroll
      for (int j = 0; j < 8; ++j) { const f32x2 cs = tsw[s * 8 + j]; o[j] = (ll >= 2) ? nv[j] : ((ll & 1) ? (nv[j] * cs.x + pv_[j] * cs.y) : (nv[j] * cs.x - pv_[j] * cs.y)); }
      if (pass < 4) st8(SQ + ((size_t)(b * 32 + pass * 8 + hl) * SEQ + s) * 64 + 8 * ll, o);
      else if (hl < 4) st8(SK + ((size_t)(b * 4 + hl) * SEQ + s) * 64 + 8 * ll, o);
      else st8(SV + ((size_t)(b * 4 + (hl - 4)) * SEQ + s) * 64 + 8 * ll, v);
    }
  }
}

#ifdef NO_GEMM
#define GEMM_PHASE(EPI_T, epi, Aoff, Boff, N_, K_) do { (void)(epi); } while (0)
#else
#define GEMM_PHASE(EPI_T, epi, Aoff, Boff, N_, K_) do { \
    pg8::Gemm g_{(const pg8::bf16_t*)(ws + (Aoff)), (const pg8::bf16_t*)(ws + (Boff)), T, (N_), (K_)}; pg8::StaticOrder S_; S_.init(T, (N_), c.G, (int)blockIdx.x); \
    pg8::gemm_phase<EPI_T, pg8::StaticOrder, true, true>(ldsl, g_, S_, (epi)); } while (0)
#endif

#ifndef REP_THIN2
#define REP_THIN2 1
#endif
#ifndef REP_THIN3
#define REP_THIN3 1
#endif
#ifndef REP_SWA
#define REP_SWA 1
#endif
#ifndef REP_PRO
#define REP_PRO 1
#endif
#ifndef REP_THIN
#define REP_THIN 1
#endif
#ifndef REP_MLA
#define REP_MLA 1
#endif
#ifndef REP_GQA
#define REP_GQA 1
#endif
#ifndef REP_UP
#define REP_UP 1
#endif
__global__ void __launch_bounds__(NWAVES * 64, 2) fwd_megakernel(Args a) {
  extern __shared__ __attribute__((aligned(16))) unsigned char lds[];
#ifdef NO_SYNC
  struct { __device__ void sync() const { __syncthreads(); } } grid;
#else
  cg::grid_group grid = cg::this_grid();
#endif
  LAS unsigned char* ldsl = (LAS unsigned char*)lds;
#define MKCTX() do { int t_ = threadIdx.x; asm volatile("" : "+v"(t_)); c.lane = t_ & 63; c.wave = __builtin_amdgcn_readfirstlane(t_ >> 6); c.G = gridDim.x; \
    { const int bx = blockIdx.x; c.vcu = (c.G % 8 == 0) ? (bx % 8) * (c.G / 8) + bx / 8 : bx; } \
    c.gw = blockIdx.x * NWAVES + c.wave; c.NGW = c.G * NWAVES; c.ws = a.ws; } while (0)
  Ctx c; MKCTX();
  volatile LAS unsigned* bst = (volatile LAS unsigned*)(ldsl + 131072 + 512);
  if (threadIdx.x < 2) bst[threadIdx.x] = 0u;
  __syncthreads();
  XcdBarrier xbar = xcd_barrier_post((unsigned*)a.ws, bst);
#ifdef USE_CG_ALL
#define SEAM() do { grid.sync(); MKCTX(); } while (0)
#else
#define SEAM() do { xcd_barrier(xbar); MKCTX(); } while (0)
#endif
  unsigned char* ws = a.ws;
  float* X = a.out; float* RSS = (float*)(a.ws + WS_ROWSS);

#ifndef NO_PRO
  prologue(c, a, ldsl);

#endif
  grid.sync(); MKCTX();
  { pg8::EpiB<0> E{(pg8::bf16_t*)(ws + WS_PROJ), EVEN_IN_P, nullptr, 0.f, 0.f}; GEMM_PHASE(pg8::EpiB<0>, E, WS_XN, WS_WIN, EVEN_IN_P, DM); }
  SEAM();
#ifndef NO_POST
  for (int rep = 0; rep < REP_THIN; ++rep) { MKCTX(); post_proj(c, a); }
#endif
  SEAM();
  { pg8::EpiB<0> E{(pg8::bf16_t*)(ws + WS_QAR), 1536, nullptr, 0.f, 0.f}; GEMM_PHASE(pg8::EpiB<0>, E, WS_CQN, WS_WUQ, 1536, 512); }
  { pg8::EpiB<0> E{(pg8::bf16_t*)(ws + WS_KVR), 2048, nullptr, 0.f, 0.f}; GEMM_PHASE(pg8::EpiB<0>, E, WS_CKVN, WS_WUKV, 2048, 256); }
  SEAM();
#ifndef NO_POST
  for (int rep = 0; rep < REP_THIN2; ++rep) { MKCTX(); post_mla(c, a); }
#endif
  SEAM();
  {
    constexpr float L2E = 1.4426950408889634f;
    const int nper = (512 + c.G - 1) / c.G;
    for (int rep = 0; rep < REP_MLA; ++rep)
    for (int i = 0; i < nper; ++i) {
      const int u = c.vcu * nper + i; if (u >= 512) break;
      int tid = threadIdx.x; asm volatile("" : "+v"(tid)); const int wid = tid >> 6, lane = tid & 63, r32 = lane & 31;
      const int bh = u >> 5, qb = u & 31, b = bh >> 3, h = bh & 7;
      const float sc = 0.07216878364870322f;
      const att::bf16* Q = (const att::bf16*)(ws + WS_QA) + ((size_t)bh * SEQ + qb * 256 + wid * 32 + r32) * 192;
      const att::bf16* K = (const att::bf16*)(ws + WS_KA) + (size_t)bh * SEQ * 192;
      const att::bf16* V = (const att::bf16*)(ws + WS_VA) + (size_t)bh * SEQ * 128;
      att::bf16* O = (att::bf16*)(ws + WS_MRG) + ((size_t)b * SEQ + qb * 256 + wid * 32) * 2048 + h * 128;
#ifndef NO_A192
      att::attn_unit<192, 128, false, false, 1>(Q, K, V, O, 2048, 0, SEQ / 64, 0, SEQ, 0, -1e30f, 0.f, sc * L2E, 8.f / sc, (char*)lds);
#endif
    }
    for (int rep = 0; rep < REP_GQA; ++rep)
    for (int i = 0; i < nper; ++i) {
      const int u = c.vcu * nper + i; if (u >= 512) break;
      int tid = threadIdx.x; asm volatile("" : "+v"(tid)); const int wid = tid >> 6, lane = tid & 63, r32 = lane & 31;
      const int bh = u >> 5, qb = u & 31, b = bh >> 3, h = bh & 7, kvh = h >> 2;
      const float sc = 0.08838834764831845f;
      const att::bf16* Q = (const att::bf16*)(ws + WS_QG) + ((size_t)bh * SEQ + qb * 256 + wid * 32 + r32) * 128;
      const att::bf16* K = (const att::bf16*)(ws + WS_KG) + (size_t)(b * 2 + kvh) * SEQ * 128;
      const att::bf16* V = (const att::bf16*)(ws + WS_VG) + (size_t)(b * 2 + kvh) * SEQ * 128;
      att::bf16* O = (att::bf16*)(ws + WS_MRG) + ((size_t)b * SEQ + qb * 256 + wid * 32) * 2048 + 1024 + h * 128;
#ifndef NO_A128
      att::attn_unit<128, 128, false, false, 2>(Q, K, V, O, 2048, 0, SEQ / 64, 0, SEQ, 0, -1e30f, 0.f, sc * L2E, 8.f / sc, (char*)lds);
#endif
    }
  }
  SEAM();
  { pg8::EpiResN E{a.in[0], X, (pg8::bf16_t*)(ws + WS_XN), RSS, DM}; GEMM_PHASE(pg8::EpiResN, E, WS_MRG, WS_WOE, DM, DM); }
  SEAM();
  { pg8::EpiB<2> E{(pg8::bf16_t*)(ws + WS_U), DFF, RSS, 1.f / DM, EPS}; GEMM_PHASE(pg8::EpiB<2>, E, WS_XN, WS_WUP, DFF, DM); }
#if REP_UP > 1
  MKCTX(); { pg8::EpiB<2> E{(pg8::bf16_t*)(ws + WS_U), DFF, RSS, 1.f / DM, EPS}; GEMM_PHASE(pg8::EpiB<2>, E, WS_XN, WS_WUP, DFF, DM); }
#endif
  SEAM();
#ifdef REP_DN
  { pg8::EpiB<0> E{(pg8::bf16_t*)(ws + AB + 256 * MiB), DM, nullptr, 0.f, 0.f}; GEMM_PHASE(pg8::EpiB<0>, E, WS_U, WS_WDN, DM, DFF); } MKCTX();
#endif
  { pg8::EpiResN E{X, X, (pg8::bf16_t*)(ws + WS_XN), RSS + T, DM}; GEMM_PHASE(pg8::EpiResN, E, WS_U, WS_WDN, DM, DFF); }
  SEAM();
  { pg8::EpiB<0> E{(pg8::bf16_t*)(ws + WS_PROJ), ODD_IN, RSS + T, 1.f / DM, EPS}; GEMM_PHASE(pg8::EpiB<0>, E, WS_XN, WS_WQKV, ODD_IN, DM); }
  SEAM();
#ifndef NO_POST
  for (int rep = 0; rep < REP_THIN3; ++rep) { MKCTX(); post_qkv(c, a); }
#endif
#ifndef NO_PRO
  MKCTX(); convert_layer1(c, a, ldsl);
#endif
  SEAM();
  {
    constexpr float L2E = 1.4426950408889634f; const float sc = 0.125f;
    const int nper = (2048 + c.G - 1) / c.G;
    for (int rep = 0; rep < REP_SWA; ++rep)
    for (int i = 0; i < nper; ++i) {
      const int u = c.vcu * nper + i; if (u >= 2048) break;
      int tid = threadIdx.x; asm volatile("" : "+v"(tid)); const int wid = tid >> 6, lane = tid & 63, r32 = lane & 31;
      const int b = u >> 10, kvh = (u >> 8) & 3, rb = u & 255, h = kvh * 8 + wid;
      const att::bf16* Q = (const att::bf16*)(ws + WS_SQ) + ((size_t)(b * 32 + h) * SEQ + rb * 32 + r32) * 64;
      const att::bf16* K = (const att::bf16*)(ws + WS_SK) + (size_t)(b * 4 + kvh) * SEQ * 64;
      const att::bf16* V = (const att::bf16*)(ws + WS_SV) + (size_t)(b * 4 + kvh) * SEQ * 64;
      att::bf16* O = (att::bf16*)(ws + WS_MRG) + ((size_t)b * SEQ + rb * 32) * 2048 + h * 64;
      const float sink = a.in[17][h];
#ifndef NO_A64
      att::swa_unit<5>(Q, K, V, O, 2048, rb * 32 - 128, rb * 32 + r32, SEQ, 128, sink / sc, sc * L2E, 8.f / sc, (char*)lds);
#endif
    }
  }
  SEAM();
  { pg8::EpiResN E{X, X, (pg8::bf16_t*)(ws + WS_XN), RSS + 2 * T, DM}; GEMM_PHASE(pg8::EpiResN, E, WS_MRG, WS_WOO, DM, DM); }
  SEAM();
  { pg8::EpiB<2> E{(pg8::bf16_t*)(ws + WS_U), DFF, RSS + 2 * T, 1.f / DM, EPS}; GEMM_PHASE(pg8::EpiB<2>, E, WS_XN, WS_WUP, DFF, DM); }
#if REP_UP > 1
  MKCTX(); { pg8::EpiB<2> E{(pg8::bf16_t*)(ws + WS_U), DFF, RSS + 2 * T, 1.f / DM, EPS}; GEMM_PHASE(pg8::EpiB<2>, E, WS_XN, WS_WUP, DFF, DM); }
#endif
  SEAM();
#ifdef REP_DN
  { pg8::EpiB<0> E{(pg8::bf16_t*)(ws + AB + 256 * MiB), DM, nullptr, 0.f, 0.f}; GEMM_PHASE(pg8::EpiB<0>, E, WS_U, WS_WDN, DM, DFF); } MKCTX();
#endif
  { pg8::EpiRes E{X, X, DM}; GEMM_PHASE(pg8::EpiRes, E, WS_U, WS_WDN, DM, DFF); }
}

#ifdef PROBE_PRO_KERNEL
__global__ void __launch_bounds__(NWAVES * 64, 2) probe_prologue(Args a) {
  extern __shared__ __attribute__((aligned(16))) unsigned char lds[];
  LAS unsigned char* ldsl = (LAS unsigned char*)lds;
  Ctx c; { int t_ = threadIdx.x; c.lane = t_ & 63; c.wave = __builtin_amdgcn_readfirstlane(t_ >> 6); c.G = gridDim.x; c.vcu = blockIdx.x; c.gw = blockIdx.x * NWAVES + c.wave; c.NGW = c.G * NWAVES; c.ws = a.ws; }
  prologue(c, a, ldsl);
  convert_layer1(c, a, ldsl);
}
#endif
extern "C" void kernel_launch(void* const* d_in, const int* in_sizes, int n_in, void* d_out, int out_size, void* d_ws, size_t ws_size, hipStream_t stream) {
  static int grid = 0;
  if (grid == 0) {
    if (n_in != 22 || out_size != T * DM || ws_size < WS_NEED) { fprintf(stderr, "kernel_launch: unexpected shapes: n_in %d out %d ws %zu (need %zu)\n", n_in, out_size, ws_size, (size_t)WS_NEED); grid = -1; return; }
    int dev = 0, cus = 0, per_cu = 0;
    (void)hipGetDevice(&dev); (void)hipDeviceGetAttribute(&cus, hipDeviceAttributeMultiprocessorCount, dev);
    if (LDS_BYTES > 0 && hipFuncSetAttribute((const void*)fwd_megakernel, hipFuncAttributeMaxDynamicSharedMemorySize, LDS_BYTES) != hipSuccess) { fprintf(stderr, "kernel_launch: hipFuncSetAttribute failed\n"); grid = -1; return; }
    if (hipOccupancyMaxActiveBlocksPerMultiprocessor(&per_cu, (const void*)fwd_megakernel, NWAVES * 64, LDS_BYTES) != hipSuccess || per_cu < 1) { fprintf(stderr, "kernel_launch: occupancy query says %d\n", per_cu); per_cu = 1; }
    (void)hipGetLastError();
    grid = cus * 1;
    fprintf(stderr, "kernel_launch: grid %d (cus %d, per_cu %d)\n", grid, cus, per_cu);
  }
  if (grid < 0) return;
  Args a; memset(&a, 0, sizeof(a));
  for (int i = 0; i < 22; ++i) a.in[i] = (const float*)d_in[i];
  a.out = (float*)d_out; a.ws = (unsigned char*)d_ws;
  for (int f = 0; f < 32; ++f) { a.inv_mla[f] = (float)pow((double)500000.0f, -(double)(2 * f) / 64.0); a.inv_ax[f] = (float)pow((double)10000.0f, -(double)(2 * f) / 64.0); }
  for (int f = 0; f < 8; ++f) a.inv_swa[f] = (float)pow((double)500000.0f, -(double)(2 * f) / 16.0);
  if (hipMemsetAsync(d_ws, 0, 512 * 1024, stream) != hipSuccess) { fprintf(stderr, "kernel_launch: memset failed\n"); return; }
#ifdef PROBE_PRO_KERNEL
  (void)hipFuncSetAttribute((const void*)probe_prologue, hipFuncAttributeMaxDynamicSharedMemorySize, LDS_BYTES);
  hipLaunchKernelGGL(probe_prologue, dim3(grid), dim3(NWAVES * 64), LDS_BYTES, stream, a);
#endif
  void* args[] = {&a};
#ifdef PROBE_PLAIN
  hipLaunchKernelGGL(fwd_megakernel, dim3(grid), dim3(NWAVES * 64), LDS_BYTES, stream, a); hipError_t e = hipPeekAtLastError();
#else
  hipError_t e = hipLaunchCooperativeKernel((const void*)fwd_megakernel, dim3(grid), dim3(NWAVES * 64), args, LDS_BYTES, stream);
#endif
  if (e != hipSuccess) fprintf(stderr, "kernel_launch: cooperative launch failed: %s (grid %d)\n", hipGetErrorString(e), grid);
}
```

```cpp
#include <hip/hip_runtime.h>
#include <hip/hip_cooperative_groups.h>
#include <cstdio>
#include <cstdint>
#include <cmath>
#include <cstring>
namespace cg = cooperative_groups;

namespace pg8 {
#define PG8_LAS __attribute__((address_space(3)))
typedef unsigned short bf16_t;
typedef short bf16x8 __attribute__((ext_vector_type(8)));
typedef float f32x4 __attribute__((ext_vector_type(4)));
typedef unsigned u32x4 __attribute__((ext_vector_type(4)));
constexpr int BM = 256, BK = 64, HALF = 128, HTB = HALF * BK * 2  , STAGE_BYTES = 8 * HTB, NXCD = 8, WGM = 8;

__host__ __device__ __forceinline__ int lds_byte(int r, int c) { const int st = (r >> 4) * 2 + (c >> 5), rr = r & 15, cc = c & 31, ob = rr * 64 + cc * 2; return st * 1024 + (ob ^ (((ob >> 9) & 1) << 5)); }
__host__ __device__ __forceinline__ void stage_rc(int b, int& R, int& C) { const int st = b / 1024, sb = b % 1024, swz = sb ^ (((sb >> 9) & 1) << 5); R = (st >> 1) * 16 + swz / 64; C = (st & 1) * 32 + (swz % 64) / 2; }
__host__ __device__ __forceinline__ int perm32(int rho) { const int n = rho >> 4, i = rho & 15; return 8 * (i >> 2) + 4 * n + (i & 3); }

struct Unit { int pm, pn; };
struct Gemm { const bf16_t* A; const bf16_t* Bt; int M, N, K; };

struct StaticOrder {
    int nM, nN, nwg, G, c;
    __host__ __device__ void init(int M, int N, int G_, int c_) { nM = M / BM; nN = N / BM; nwg = nM * nN; G = G_; c = c_; }
    __host__ __device__ bool next(int i, Unit& u) const {
        const long L = (long)i * G + c; if (L >= nwg) return false;
        int wgid = (int)L; { const int q = nwg / NXCD, r = nwg % NXCD, xcd = wgid % NXCD, off = wgid / NXCD; wgid = (xcd < r ? xcd * (q + 1) : r * (q + 1) + (xcd - r) * q) + off; }
        const int nig = WGM * nN, gid = wgid / nig, fm = gid * WGM, gsz = (nM - fm) < WGM ? (nM - fm) : WGM;
        u.pm = fm + ((wgid % nig) % gsz); u.pn = (wgid % nig) / gsz; return true;
    }
    __device__ __forceinline__ void a_ready(const Unit&) const {}
    __device__ __forceinline__ void done(const Unit&) const {}
};

__device__ __forceinline__ unsigned cvt_pk_bf16(float lo, float hi) { unsigned r; asm volatile("v_cvt_pk_bf16_f32 %0, %1, %2" : "=v"(r) : "v"(lo), "v"(hi)); return r; }
typedef float f32x2 __attribute__((ext_vector_type(2)));
__device__ __forceinline__ f32x2 gelu_pk(f32x2 v) {
    const f32x2 av = __builtin_elementwise_abs(v), d = av * 0.2316418882f + 1.0f;
    f32x2 t; t.x = __builtin_amdgcn_rcpf(d.x); t.y = __builtin_amdgcn_rcpf(d.y);
    f32x2 q = t * 0.5307027145f + (-0.7265760135f); q = q * t + 0.7107068705f; q = q * t + (-0.142248368f); q = q * t + 0.127414796f; q = q * t;
    const f32x2 s = (v * v) * (-0.72134752044f);
    f32x2 e; e.x = __builtin_amdgcn_exp2f(s.x); e.y = __builtin_amdgcn_exp2f(s.y);
    const f32x2 m = v * (q * e), r = v - m;
    f32x2 o; o.x = v.x < 0.f ? m.x : r.x; o.y = v.y < 0.f ? m.y : r.y; return o;
}

template <int ACT  > struct EpiBf16 {
    static constexpr bool PERM = true, AFTER_DRAIN = false; static_assert(ACT == 0 || ACT == 1, "EpiBf16: ACT is 0 (none) or 1 (gelu_pk)");
    bf16_t* O; int ldc; const float* bias; int split_cols; size_t split_stride; float scale0;
    __device__ __forceinline__ void operator()(const f32x4 (&acc)[2][2][4][2], const Unit& u, int wr, int wc, int fr, int fq) const {
        const int row0 = u.pm * BM + wr * 64 + fr; int colt = u.pn * BM; bf16_t* base = O;
        float sc = 1.f; if (split_cols) { const int t = colt / split_cols; base += (size_t)t * split_stride; colt -= t * split_cols; if (t == 0) sc = scale0; }
        const int col0 = colt + wc * 32 + 8 * fq, bcol0 = u.pn * BM + wc * 32 + 8 * fq;
        f32x4 bv[2][2];
#pragma unroll
        for (int bj = 0; bj < 2; ++bj)
#pragma unroll
            for (int n = 0; n < 2; ++n) bv[bj][n] = bias ? *(const f32x4*)(bias + bcol0 + bj * HALF + 4 * n) : (f32x4){0.f, 0.f, 0.f, 0.f};
#pragma unroll
        for (int ai = 0; ai < 2; ++ai)
#pragma unroll
            for (int m = 0; m < 4; ++m) { bf16_t* rowp = base + (size_t)(row0 + ai * HALF + m * 16) * ldc + col0;
#pragma unroll
                for (int bj = 0; bj < 2; ++bj) { f32x4 v0 = acc[ai][bj][m][0] + bv[bj][0], v1 = acc[ai][bj][m][1] + bv[bj][1];
                    if (ACT == 1) { f32x2 a = gelu_pk((f32x2){v0[0], v0[1]}), b = gelu_pk((f32x2){v0[2], v0[3]}), c = gelu_pk((f32x2){v1[0], v1[1]}), d = gelu_pk((f32x2){v1[2], v1[3]});
                        v0 = (f32x4){a.x, a.y, b.x, b.y}; v1 = (f32x4){c.x, c.y, d.x, d.y}; }
                    v0 = v0 * sc; v1 = v1 * sc; u32x4 w; w.x = cvt_pk_bf16(v0[0], v0[1]); w.y = cvt_pk_bf16(v0[2], v0[3]); w.z = cvt_pk_bf16(v1[0], v1[1]); w.w = cvt_pk_bf16(v1[2], v1[3]);
                    *(u32x4*)(rowp + bj * HALF) = w; } }
    }
};

template <int ACT  > struct EpiB {
    static constexpr bool PERM = true, AFTER_DRAIN = false;
    bf16_t* O; int ldc; const float* rowss; float inv_n, eps;
    __device__ __forceinline__ void operator()(const f32x4 (&acc)[2][2][4][2], const Unit& u, int wr, int wc, int fr, int fq) const {
        const int row0 = u.pm * BM + wr * 64 + fr; const int col0 = u.pn * BM + wc * 32 + 8 * fq;
#pragma unroll
        for (int ai = 0; ai < 2; ++ai)
#pragma unroll
            for (int m = 0; m < 4; ++m) { bf16_t* rowp = O + (size_t)(row0 + ai * HALF + m * 16) * ldc + col0;
                const float rs = rowss ? 1.0f / sqrtf(rowss[row0 + ai * HALF + m * 16] * inv_n + eps) : 1.0f;
#pragma unroll
                for (int bj = 0; bj < 2; ++bj) { f32x4 v0 = acc[ai][bj][m][0] * rs, v1 = acc[ai][bj][m][1] * rs;
                    if (ACT == 2) {
#pragma unroll
                        for (int e = 0; e < 4; ++e) { float a = fmaxf(v0[e], 0.f), b = fmaxf(v1[e], 0.f); v0[e] = a * a; v1[e] = b * b; } }
                    u32x4 w; w.x = cvt_pk_bf16(v0[0], v0[1]); w.y = cvt_pk_bf16(v0[2], v0[3]); w.z = cvt_pk_bf16(v1[0], v1[1]); w.w = cvt_pk_bf16(v1[2], v1[3]);
                    *(u32x4*)(rowp + bj * HALF) = w; } }
    }
};
struct EpiRes {
    static constexpr bool PERM = true, AFTER_DRAIN = false;
    const float* base; float* out; int ldc;
    __device__ __forceinline__ void operator()(const f32x4 (&acc)[2][2][4][2], const Unit& u, int wr, int wc, int fr, int fq) const {
        const int row0 = u.pm * BM + wr * 64 + fr; const int col0 = u.pn * BM + wc * 32 + 8 * fq;
#pragma unroll
        for (int ai = 0; ai < 2; ++ai)
#pragma unroll
            for (int m = 0; m < 4; ++m) { const size_t off = (size_t)(row0 + ai * HALF + m * 16) * ldc + col0;
#pragma unroll
                for (int bj = 0; bj < 2; ++bj)
#pragma unroll
                    for (int n = 0; n < 2; ++n) { const f32x4 b = *(const f32x4*)(base + off + bj * HALF + 4 * n); *(f32x4*)(out + off + bj * HALF + 4 * n) = b + acc[ai][bj][m][n]; } }
    }
};
struct EpiResN {
    static constexpr bool PERM = true, AFTER_DRAIN = false;
    const float* base; float* out; bf16_t* xn; float* rowss; int ldc;
    __device__ __forceinline__ void operator()(const f32x4 (&acc)[2][2][4][2], const Unit& u, int wr, int wc, int fr, int fq) const {
        const int row0 = u.pm * BM + wr * 64 + fr; const int col0 = u.pn * BM + wc * 32 + 8 * fq;
#pragma unroll
        for (int ai = 0; ai < 2; ++ai)
#pragma unroll
            for (int m = 0; m < 4; ++m) { const int row = row0 + ai * HALF + m * 16; const size_t off = (size_t)row * ldc + col0; float ss = 0.f;
#pragma unroll
                for (int bj = 0; bj < 2; ++bj) { f32x4 o[2];
#pragma unroll
                    for (int n = 0; n < 2; ++n) { const f32x4 b = *(const f32x4*)(base + off + bj * HALF + 4 * n); o[n] = b + acc[ai][bj][m][n]; *(f32x4*)(out + off + bj * HALF + 4 * n) = o[n];
                        ss += (o[n][0] * o[n][0] + o[n][1] * o[n][1]) + (o[n][2] * o[n][2] + o[n][3] * o[n][3]); }
                    u32x4 w; w.x = cvt_pk_bf16(o[0][0], o[0][1]); w.y = cvt_pk_bf16(o[0][2], o[0][3]); w.z = cvt_pk_bf16(o[1][0], o[1][1]); w.w = cvt_pk_bf16(o[1][2], o[1][3]);
                    *(u32x4*)(xn + off + bj * HALF) = w; }
                ss += __shfl_xor(ss, 16); ss += __shfl_xor(ss, 32);
                if (fq == 0) atomicAdd(rowss + row, ss); }
    }
};

template <class Epi, class Sched, bool ALIGN_EPI = false, bool SP2 = false>
__device__ __forceinline__ void gemm_phase(PG8_LAS unsigned char* lds, const Gemm g, const Sched& S, const Epi& E) {
    int tid = threadIdx.x; asm volatile("" : "+v"(tid));
    const int wid = __builtin_amdgcn_readfirstlane(tid >> 6), lane = tid & 63, wr = wid >> 2, wc = wid & 3, fr = lane & 15, fq = lane >> 4;
    const int K = g.K, nt = K / BK;
    unsigned voffA[2], voffB[2];
#pragma unroll
    for (int i = 0; i < 2; ++i) { int R, C; stage_rc(tid * 16 + i * 8192, R, C); const int Rb = Epi::PERM ? ((R & ~31) + perm32(R & 31)) : R;
        voffA[i] = (unsigned)(R * K + C) * 2u; voffB[i] = (unsigned)(Rb * K + C) * 2u; }
    const size_t kstep = (size_t)(BK * 2);
    const size_t hstep = (size_t)HALF * K * 2;
    const size_t tstep = 2 * hstep;
    const unsigned ldsw = (unsigned)wid * 1024u;
    const int aoff = lds_byte(wr * 64 + fr, fq * 8), boff = lds_byte(wc * 32 + fr, fq * 8);
#define PG8_SA(b, h) (((b) * 2 + (h)) * HTB)
#define PG8_SB(b, h) ((4 + (b) * 2 + (h)) * HTB)
#define PG8_STAGE(bufoff, gbase, voff) do { _Pragma("unroll") for (int _i = 0; _i < 2; ++_i) \
        __builtin_amdgcn_global_load_lds((const unsigned*)((const char*)(gbase) + (voff)[_i]), (PG8_LAS unsigned*)(lds + (bufoff) + ldsw + _i * 8192), 16, 0, 0); } while (0)
#define PG8_LDA(dst, b, h) do { _Pragma("unroll") for (int m = 0; m < 4; ++m) _Pragma("unroll") for (int k = 0; k < 2; ++k) dst[m][k] = *(const PG8_LAS bf16x8*)(lds + PG8_SA(b, h) + aoff + m * 2048 + k * 1024); } while (0)
#define PG8_LDB(dst, b, h) do { _Pragma("unroll") for (int n = 0; n < 2; ++n) _Pragma("unroll") for (int k = 0; k < 2; ++k) dst[n][k] = *(const PG8_LAS bf16x8*)(lds + PG8_SB(b, h) + boff + n * 2048 + k * 1024); } while (0)
#define PG8_MMA(ai, bj, At, Bt) do { __builtin_amdgcn_s_setprio(1); _Pragma("unroll") for (int m = 0; m < 4; ++m) _Pragma("unroll") for (int n = 0; n < 2; ++n) _Pragma("unroll") for (int k = 0; k < 2; ++k) \
        acc[ai][bj][m][n] = __builtin_amdgcn_mfma_f32_16x16x32_bf16(Bt[n][k], At[m][k], acc[ai][bj][m][n], 0, 0, 0); __builtin_amdgcn_s_setprio(0); } while (0)
#define PG8_WAIT_V(n) asm volatile("s_waitcnt vmcnt(" #n ")" ::: "memory")
#define PG8_WAIT_L(n) asm volatile("s_waitcnt lgkmcnt(" #n ")" ::: "memory")
#define PG8_BAR __builtin_amdgcn_s_barrier()
#define PG8_SCHED __builtin_amdgcn_sched_barrier(0)
    Unit cur, nxt; int ui = 0;
    if (!S.next(0, cur)) return;
    f32x4 acc[2][2][4][2];
#pragma unroll
    for (int a = 0; a < 2; ++a)
#pragma unroll
        for (int b = 0; b < 2; ++b)
#pragma unroll
            for (int m = 0; m < 4; ++m)
#pragma unroll
                for (int n = 0; n < 2; ++n) acc[a][b][m][n] = (f32x4){0.f, 0.f, 0.f, 0.f};
    bf16x8 At[4][2], B0[2][2], B1[2][2];
    const char* cA = (const char*)g.A + (size_t)cur.pm * tstep; const char* cB = (const char*)g.Bt + (size_t)cur.pn * tstep;
    S.a_ready(cur);
    if constexpr (SP2) {
        PG8_STAGE(PG8_SB(0, 0), cB, voffB); PG8_STAGE(PG8_SB(0, 1), cB + hstep, voffB); PG8_STAGE(PG8_SA(0, 0), cA, voffA); PG8_STAGE(PG8_SA(0, 1), cA + hstep, voffA);
        if (wr == 1) PG8_BAR;
        PG8_WAIT_V(2); PG8_BAR;
        PG8_STAGE(PG8_SB(1, 0), cB + kstep, voffB); PG8_STAGE(PG8_SA(1, 0), cA + kstep, voffA); PG8_STAGE(PG8_SB(1, 1), cB + hstep + kstep, voffB);
        PG8_WAIT_V(6); PG8_BAR;
    } else {
        PG8_STAGE(PG8_SB(0, 0), cB, voffB); PG8_STAGE(PG8_SA(0, 0), cA, voffA); PG8_STAGE(PG8_SB(0, 1), cB + hstep, voffB); PG8_STAGE(PG8_SA(0, 1), cA + hstep, voffA);
        if (wr == 1) PG8_BAR;
        PG8_WAIT_V(4); PG8_BAR;
        PG8_STAGE(PG8_SB(1, 0), cB + kstep, voffB); PG8_STAGE(PG8_SA(1, 0), cA + kstep, voffA); PG8_STAGE(PG8_SB(1, 1), cB + hstep + kstep, voffB);
        PG8_WAIT_V(6); PG8_BAR;
    }
    for (;;) {
        const bool has_next = S.next(ui + 1, nxt);
        const char* nA = has_next ? (const char*)g.A + (size_t)nxt.pm * tstep : cA; const char* nB = has_next ? (const char*)g.Bt + (size_t)nxt.pn * tstep : cB;
        for (int t = 0; t < nt; t += 2) {
            const bool last = (t == nt - 2);
            const char* a1 = cA + (size_t)(t + 1) * kstep;
            const char* a2 = last ? nA : cA + (size_t)(t + 2) * kstep; const char* b2 = last ? nB : cB + (size_t)(t + 2) * kstep;
            const char* a3 = a2 + kstep; const char* b3 = b2 + kstep;
            if (last && has_next) S.a_ready(nxt);
            if constexpr (SP2) {
            PG8_LDB(B0, 0, 0); PG8_LDB(B1, 0, 1); PG8_SCHED; PG8_LDA(At, 0, 0); PG8_STAGE(PG8_SA(1, 1), a1 + hstep, voffA);
            PG8_WAIT_V(8); PG8_WAIT_L(0); PG8_BAR; PG8_MMA(0, 0, At, B0); PG8_MMA(0, 1, At, B1); PG8_BAR; PG8_SCHED;
            PG8_LDA(At, 0, 1); PG8_STAGE(PG8_SB(0, 0), b2, voffB); PG8_STAGE(PG8_SB(0, 1), b2 + hstep, voffB); PG8_STAGE(PG8_SA(0, 0), a2, voffA);
            PG8_WAIT_V(8); PG8_WAIT_L(0); PG8_BAR; PG8_MMA(1, 0, At, B0); PG8_MMA(1, 1, At, B1); PG8_BAR; PG8_SCHED;
            PG8_LDB(B0, 1, 0); PG8_LDB(B1, 1, 1); PG8_SCHED; PG8_LDA(At, 1, 0); PG8_STAGE(PG8_SA(0, 1), a2 + hstep, voffA);
            PG8_WAIT_V(8); PG8_WAIT_L(0); PG8_BAR; PG8_MMA(0, 0, At, B0); PG8_MMA(0, 1, At, B1); PG8_BAR; PG8_SCHED;
            PG8_LDA(At, 1, 1); PG8_STAGE(PG8_SB(1, 0), b3, voffB); PG8_STAGE(PG8_SB(1, 1), b3 + hstep, voffB); PG8_STAGE(PG8_SA(1, 0), a3, voffA);
            PG8_WAIT_V(8); PG8_WAIT_L(0); PG8_BAR; PG8_MMA(1, 0, At, B0); PG8_MMA(1, 1, At, B1); PG8_BAR; PG8_SCHED;
            } else {
            PG8_LDB(B0, 0, 0); PG8_SCHED; PG8_LDA(At, 0, 0); PG8_STAGE(PG8_SA(1, 1), a1 + hstep, voffA);
            PG8_WAIT_L(8); PG8_BAR; PG8_WAIT_L(0); PG8_MMA(0, 0, At, B0); PG8_BAR; PG8_SCHED;
            PG8_LDB(B1, 0, 1); PG8_STAGE(PG8_SB(0, 0), b2, voffB);
            PG8_BAR; PG8_WAIT_L(0); PG8_MMA(0, 1, At, B1); PG8_BAR;
            PG8_LDA(At, 0, 1); PG8_STAGE(PG8_SA(0, 0), a2, voffA);
            PG8_BAR; PG8_WAIT_L(0); PG8_MMA(1, 0, At, B0); PG8_BAR; PG8_SCHED;
            PG8_STAGE(PG8_SB(0, 1), b2 + hstep, voffB);
            PG8_WAIT_V(6); PG8_BAR; PG8_MMA(1, 1, At, B1); PG8_BAR;
            PG8_LDB(B0, 1, 0); PG8_SCHED; PG8_LDA(At, 1, 0); PG8_STAGE(PG8_SA(0, 1), a2 + hstep, voffA);
            PG8_WAIT_L(8); PG8_BAR; PG8_WAIT_L(0); PG8_MMA(0, 0, At, B0); PG8_BAR; PG8_SCHED;
            PG8_LDB(B1, 1, 1); PG8_STAGE(PG8_SB(1, 0), b3, voffB);
            PG8_BAR; PG8_WAIT_L(0); PG8_MMA(0, 1, At, B1); PG8_BAR;
            PG8_LDA(At, 1, 1); PG8_STAGE(PG8_SA(1, 0), a3, voffA);
            PG8_BAR; PG8_WAIT_L(0); PG8_MMA(1, 0, At, B0); PG8_BAR; PG8_SCHED;
            PG8_STAGE(PG8_SB(1, 1), b3 + hstep, voffB);
            PG8_WAIT_V(6); PG8_BAR; PG8_MMA(1, 1, At, B1); PG8_BAR;
            }
        }
        if constexpr (ALIGN_EPI) { if (wr == 0) PG8_BAR; }
        if constexpr (!Epi::AFTER_DRAIN) { E(acc, cur, wr, wc, fr, fq); S.done(cur); }
        if (!has_next) break;
#pragma unroll
        for (int a = 0; a < 2; ++a)
#pragma unroll
            for (int b = 0; b < 2; ++b)
#pragma unroll
                for (int m = 0; m < 4; ++m)
#pragma unroll
                    for (int n = 0; n < 2; ++n) acc[a][b][m][n] = (f32x4){0.f, 0.f, 0.f, 0.f};
        cur = nxt; cA = nA; cB = nB; ++ui;
        if constexpr (ALIGN_EPI) { if (wr == 1) PG8_BAR; }
    }
    PG8_WAIT_V(0);
    if constexpr (!ALIGN_EPI) { if (wr == 0) PG8_BAR; }
    PG8_BAR;
    if constexpr (Epi::AFTER_DRAIN) { E.fused(acc, cur, wr, wc, fr, fq, lds, wid, lane); S.done(cur); }
#undef PG8_SA
#undef PG8_SB
#undef PG8_STAGE
#undef PG8_LDA
#undef PG8_LDB
#undef PG8_MMA
#undef PG8_WAIT_V
#undef PG8_WAIT_L
#undef PG8_BAR
#undef PG8_SCHED
}
}

namespace att {
typedef unsigned short bf16;
using bf16x8 = __attribute__((ext_vector_type(8))) short;
using s16x4  = __attribute__((ext_vector_type(4))) short;
using f32x16 = __attribute__((ext_vector_type(16))) float;
using u32x4  = __attribute__((ext_vector_type(4))) unsigned;
constexpr int NW = 8, QBLK = 32, KVBLK = 64;
#define SBAR() __builtin_amdgcn_sched_barrier(0)
__device__ __forceinline__ int crow(int r, int hi) { return (r & 3) + 8 * (r >> 2) + 4 * hi; }
__device__ __forceinline__ unsigned cvtpk(float lo, float hi) { unsigned r; asm volatile("v_cvt_pk_bf16_f32 %0, %1, %2" : "=v"(r) : "v"(lo), "v"(hi)); return r; }
template <int DK> __device__ __forceinline__ int kswz(int row, int colB) { const int f = (DK == 128) ? ((row & 7) | ((row & 16) >> 1)) : ((row >> 1) & 7); return row * (DK * 2) + (colB ^ (f << 4)); }

__device__ __forceinline__ void partialSM(f32x16& p0, f32x16& p1, float& m_reg, float& mn, float& alpha, const float C, const float thr_raw) {
  float pmax = p0[0];
#pragma unroll
  for (int r = 1; r < 16; ++r) pmax = fmaxf(pmax, p0[r]);
#pragma unroll
  for (int r = 0; r < 16; ++r) pmax = fmaxf(pmax, p1[r]);
  { auto rr = __builtin_amdgcn_permlane32_swap(__float_as_uint(pmax), __float_as_uint(pmax), false, false);
    pmax = fmaxf(__uint_as_float(rr[0]), __uint_as_float(rr[1])); }
  if (__builtin_expect(__all(pmax - m_reg <= thr_raw), 1)) { mn = m_reg; alpha = 1.f; }
  else { mn = fmaxf(m_reg, pmax); alpha = __builtin_amdgcn_exp2f((m_reg - mn) * C); m_reg = mn; }
  float mnC = -mn * C;
#pragma unroll
  for (int r = 0; r < 16; ++r) p0[r] = fmaf(p0[r], C, mnC);
#pragma unroll
  for (int r = 0; r < 16; ++r) p1[r] = fmaf(p1[r], C, mnC);
#pragma unroll
  for (int r = 0; r < 16; ++r) p0[r] = __builtin_amdgcn_exp2f(p0[r]);
}
__device__ __forceinline__ void finishSM(f32x16& p0, f32x16& p1, float alpha, float& l_reg, bf16x8& pa0, bf16x8& pa1, bf16x8& pa2, bf16x8& pa3) {
#pragma unroll
  for (int r = 0; r < 16; ++r) p1[r] = __builtin_amdgcn_exp2f(p1[r]);
  float ps = 0;
#pragma unroll
  for (int r = 0; r < 16; ++r) ps += p0[r];
#pragma unroll
  for (int r = 0; r < 16; ++r) ps += p1[r];
  { auto rr = __builtin_amdgcn_permlane32_swap(__float_as_uint(ps), __float_as_uint(ps), false, false);
    ps = __uint_as_float(rr[0]) + __uint_as_float(rr[1]); }
  l_reg = l_reg * alpha + ps;
#define PK4(P, BASE, OUT) do { unsigned a0 = cvtpk(P[BASE + 0], P[BASE + 1]), a1 = cvtpk(P[BASE + 2], P[BASE + 3]);   \
    unsigned b0 = cvtpk(P[BASE + 4], P[BASE + 5]), b1 = cvtpk(P[BASE + 6], P[BASE + 7]);                              \
    auto r0 = __builtin_amdgcn_permlane32_swap(a0, b0, false, false); auto r1 = __builtin_amdgcn_permlane32_swap(a1, b1, false, false); \
    u32x4 w = {r0[0], r1[0], r0[1], r1[1]}; OUT = *reinterpret_cast<bf16x8*>(&w); } while (0)
  PK4(p0, 0, pa0); PK4(p0, 8, pa1); PK4(p1, 0, pa2); PK4(p1, 8, pa3);
#undef PK4
}
template <int DK, int GS> __device__ __forceinline__ void qkt(f32x16& p0, f32x16& p1, const char* Ks, const int (&kb)[4], const int (&kbx)[4], const bf16x8* qr) {
  constexpr int ND = DK / 16, NG = ND / GS;
  static_assert(ND % GS == 0, "group size");
  p0 = f32x16{}; p1 = f32x16{};
  bf16x8 fa[2][GS], fb[2][GS];
#define QK_RD(buf, g) do { _Pragma("unroll") for (int s_ = 0; s_ < GS; ++s_) { const int d0_ = (g) * GS + s_, e_ = d0_ & 3, gg_ = d0_ >> 2; \
      const int ko_ = (DK == 128) ? (gg_ ? kbx[e_] : kb[e_]) : (kb[e_] + gg_ * 128); \
      fa[buf][s_] = *reinterpret_cast<const bf16x8*>(Ks + ko_); fb[buf][s_] = *reinterpret_cast<const bf16x8*>(Ks + ko_ + 32 * DK * 2); } } while (0)
  QK_RD(0, 0);
#pragma unroll
  for (int g = 0; g < NG; ++g) {
    if (g + 1 < NG) { QK_RD((g + 1) & 1, g + 1); }
    SBAR();
#pragma unroll
    for (int s_ = 0; s_ < GS; ++s_) {
      p0 = __builtin_amdgcn_mfma_f32_32x32x16_bf16(fa[g & 1][s_], qr[g * GS + s_], p0, 0, 0, 0);
      p1 = __builtin_amdgcn_mfma_f32_32x32x16_bf16(fb[g & 1][s_], qr[g * GS + s_], p1, 0, 0, 0); }
    SBAR();
  }
#undef QK_RD
}
template <int NCB> __device__ __forceinline__ int v_st(int k, int c) { const int kk = (k & ~0xC) | ((k & 4) << 1) | ((k & 8) >> 1); return ((kk >> 3) * NCB + (c >> 5)) * 512 + ((kk & 7) * 32 + (c & 31)) * 2; }
__device__ __forceinline__ int v_rd_base(int lane) { return ((lane & 3) << 3) | (((lane >> 2) & 3) << 6) | (((lane >> 4) & 1) << 5) | (((lane >> 5) & 1) << 8); }
template <int OFF> __device__ __forceinline__ s16x4 tr_read(int vb) {
  s16x4 r; asm volatile("ds_read_b64_tr_b16 %0, %1 offset:%2" : "=&v"(r) : "v"(vb), "i"(OFF) : "memory"); return r;
}
template <int D0, int NCB> __device__ __forceinline__ void pv_one(f32x16& od, int vb, bf16x8 pa0, bf16x8 pa1, bf16x8 pa2, bf16x8 pa3) {
#define VOFF(ks, half) (D0 * 512 + (ks) * (1024 * NCB) + (half) * (512 * NCB))
  const s16x4 l0 = tr_read<VOFF(0, 0)>(vb), h0 = tr_read<VOFF(0, 1)>(vb), l1 = tr_read<VOFF(1, 0)>(vb), h1 = tr_read<VOFF(1, 1)>(vb);
  const s16x4 l2 = tr_read<VOFF(2, 0)>(vb), h2 = tr_read<VOFF(2, 1)>(vb), l3 = tr_read<VOFF(3, 0)>(vb), h3 = tr_read<VOFF(3, 1)>(vb);
#undef VOFF
  asm volatile("s_waitcnt lgkmcnt(0)" ::: "memory"); SBAR();
#define PK(L, H) (bf16x8){L[0], L[1], L[2], L[3], H[0], H[1], H[2], H[3]}
  od = __builtin_amdgcn_mfma_f32_32x32x16_bf16(pa0, PK(l0, h0), od, 0, 0, 0);
  od = __builtin_amdgcn_mfma_f32_32x32x16_bf16(pa1, PK(l1, h1), od, 0, 0, 0);
  od = __builtin_amdgcn_mfma_f32_32x32x16_bf16(pa2, PK(l2, h2), od, 0, 0, 0);
  od = __builtin_amdgcn_mfma_f32_32x32x16_bf16(pa3, PK(l3, h3), od, 0, 0, 0);
#undef PK
}
template <int NCB> __device__ __forceinline__ void pv_all(f32x16* o, int vb, bf16x8 pa0, bf16x8 pa1, bf16x8 pa2, bf16x8 pa3) {
  pv_one<0, NCB>(o[0], vb, pa0, pa1, pa2, pa3); pv_one<1, NCB>(o[1], vb, pa0, pa1, pa2, pa3);
  if constexpr (NCB == 4) { pv_one<2, NCB>(o[2], vb, pa0, pa1, pa2, pa3); pv_one<3, NCB>(o[3], vb, pa0, pa1, pa2, pa3); }
}

template <int DK, int DV, bool SWA, bool TWO, int GS>
__device__ __forceinline__ void attn_unit(const bf16* __restrict__ Qrow, const bf16* __restrict__ Kh, const bf16* __restrict__ Vh, bf16* __restrict__ Ow, const int ldo,
                                          const int kstart, const int NT, const int qpos, const int seq, const int win,
                                          const float m_init, const float l_init, const float C, const float thr_raw, char* lds) {
  constexpr int NCB = DV / 32, SHM_V = KVBLK * DV * 2, SHM_K = KVBLK * DK * 2, KCH = DK / 8, VCH = DV / 8, NKC = DK / 64, NVC = DV / 64;
  int tid = threadIdx.x; asm volatile("" : "+v"(tid));
  const int wid = tid >> 6, lane = tid & 63, r32 = lane & 31, hi = lane >> 5;
  char* V_lds = lds; char* K_lds = lds + 2 * SHM_V;
  float* ws = (float*)(lds + 2 * SHM_V + 2 * SHM_K) + wid * 64; float* li_l = ws; float* al_l = ws + 32;
  float m_reg = m_init, l_reg = l_init; f32x16 o[NCB]; bf16x8 qr[DK / 16];
#pragma unroll
  for (int d = 0; d < NCB; ++d) o[d] = f32x16{};
#pragma unroll
  for (int d0 = 0; d0 < DK / 16; ++d0) qr[d0] = *reinterpret_cast<const bf16x8*>(Qrow + d0 * 16 + hi * 8);
  unsigned koff[NKC], voff[NVC]; int kdst[NKC], vdst[NVC], krow0 = 0;
#pragma unroll
  for (int i = 0; i < NKC; ++i) { const int c = tid + 512 * i, row = c / KCH, col = (c % KCH) * 8; koff[i] = (unsigned)(row * DK + col) * 2u; kdst[i] = kswz<DK>(row, col * 2); if (i == 0) krow0 = row; }
#pragma unroll
  for (int i = 0; i < NVC; ++i) { const int c = tid + 512 * i, row = c / VCH, col = (c % VCH) * 8; voff[i] = (unsigned)(row * DV + col) * 2u; vdst[i] = v_st<NCB>(row, col); }
  const int vb0 = (int)(uintptr_t)V_lds + v_rd_base(lane);
  int kb[4], kbx[4];
#pragma unroll
  for (int e = 0; e < 4; ++e) { kb[e] = kswz<DK>(r32, (e * 16 + hi * 8) * 2); kbx[e] = kb[e] ^ 128; }
  bf16x8 ks[NKC], vs[NVC], ks2[NKC], vs2[NVC];
#define SLOADX(ks, vs, k0) do { if constexpr (SWA) { static_assert(!SWA || (NKC == 1 && NVC == 1 && DK == DV), "SWA path: one chunk per thread"); \
      const int kr_ = min(max((k0) + krow0, 0), seq - 1) - krow0; const char* Kt = (const char*)Kh + (long)kr_ * (DK * 2); const char* Vt = (const char*)Vh + (long)kr_ * (DV * 2); \
      vs[0] = *reinterpret_cast<const bf16x8*>(Vt + voff[0]); ks[0] = *reinterpret_cast<const bf16x8*>(Kt + koff[0]); } \
    else { const char* Kt = (const char*)Kh + (long)(k0) * (DK * 2); const char* Vt = (const char*)Vh + (long)(k0) * (DV * 2); \
      _Pragma("unroll") for (int i = 0; i < NVC; ++i) vs[i] = *reinterpret_cast<const bf16x8*>(Vt + voff[i]); \
      _Pragma("unroll") for (int i = 0; i < NKC; ++i) ks[i] = *reinterpret_cast<const bf16x8*>(Kt + koff[i]); } } while (0)
#define SWRITEX(ks, vs, b) do { _Pragma("unroll") for (int i = 0; i < NVC; ++i) *(bf16x8*)(V_lds + (b) * SHM_V + vdst[i]) = vs[i]; \
    _Pragma("unroll") for (int i = 0; i < NKC; ++i) *(bf16x8*)(K_lds + (b) * SHM_K + kdst[i]) = ks[i]; } while (0)
#define SLOAD(k0) SLOADX(ks, vs, k0)
#define SWRITE(b) SWRITEX(ks, vs, b)
#define SWAIT() asm volatile("s_waitcnt vmcnt(0)" ::: "memory")
#define RESC(a) do { if (__any((a) < 1.f)) { if (hi == 0) al_l[r32] = (a); asm volatile("s_waitcnt lgkmcnt(0)" ::: "memory"); \
    _Pragma("unroll") for (int d = 0; d < NCB; ++d) _Pragma("unroll") for (int r = 0; r < 16; ++r) o[d][r] *= al_l[crow(r, hi)]; } } while (0)
#define MASK(P0, P1, k0) do { if constexpr (SWA) { const int kb = (k0) + 4 * hi; \
    _Pragma("unroll") for (int r = 0; r < 16; ++r) { const int kv = kb + (r & 3) + 8 * (r >> 2); const int dq = qpos - kv; \
      if (!(dq <= win && dq >= -win && kv >= 0 && kv < seq)) P0[r] = -INFINITY; \
      const int kv2 = kv + 32, dq2 = qpos - kv2; if (!(dq2 <= win && dq2 >= -win && kv2 >= 0 && kv2 < seq)) P1[r] = -INFINITY; } } } while (0)
  f32x16 pA0, pA1, pB0, pB1; float mnA, mnB, alA, alB; bf16x8 pa0, pa1, pa2, pa3;
  if constexpr (TWO) {
  SLOAD(kstart); SWAIT(); SWRITE(0); __syncthreads();
  qkt<DK, GS>(pA0, pA1, K_lds, kb, kbx, qr); MASK(pA0, pA1, kstart); partialSM(pA0, pA1, m_reg, mnA, alA, C, thr_raw);
  SLOAD(kstart + KVBLK);
  SWAIT(); SWRITE(1); __syncthreads();
  for (int j = 1; j + 1 < NT; j += 2) {
    SBAR(); qkt<DK, GS>(pB0, pB1, K_lds + SHM_K, kb, kbx, qr);
    finishSM(pA0, pA1, alA, l_reg, pa0, pa1, pa2, pa3); SBAR();
    SLOAD(kstart + (j + 1) * KVBLK); SBAR();
    pv_all<NCB>(o, vb0, pa0, pa1, pa2, pa3); MASK(pB0, pB1, kstart + j * KVBLK); partialSM(pB0, pB1, m_reg, mnB, alB, C, thr_raw);
    __syncthreads(); SWAIT(); SWRITE(0);
    RESC(alB); __syncthreads();
    SBAR(); qkt<DK, GS>(pA0, pA1, K_lds, kb, kbx, qr);
    finishSM(pB0, pB1, alB, l_reg, pa0, pa1, pa2, pa3); SBAR();
    SLOAD(kstart + (j + 2) * KVBLK); SBAR();
    pv_all<NCB>(o, vb0 + SHM_V, pa0, pa1, pa2, pa3); MASK(pA0, pA1, kstart + (j + 1) * KVBLK); partialSM(pA0, pA1, m_reg, mnA, alA, C, thr_raw);
    __syncthreads(); SWAIT(); SWRITE(1);
    RESC(alA); __syncthreads();
  }
  SBAR(); qkt<DK, GS>(pB0, pB1, K_lds + SHM_K, kb, kbx, qr);
  finishSM(pA0, pA1, alA, l_reg, pa0, pa1, pa2, pa3); SBAR();
  pv_all<NCB>(o, vb0, pa0, pa1, pa2, pa3); MASK(pB0, pB1, kstart + (NT - 1) * KVBLK); partialSM(pB0, pB1, m_reg, mnB, alB, C, thr_raw);
  RESC(alB);
  finishSM(pB0, pB1, alB, l_reg, pa0, pa1, pa2, pa3); SBAR();
  pv_all<NCB>(o, vb0 + SHM_V, pa0, pa1, pa2, pa3);
  } else {
#define TILE(bsel, jj) do { SBAR(); qkt<DK, GS>(pA0, pA1, K_lds + (bsel) * SHM_K, kb, kbx, qr); MASK(pA0, pA1, kstart + (jj) * KVBLK); partialSM(pA0, pA1, m_reg, mnA, alA, C, thr_raw); \
      RESC(alA); finishSM(pA0, pA1, alA, l_reg, pa0, pa1, pa2, pa3); SBAR(); pv_all<NCB>(o, vb0 + (bsel) * SHM_V, pa0, pa1, pa2, pa3); SBAR(); } while (0)
    SLOADX(ks, vs, kstart); SBAR(); SLOADX(ks2, vs2, kstart + KVBLK); SBAR();
    SWRITEX(ks, vs, 0); SBAR();
    SLOADX(ks, vs, kstart + 2 * KVBLK); SBAR();
    __syncthreads();
    for (int j = 0; j < NT; j += 2) {
      TILE(0, j);
      SWRITEX(ks2, vs2, 1); SBAR();
      if (j + 3 < NT) { SLOADX(ks2, vs2, kstart + (j + 3) * KVBLK); } SBAR();
      __syncthreads();
      TILE(1, j + 1);
      if (j + 2 < NT) { SWRITEX(ks, vs, 0); SBAR(); if (j + 4 < NT) { SLOADX(ks, vs, kstart + (j + 4) * KVBLK); } SBAR(); }
      __syncthreads();
    }
#undef TILE
  }
  if (hi == 0) li_l[r32] = l_reg; asm volatile("s_waitcnt lgkmcnt(0)" ::: "memory");
  float rli[16];
#pragma unroll
  for (int r = 0; r < 16; ++r) rli[r] = __builtin_amdgcn_rcpf(li_l[crow(r, hi)]);
  __syncthreads();
  { bf16* stg = (bf16*)lds + wid * (QBLK * DV);
#pragma unroll
    for (int r = 0; r < 16; ++r) { const int orow = crow(r, hi);
#pragma unroll
      for (int d0 = 0; d0 < NCB; ++d0) stg[orow * DV + d0 * 32 + r32] = (bf16)(cvtpk(o[d0][r] * rli[r], 0.f) & 0xffffu); }
    asm volatile("s_waitcnt lgkmcnt(0)" ::: "memory");
#pragma unroll
    for (int i = 0; i < (QBLK * VCH) / 64; ++i) { const int idx = i * 64 + lane, row = idx / VCH, ch = idx % VCH;
      const u32x4 v = *(const u32x4*)(stg + row * DV + ch * 8); *(u32x4*)(Ow + (long)row * ldo + ch * 8) = v; } }
  __syncthreads();
#undef SLOAD
#undef SLOADX
#undef SWRITEX
#undef SWRITE
#undef SWAIT
#undef RESC
#undef MASK
}
template <int NT>
__device__ __forceinline__ void swa_unit(const bf16* __restrict__ Qrow, const bf16* __restrict__ Kh, const bf16* __restrict__ Vh, bf16* __restrict__ Ow, const int ldo,
                                         const int kstart, const int qpos, const int seq, const int win,
                                         const float m_init, const float C, const float thr_raw, char* lds) {
  constexpr int DK = 64, DV = 64, NCB = 2, SHM = KVBLK * 64 * 2, VCH = 8;
  int tid = threadIdx.x; asm volatile("" : "+v"(tid));
  const int wid = tid >> 6, lane = tid & 63, r32 = lane & 31, hi = lane >> 5;
  char* V_lds = lds; char* K_lds = lds + NT * SHM;
  float* ws = (float*)(lds + 2 * NT * SHM) + wid * 64; float* li_l = ws; float* al_l = ws + 32;
  float m_reg = m_init, l_reg = 1.f; f32x16 o[NCB]; bf16x8 qr[4];
  o[0] = f32x16{}; o[1] = f32x16{};
#pragma unroll
  for (int d0 = 0; d0 < 4; ++d0) qr[d0] = *reinterpret_cast<const bf16x8*>(Qrow + d0 * 16 + hi * 8);
  const int row = tid >> 3, col = (tid & 7) * 8;
  const int kdst = kswz<DK>(row, col * 2), vdst = v_st<NCB>(row, col);
  const int vb0 = (int)(uintptr_t)V_lds + v_rd_base(lane);
  int kb[4], kbx[4];
#pragma unroll
  for (int e = 0; e < 4; ++e) { kb[e] = kswz<DK>(r32, (e * 16 + hi * 8) * 2); kbx[e] = kb[e]; }
  bf16x8 ksr[NT], vsr[NT];
#pragma unroll
  for (int t = 0; t < NT; ++t) { const int kr = min(max(kstart + t * KVBLK + row, 0), seq - 1);
    ksr[t] = *reinterpret_cast<const bf16x8*>(Kh + (long)kr * DK + col); vsr[t] = *reinterpret_cast<const bf16x8*>(Vh + (long)kr * DV + col); }
#pragma unroll
  for (int t = 0; t < NT; ++t) { *(bf16x8*)(K_lds + t * SHM + kdst) = ksr[t]; *(bf16x8*)(V_lds + t * SHM + vdst) = vsr[t]; }
  __syncthreads();
  f32x16 p0, p1; float mn, al; bf16x8 pa0, pa1, pa2, pa3;
#pragma unroll
  for (int t = 0; t < NT; ++t) {
    const int k0 = kstart + t * KVBLK;
    SBAR(); qkt<DK, 2>(p0, p1, K_lds + t * SHM, kb, kbx, qr);
    { const int kbase = k0 + 4 * hi;
#pragma unroll
      for (int r = 0; r < 16; ++r) { const int kv = kbase + (r & 3) + 8 * (r >> 2); const int dq = qpos - kv;
        if (!(dq <= win && dq >= -win && kv >= 0 && kv < seq)) p0[r] = -INFINITY;
        const int kv2 = kv + 32, dq2 = qpos - kv2; if (!(dq2 <= win && dq2 >= -win && kv2 >= 0 && kv2 < seq)) p1[r] = -INFINITY; } }
    partialSM(p0, p1, m_reg, mn, al, C, thr_raw);
    if (__any(al < 1.f)) { if (hi == 0) al_l[r32] = al; asm volatile("s_waitcnt lgkmcnt(0)" ::: "memory");
#pragma unroll
      for (int d = 0; d < NCB; ++d)
#pragma unroll
        for (int r = 0; r < 16; ++r) o[d][r] *= al_l[crow(r, hi)]; }
    finishSM(p0, p1, al, l_reg, pa0, pa1, pa2, pa3); SBAR();
    pv_all<NCB>(o, vb0 + t * SHM, pa0, pa1, pa2, pa3);
  }
  if (hi == 0) li_l[r32] = l_reg; asm volatile("s_waitcnt lgkmcnt(0)" ::: "memory");
  float rli[16];
#pragma unroll
  for (int r = 0; r < 16; ++r) rli[r] = __builtin_amdgcn_rcpf(li_l[crow(r, hi)]);
  __syncthreads();
  { bf16* stg = (bf16*)lds + wid * (QBLK * DV);
#pragma unroll
    for (int r = 0; r < 16; ++r) { const int orow = crow(r, hi);
#pragma unroll
      for (int d0 = 0; d0 < NCB; ++d0) stg[orow * DV + d0 * 32 + r32] = (bf16)(cvtpk(o[d0][r] * rli[r], 0.f) & 0xffffu); }
    asm volatile("s_waitcnt lgkmcnt(0)" ::: "memory");
#pragma unroll
    for (int i = 0; i < (QBLK * VCH) / 64; ++i) { const int idx = i * 64 + lane, rw = idx / VCH, ch = idx % VCH;
      const u32x4 v = *(const u32x4*)(stg + rw * DV + ch * 8); *(u32x4*)(Ow + (long)rw * ldo + ch * 8) = v; } }
  __syncthreads();
}
#undef SBAR
}

#define LAS __attribute__((address_space(3)))
typedef unsigned short bf16;
typedef unsigned v4u __attribute__((ext_vector_type(4)));
typedef unsigned v2u __attribute__((ext_vector_type(2)));
typedef float f32x4 __attribute__((ext_vector_type(4)));
typedef float f32x2 __attribute__((ext_vector_type(2)));
constexpr int NWAVES = 8;
constexpr int BATCH = 2, SEQ = 8192, T = BATCH * SEQ, DM = 2048, DFF = 8192;
constexpr int EVEN_IN = 2368, EVEN_IN_P = 2560, ODD_IN = 2560;
constexpr float EPS = 1e-6f;
constexpr size_t MiB = 1u << 20;
constexpr size_t WS_WIN = 1 * MiB, WS_WUQ = 11 * MiB, WS_WUKV = 13 * MiB, WS_WOE = 14 * MiB, WS_WUP = 22 * MiB, WS_WDN = 54 * MiB;
constexpr size_t WS_WQKV = 487 * MiB, WS_WOO = 497 * MiB;
constexpr size_t WS_TMLA = 86 * MiB, WS_TAX = 88 * MiB, WS_TSWA = 92 * MiB;
constexpr size_t WS_XN = 93 * MiB;
constexpr size_t WS_ROWSS = 64 * 1024;
constexpr size_t AB = 157 * MiB;
constexpr size_t WS_MRG = AB;
constexpr size_t WS_U = AB;
constexpr size_t WS_PROJ = AB, WS_KVR = AB, WS_QAR = AB + 80 * MiB, WS_CQN = AB + 128 * MiB, WS_CKVN = AB + 144 * MiB, WS_KR = AB + 152 * MiB, WS_QG = AB + 154 * MiB,
                 WS_KG = AB + 186 * MiB, WS_VG = AB + 194 * MiB, WS_QA = AB + 202 * MiB, WS_KA = AB + 250 * MiB, WS_VA = AB + 298 * MiB;
constexpr size_t WS_SQ = AB + 80 * MiB, WS_SK = AB + 144 * MiB, WS_SV = AB + 152 * MiB;
constexpr size_t WS_END = AB + 330 * MiB;
static_assert(WS_END <= WS_WQKV && WS_WOO + 8 * MiB <= 512 * MiB && WS_U + 256 * MiB <= WS_WQKV, "workspace map");
constexpr size_t WS_NEED = 505 * MiB;
#ifdef PROBE_NOLDS
constexpr int LDS_BYTES = 0;
#else
constexpr int LDS_BYTES = 131072 + 1024;
#endif

__device__ __forceinline__ unsigned cvtpk2(float lo, float hi) { unsigned r; asm volatile("v_cvt_pk_bf16_f32 %0, %1, %2" : "=v"(r) : "v"(lo), "v"(hi)); return r; }
__device__ __forceinline__ float bflo(unsigned w) { return __uint_as_float(w << 16); }
__device__ __forceinline__ float bfhi(unsigned w) { return __uint_as_float(w & 0xffff0000u); }
__device__ __forceinline__ void ld8(const bf16* p, float (&v)[8]) { const v4u w = *(const v4u*)p; v[0] = bflo(w.x); v[1] = bfhi(w.x); v[2] = bflo(w.y); v[3] = bfhi(w.y); v[4] = bflo(w.z); v[5] = bfhi(w.z); v[6] = bflo(w.w); v[7] = bfhi(w.w); }
__device__ __forceinline__ void st8(bf16* p, const float (&v)[8]) { v4u w; w.x = cvtpk2(v[0], v[1]); w.y = cvtpk2(v[2], v[3]); w.z = cvtpk2(v[4], v[5]); w.w = cvtpk2(v[6], v[7]); *(v4u*)p = w; }
__device__ __forceinline__ void ld4(const bf16* p, float (&v)[4]) { const v2u w = *(const v2u*)p; v[0] = bflo(w.x); v[1] = bfhi(w.x); v[2] = bflo(w.y); v[3] = bfhi(w.y); }
__device__ __forceinline__ void st4(bf16* p, const float (&v)[4]) { v2u w; w.x = cvtpk2(v[0], v[1]); w.y = cvtpk2(v[2], v[3]); *(v2u*)p = w; }
template <int W> __device__ __forceinline__ float grp_sum(float v) {
#pragma unroll
  for (int o = 1; o < W; o <<= 1) v += __shfl_xor(v, o);
  return v;
}
__device__ __forceinline__ float sumsq8(const float (&v)[8]) { float s = 0.f;
#pragma unroll
  for (int j = 0; j < 8; ++j) s += v[j] * v[j];
  return s; }

#define XB_TMO      128
#define XB_XCNT(j)  (256  + 64 * (j))
#define XB_XSUB(j)  (1280 + 64 * (j))
#define XB_XGEN(j)  (2304 + 64 * (j))
#define XB_TOP      3328
#define XB_TOPGEN   3392
#define XCD_BAR_WORDS 3456
#define XB_SPIN_CAP (1u << 18)

__device__ __forceinline__ unsigned xb_ld(unsigned* p)              { return __hip_atomic_load(p, __ATOMIC_RELAXED, __HIP_MEMORY_SCOPE_AGENT); }
__device__ __forceinline__ unsigned xb_add(unsigned* p, unsigned v) { return __hip_atomic_fetch_add(p, v, __ATOMIC_RELAXED, __HIP_MEMORY_SCOPE_AGENT); }
__device__ __forceinline__ unsigned xb_xcc_id() { return (unsigned)__builtin_amdgcn_s_getreg((3 << 11) | 20) & 0xFu; }
#define XB_SPIN(cond, bar) do { unsigned _sp = 0; while (cond) { __builtin_amdgcn_s_sleep(1); \
    if ((++_sp & 255u) == 0u) { if (xb_ld(&(bar)[XB_TMO])) break; if (_sp > XB_SPIN_CAP) { atomicAdd(&(bar)[XB_TMO], 1u); break; } } } } while (0)

struct XcdBarrier {
    unsigned* bar; unsigned x;
    volatile LAS unsigned* st;
};

__device__ __forceinline__ XcdBarrier xcd_barrier_post(unsigned* bar, volatile LAS unsigned* st) {
    XcdBarrier b; b.bar = bar; b.x = xb_xcc_id(); b.st = st;
    if (threadIdx.x == 0) (void)xb_add(&bar[XB_XCNT(b.x)], 1u);
    return b;
}
__device__ __forceinline__ void xcd_barrier_complete(unsigned* bar, unsigned x, unsigned& nloc, unsigned& nx) {
    const unsigned G = gridDim.x * gridDim.y * gridDim.z;
    unsigned sum, cnt, mine, sp = 0u;
    for (;;) {
        sum = 0u; cnt = 0u; mine = 0u;
#pragma unroll
        for (unsigned j = 0; j < 16; ++j) { const unsigned c = xb_ld(&bar[XB_XCNT(j)]); sum += c; cnt += (c > 0u) ? 1u : 0u; mine = (j == x) ? c : mine; }
        if (sum == G) break;
        __builtin_amdgcn_s_sleep(1);
        if ((++sp & 255u) == 0u) { if (xb_ld(&bar[XB_TMO])) break; if (sp > XB_SPIN_CAP) { atomicAdd(&bar[XB_TMO], 1u); break; } }
    }
    nloc = mine > 0u ? mine : 1u; nx = cnt > 0u ? cnt : 1u;
}

__device__ __forceinline__ void xcd_barrier(const XcdBarrier& b) {
    asm volatile("s_waitcnt vmcnt(0)" ::: "memory");
    __syncthreads();
    if (threadIdx.x == 0) {
        unsigned* bar = b.bar;
        __builtin_amdgcn_s_waitcnt(0);
        unsigned nloc = b.st[0], nx = b.st[1];
        if (nloc == 0u) { xcd_barrier_complete(bar, b.x, nloc, nx); b.st[0] = nloc; b.st[1] = nx; }
        const unsigned old = xb_add(&bar[XB_XSUB(b.x)], 1u);
        const unsigned gen = old / nloc;
        if (old + 1u == (gen + 1u) * nloc) {
            __builtin_amdgcn_fence(__ATOMIC_RELEASE, "agent");
            asm volatile("s_waitcnt vmcnt(0)" ::: "memory");
            const unsigned og = xb_add(&bar[XB_TOP], 1u);
            const unsigned tg = og / nx;
            if (og + 1u == (tg + 1u) * nx) xb_add(&bar[XB_TOPGEN], 1u);
            else XB_SPIN(xb_ld(&bar[XB_TOPGEN]) == tg, bar);
            __builtin_amdgcn_fence(__ATOMIC_ACQUIRE, "agent");
            xb_add(&bar[XB_XGEN(b.x)], 1u);
            asm volatile("s_waitcnt vmcnt(0)" ::: "memory");
        } else {
            XB_SPIN(xb_ld(&bar[XB_XGEN(b.x)]) == gen, bar);
            __builtin_amdgcn_fence(__ATOMIC_ACQUIRE, "agent");
            asm volatile("s_waitcnt vmcnt(0)" ::: "memory");
        }
    }
    __syncthreads();
}

struct Args {
  const float* in[22]; float* out; unsigned char* ws;
  float inv_mla[32], inv_ax[32], inv_swa[8];
};

struct Ctx { int lane, wave, gw, NGW, G, vcu; unsigned char* ws; };

__device__ __forceinline__ void transpose_stream(const float* __restrict__ W, const int K, const int N, bf16* __restrict__ WT, LAS float* scr, const int first, const int items, const int stride, const int lane, const float* __restrict__ gain) {
  const int nblk = N / 32, half = lane >> 5, l31 = lane & 31;
  float cur[32], nxt[32];
  if (first >= items) return;
#define TS_LOAD(dst, item_) do { const int kb_ = (item_) / nblk, nb_ = (item_) % nblk; const float* p_ = W + (size_t)(64 * kb_ + half) * N + 32 * nb_ + l31; \
    _Pragma("unroll") for (int i = 0; i < 32; ++i) dst[i] = p_[(size_t)(2 * i) * N]; } while (0)
  TS_LOAD(cur, first);
  for (int it = first; it < items; it += stride) {
    const bool more = it + stride < items;
    if (more) TS_LOAD(nxt, it + stride);
    const int kb = it / nblk, nb = it % nblk, k0 = 64 * kb, n0 = 32 * nb;
    if (gain) {
#pragma unroll
      for (int i = 0; i < 32; ++i) cur[i] *= gain[k0 + 2 * i + half]; }
#pragma unroll
    for (int i = 0; i < 32; ++i) scr[(2 * i + half) * 33 + l31] = cur[i];
    asm volatile("s_waitcnt lgkmcnt(0)" ::: "memory");
    const int c = lane & 7;
#pragma unroll
    for (int j = 0; j < 4; ++j) { const int n = (lane >> 3) + 8 * j; const LAS float* s = scr + (8 * c) * 33 + n;
      v4u o; o.x = cvtpk2(s[0 * 33], s[1 * 33]); o.y = cvtpk2(s[2 * 33], s[3 * 33]); o.z = cvtpk2(s[4 * 33], s[5 * 33]); o.w = cvtpk2(s[6 * 33], s[7 * 33]);
      *(v4u*)(WT + (size_t)(n0 + n) * K + k0 + 8 * c) = o; }
    asm volatile("s_waitcnt lgkmcnt(0)" ::: "memory");
    if (more) {
#pragma unroll
      for (int i = 0; i < 32; ++i) cur[i] = nxt[i]; }
  }
#undef TS_LOAD
}
__device__ __forceinline__ void rms_row(const float* xrow, const float* gain, bf16* orow, int lane) {
  f32x4 v[8]; float s = 0.f;
#pragma unroll
  for (int j = 0; j < 8; ++j) { v[j] = *((const f32x4*)xrow + lane + 64 * j); s += (v[j].x * v[j].x + v[j].y * v[j].y) + (v[j].z * v[j].z + v[j].w * v[j].w); }
  const float rstd = 1.0f / sqrtf(grp_sum<64>(s) * (1.f / DM) + EPS);
#pragma unroll
  for (int j = 0; j < 8; ++j) { const f32x4 g = *((const f32x4*)gain + lane + 64 * j); v2u w; w.x = cvtpk2(v[j].x * rstd * g.x, v[j].y * rstd * g.y); w.y = cvtpk2(v[j].z * rstd * g.z, v[j].w * rstd * g.w);
    *((v2u*)orow + lane + 64 * j) = w; }
}
__device__ __forceinline__ void norm_phase(const Ctx& c, const float* x, const float* gain, bf16* xn) {
  for (int m = c.gw; m < T; m += c.NGW) rms_row(x + (size_t)m * DM, gain, xn + (size_t)m * DM, c.lane);
}
__device__ __forceinline__ f32x2 sincos_rev(float ang) {
  double fr = (double)ang * 0.15915494309189533577; fr -= rint(fr); const float f = (float)fr;
  return (f32x2){__builtin_amdgcn_cosf(f), __builtin_amdgcn_sinf(f)};
}

__device__ __forceinline__ void prologue(const Ctx& c, const Args& a, LAS unsigned char* lds) {
  LAS float* scr = (LAS float*)(lds + c.wave * 16384);
  unsigned char* ws = c.ws;
  int base = 0;
#define DO_W(inidx, K_, N_, off, srcoff, gain_) do { const int items = ((K_) / 64) * ((N_) / 32); const float* W = a.in[inidx] + (srcoff); bf16* WT = (bf16*)(ws + (off)); \
    const int first = (c.gw - (base % c.NGW) + c.NGW) % c.NGW; \
    transpose_stream(W, (K_), (N_), WT, scr, first, items, c.NGW, c.lane, (gain_)); \
    base += items; } while (0)
  DO_W(2, DM, EVEN_IN, WS_WIN, 0, nullptr); DO_W(5, 512, 1536, WS_WUQ, 0, nullptr); DO_W(6, 256, 2048, WS_WUKV, 0, nullptr);
#undef DO_W
  { v4u* z = (v4u*)((bf16*)(ws + WS_WIN) + (size_t)EVEN_IN * DM); const int n16 = (EVEN_IN_P - EVEN_IN) * DM / 8;
    for (int i = c.gw * 64 + c.lane; i < n16; i += c.NGW * 64) z[i] = (v4u){0u, 0u, 0u, 0u}; }
  { f32x2* tm = (f32x2*)(ws + WS_TMLA); f32x2* ta = (f32x2*)(ws + WS_TAX); f32x2* tsw = (f32x2*)(ws + WS_TSWA);
    const int gt = c.gw * 64 + c.lane, NT_ = c.NGW * 64;
    for (int i = gt; i < SEQ * 32; i += NT_) { const int s = i >> 5, f = i & 31; tm[i] = sincos_rev((float)s * a.inv_mla[f]); }
    for (int i = gt; i < SEQ * 64; i += NT_) { const int s = i >> 6, f = i & 63; const int pos = (f < 32) ? (s >> 6) : (s & 63); ta[i] = sincos_rev((float)pos * a.inv_ax[f & 31]); }
    for (int i = gt; i < SEQ * 8; i += NT_) { const int s = i >> 3, f = i & 7; tsw[i] = sincos_rev((float)s * a.inv_swa[f]); } }
  norm_phase(c, a.in[0], a.in[1], (bf16*)(ws + WS_XN));
}

template <int SET> __device__ __forceinline__ void convert_tail(const int gw, const int NGW, const int wave, const int lane, const Args& a, unsigned char* ws, LAS unsigned char* lds) {
  LAS float* scr = (LAS float*)(lds + wave * 16384);
  int base = 0;
#define DO_W(inidx, K_, N_, off, srcoff, gain_) do { const int items = ((K_) / 64) * ((N_) / 32); const float* W = a.in[inidx] + (srcoff); bf16* WT = (bf16*)(ws + (off)); \
    const int first = (gw - (base % NGW) + NGW) % NGW; \
    transpose_stream(W, (K_), (N_), WT, scr, first, items, NGW, lane, (gain_)); \
    base += items; } while (0)
  if constexpr (SET == 1) { DO_W(12, DM, DM, WS_WOE, 0, nullptr); DO_W(20, DM, DFF, WS_WUP, 0, a.in[19]); DO_W(21, DFF, DM, WS_WDN, 0, nullptr);
    DO_W(14, DM, ODD_IN, WS_WQKV, 0, a.in[13]); DO_W(18, DM, DM, WS_WOO, 0, nullptr); }
  else { DO_W(20, DM, DFF, WS_WUP, (size_t)DM * DFF, a.in[19] + DM); DO_W(21, DFF, DM, WS_WDN, (size_t)DM * DFF, nullptr); }
#undef DO_W
}
__device__ __forceinline__ void post_proj(const Ctx& c, const Args& a) {
  unsigned char* ws = c.ws; const int l = c.lane;
  const bf16* PROJ = (const bf16*)(ws + WS_PROJ);
  bf16* CQN = (bf16*)(ws + WS_CQN); bf16* CKVN = (bf16*)(ws + WS_CKVN); bf16* KR = (bf16*)(ws + WS_KR);
  bf16* QG = (bf16*)(ws + WS_QG); bf16* KG = (bf16*)(ws + WS_KG); bf16* VG = (bf16*)(ws + WS_VG);
  const f32x2* tm = (const f32x2*)(ws + WS_TMLA); const f32x2* ta = (const f32x2*)(ws + WS_TAX);
  const float* g_qlat = a.in[3]; const float* g_kvlat = a.in[4]; const float* g_krope = a.in[9]; const float* g_gq = a.in[10]; const float* g_gk = a.in[11];
  for (int t = c.gw; t < T; t += c.NGW) {
    const int b = t / SEQ, s = t % SEQ; const bf16* pr = PROJ + (size_t)t * EVEN_IN_P;
    float v[8], o[8];
    { ld8(pr + 8 * l, v); const float rstd = 1.0f / sqrtf(grp_sum<64>(sumsq8(v)) * (1.f / 512) + EPS);
#pragma unroll
      for (int j = 0; j < 8; ++j) o[j] = v[j] * rstd * g_qlat[8 * l + j];
      st8(CQN + (size_t)t * 512 + 8 * l, o); }
    { const bool act = l < 40; if (act) ld8(pr + 512 + 8 * l, v); else {
#pragma unroll
        for (int j = 0; j < 8; ++j) v[j] = 0.f; }
      float ss = grp_sum<8>(sumsq8(v)); const float ss8 = ss; ss += __shfl_xor(ss, 8); ss += __shfl_xor(ss, 16);
      if (l < 32) { const float rstd = 1.0f / sqrtf(ss * (1.f / 256) + EPS);
#pragma unroll
        for (int j = 0; j < 8; ++j) o[j] = v[j] * rstd * g_kvlat[8 * l + j];
        st8(CKVN + (size_t)t * 256 + 8 * l, o); }
      const int lr = l & 7; const float rstd8 = 1.0f / sqrtf(ss8 * (1.f / 64) + EPS); float nv[8], pv_[8];
#pragma unroll
      for (int j = 0; j < 8; ++j) nv[j] = v[j] * rstd8 * g_krope[(8 * lr + j) & 63];
#pragma unroll
      for (int j = 0; j < 8; ++j) pv_[j] = __shfl_xor(nv[j], 4);
      if (l >= 32 && l < 40) {
#pragma unroll
        for (int j = 0; j < 8; ++j) { const f32x2 cs = tm[s * 32 + 8 * (lr & 3) + j]; o[j] = (lr & 4) ? (nv[j] * cs.x + pv_[j] * cs.y) : (nv[j] * cs.x - pv_[j] * cs.y); }
        st8(KR + (size_t)t * 64 + 8 * lr, o); } }
#pragma unroll
    for (int pass = 0; pass < 3; ++pass) {
      const int hl = l >> 4, ll = l & 15;
      ld8(pr + 832 + pass * 512 + 8 * l, v);
      const float rstd = 1.0f / sqrtf(grp_sum<16>(sumsq8(v)) * (1.f / 128) + EPS);
      const float* g = (pass < 2) ? g_gq : g_gk; float nv[8], pv_[8];
#pragma unroll
      for (int j = 0; j < 8; ++j) nv[j] = v[j] * rstd * g[8 * ll + j];
#pragma unroll
      for (int j = 0; j < 8; ++j) pv_[j] = __shfl_xor(nv[j], 4);
#pragma unroll
      for (int j = 0; j < 8; ++j) { const f32x2 cs = ta[s * 64 + ((ll & 8) ? 32 : 0) + 8 * (ll & 3) + j]; o[j] = (ll & 4) ? (nv[j] * cs.x + pv_[j] * cs.y) : (nv[j] * cs.x - pv_[j] * cs.y); }
      if (pass < 2) st8(QG + ((size_t)(b * 8 + pass * 4 + hl) * SEQ + s) * 128 + 8 * ll, o);
      else if (hl < 2) st8(KG + ((size_t)(b * 2 + hl) * SEQ + s) * 128 + 8 * ll, o);
      else st8(VG + ((size_t)(b * 2 + (hl - 2)) * SEQ + s) * 128 + 8 * ll, v);
    }
  }
}
__device__ __forceinline__ void post_mla(const Ctx& c, const Args& a) {
  unsigned char* ws = c.ws; const int l = c.lane, hl = l >> 4, ll = l & 15;
  const bf16* QAR = (const bf16*)(ws + WS_QAR); const bf16* KVR = (const bf16*)(ws + WS_KVR); const bf16* KR = (const bf16*)(ws + WS_KR);
  bf16* QA = (bf16*)(ws + WS_QA); bf16* KA = (bf16*)(ws + WS_KA); bf16* VA = (bf16*)(ws + WS_VA);
  const f32x2* tm = (const f32x2*)(ws + WS_TMLA);
  const float* g_q = a.in[7]; const float* g_kn = a.in[8];
  for (int t = c.gw; t < T; t += c.NGW) {
    const int b = t / SEQ, s = t % SEQ;
#pragma unroll
    for (int pass = 0; pass < 2; ++pass) {
      const int h = pass * 4 + hl;
      {
        const bf16* q = QAR + (size_t)t * 1536 + h * 192; float v[8], r[4], o[8], ro[4];
        ld8(q + 8 * ll, v); ld4(q + 128 + 4 * ll, r);
        float ss = sumsq8(v) + (r[0] * r[0] + r[1] * r[1]) + (r[2] * r[2] + r[3] * r[3]);
        const float rstd = 1.0f / sqrtf(grp_sum<16>(ss) * (1.f / 192) + EPS);
#pragma unroll
        for (int j = 0; j < 8; ++j) o[j] = v[j] * rstd * g_q[8 * ll + j];
        float nr[4], pr_[4];
#pragma unroll
        for (int j = 0; j < 4; ++j) nr[j] = r[j] * rstd * g_q[128 + 4 * ll + j];
#pragma unroll
        for (int j = 0; j < 4; ++j) pr_[j] = __shfl_xor(nr[j], 8);
#pragma unroll
        for (int j = 0; j < 4; ++j) { const f32x2 cs = tm[s * 32 + 4 * (ll & 7) + j]; ro[j] = (ll & 8) ? (nr[j] * cs.x + pr_[j] * cs.y) : (nr[j] * cs.x - pr_[j] * cs.y); }
        bf16* qo = QA + ((size_t)(b * 8 + h) * SEQ + s) * 192; st8(qo + 8 * ll, o); st4(qo + 128 + 4 * ll, ro); }
      {
        const bf16* kv = KVR + (size_t)t * 2048 + h * 256; float v[8], o[8];
        ld8(kv + 8 * ll, v);
        const float rstd = 1.0f / sqrtf(grp_sum<16>(sumsq8(v)) * (1.f / 128) + EPS);
#pragma unroll
        for (int j = 0; j < 8; ++j) o[j] = v[j] * rstd * g_kn[8 * ll + j];
        bf16* ko = KA + ((size_t)(b * 8 + h) * SEQ + s) * 192; st8(ko + 8 * ll, o);
        *(v2u*)(ko + 128 + 4 * ll) = *(const v2u*)(KR + (size_t)t * 64 + 4 * ll);
        *(v4u*)(VA + ((size_t)(b * 8 + h) * SEQ + s) * 128 + 8 * ll) = *(const v4u*)(kv + 128 + 8 * ll); }
    }
  }
}
__device__ __forceinline__ void post_qkv(const Ctx& c, const Args& a) {
  unsigned char* ws = c.ws; const int l = c.lane, hl = l >> 3, ll = l & 7;
  const bf16* QKV = (const bf16*)(ws + WS_PROJ);
  bf16* SQ = (bf16*)(ws + WS_SQ); bf16* SK = (bf16*)(ws + WS_SK); bf16* SV = (bf16*)(ws + WS_SV);
  const f32x2* tsw = (const f32x2*)(ws + WS_TSWA);
  const float* g_q = a.in[15]; const float* g_k = a.in[16];
  for (int t = c.gw; t < T; t += c.NGW) {
    const int b = t / SEQ, s = t % SEQ; const bf16* pr = QKV + (size_t)t * ODD_IN;
#pragma unroll
    for (int pass = 0; pass < 5; ++pass) {
      float v[8], o[8], nv[8], pv_[8];
      ld8(pr + pass * 512 + 8 * l, v);
      const float rstd = 1.0f / sqrtf(grp_sum<8>(sumsq8(v)) * (1.f / 64) + EPS);
      const float* g = (pass < 4) ? g_q : g_k;
#pragma unroll
      for (int j = 0; j < 8; ++j) nv[j] = v[j] * rstd * g[8 * ll + j];
#pragma unroll
      for (int j = 0; j < 8; ++j) pv_[j] = __shfl_xor(nv[j], 1);
#pragma unroll
      for (int j = 0; j < 8; ++j) { const f32x2 cs = tsw[s * 8 + j]; o[j] = (ll >= 2) ? nv[j] : ((ll & 1) ? (nv[j] * cs.x + pv_[j] * cs.y) : (nv[j] * cs.x - pv_[j] * cs.y)); }
      if (pass < 4) st8(SQ + ((size_t)(b * 32 + pass * 8 + hl) * SEQ + s) * 64 + 8 * ll, o);
      else if (hl < 4) st8(SK + ((size_t)(b * 4 + hl) * SEQ + s) * 64 + 8 * ll, o);
      else st8(SV + ((size_t)(b * 4 + (hl - 4)) * SEQ + s) * 64 + 8 * ll, v);
    }
  }
}

#ifdef NO_GEMM
#define GEMM_PHASE(EPI_T, epi, Aoff, Boff, N_, K_) do { (void)(epi); } while (0)
#else
#define GEMM_PHASE(EPI_T, epi, Aoff, Boff, N_, K_) do { \
    pg8::Gemm g_{(const pg8::bf16_t*)(ws + (Aoff)), (const pg8::bf16_t*)(ws + (Boff)), T, (N_), (K_)}; pg8::StaticOrder S_; S_.init(T, (N_), c.G, (int)blockIdx.x); \
    pg8::gemm_phase<EPI_T, pg8::StaticOrder, true, true>(ldsl, g_, S_, (epi)); } while (0)
#endif

#ifndef REP_THIN2
#define REP_THIN2 1
#endif
#ifndef REP_THIN3
#define REP_THIN3 1
#endif
#ifndef REP_SWA
#define REP_SWA 1
#endif
#ifndef REP_PRO
#define REP_PRO 1
#endif
#ifndef REP_THIN
#define REP_THIN 1
#endif
#ifndef REP_MLA
#define REP_MLA 1
#endif
#ifndef REP_GQA
#define REP_GQA 1
#endif
#ifndef REP_UP
#define REP_UP 1
#endif
__global__ void __launch_bounds__(NWAVES * 64, 2) fwd_megakernel(Args a) {
  extern __shared__ __attribute__((aligned(16))) unsigned char lds[];
#ifdef NO_SYNC
  struct { __device__ void sync() const { __syncthreads(); } } grid;
#else
  cg::grid_group grid = cg::this_grid();
#endif
  LAS unsigned char* ldsl = (LAS unsigned char*)lds;
#define MKCTX() do { int t_ = threadIdx.x; asm volatile("" : "+v"(t_)); c.lane = t_ & 63; c.wave = __builtin_amdgcn_readfirstlane(t_ >> 6); c.G = gridDim.x; \
    { const int bx = blockIdx.x; c.vcu = (c.G % 8 == 0) ? (bx % 8) * (c.G / 8) + bx / 8 : bx; } \
    c.gw = blockIdx.x * NWAVES + c.wave; c.NGW = c.G * NWAVES; c.ws = a.ws; } while (0)
  Ctx c; MKCTX();
  volatile LAS unsigned* bst = (volatile LAS unsigned*)(ldsl + 131072 + 512);
  if (threadIdx.x < 2) bst[threadIdx.x] = 0u;
  __syncthreads();
  XcdBarrier xbar = xcd_barrier_post((unsigned*)a.ws, bst);
#ifdef USE_CG_ALL
#define SEAM() do { grid.sync(); MKCTX(); } while (0)
#else
#define SEAM() do { xcd_barrier(xbar); MKCTX(); } while (0)
#endif
  unsigned char* ws = a.ws;
  float* X = a.out; float* RSS = (float*)(a.ws + WS_ROWSS);

#ifndef NO_PRO
  prologue(c, a, ldsl);

#endif
  grid.sync(); MKCTX();
  { pg8::EpiB<0> E{(pg8::bf16_t*)(ws + WS_PROJ), EVEN_IN_P, nullptr, 0.f, 0.f}; GEMM_PHASE(pg8::EpiB<0>, E, WS_XN, WS_WIN, EVEN_IN_P, DM); }
#ifndef NO_PRO
  { MKCTX(); const int rem = ((T / 256) * (EVEN_IN_P / 256)) % c.G, first_idle = rem, n_idle = c.G - rem;
    if ((int)blockIdx.x >= first_idle) convert_tail<1>(((int)blockIdx.x - first_idle) * NWAVES + c.wave, n_idle * NWAVES, c.wave, c.lane, a, ws, ldsl); }
#endif
  SEAM();
#ifndef NO_POST
  for (int rep = 0; rep < REP_THIN; ++rep) { MKCTX(); post_proj(c, a); }
#endif
  SEAM();
  { pg8::EpiB<0> E{(pg8::bf16_t*)(ws + WS_QAR), 1536, nullptr, 0.f, 0.f}; GEMM_PHASE(pg8::EpiB<0>, E, WS_CQN, WS_WUQ, 1536, 512); }
  { pg8::EpiB<0> E{(pg8::bf16_t*)(ws + WS_KVR), 2048, nullptr, 0.f, 0.f}; GEMM_PHASE(pg8::EpiB<0>, E, WS_CKVN, WS_WUKV, 2048, 256); }
  SEAM();
#ifndef NO_POST
  for (int rep = 0; rep < REP_THIN2; ++rep) { MKCTX(); post_mla(c, a); }
#endif
  SEAM();
  {
    constexpr float L2E = 1.4426950408889634f;
    const int nper = (512 + c.G - 1) / c.G;
    for (int rep = 0; rep < REP_MLA; ++rep)
    for (int i = 0; i < nper; ++i) {
      const int u = c.vcu * nper + i; if (u >= 512) break;
      int tid = threadIdx.x; asm volatile("" : "+v"(tid)); const int wid = tid >> 6, lane = tid & 63, r32 = lane & 31;
      const int bh = u >> 5, qb = u & 31, b = bh >> 3, h = bh & 7;
      const float sc = 0.07216878364870322f;
      const att::bf16* Q = (const att::bf16*)(ws + WS_QA) + ((size_t)bh * SEQ + qb * 256 + wid * 32 + r32) * 192;
      const att::bf16* K = (const att::bf16*)(ws + WS_KA) + (size_t)bh * SEQ * 192;
      const att::bf16* V = (const att::bf16*)(ws + WS_VA) + (size_t)bh * SEQ * 128;
      att::bf16* O = (att::bf16*)(ws + WS_MRG) + ((size_t)b * SEQ + qb * 256 + wid * 32) * 2048 + h * 128;
#ifndef NO_A192
      att::attn_unit<192, 128, false, false, 1>(Q, K, V, O, 2048, 0, SEQ / 64, 0, SEQ, 0, -1e30f, 0.f, sc * L2E, 8.f / sc, (char*)lds);
#endif
    }
    for (int rep = 0; rep < REP_GQA; ++rep)
    for (int i = 0; i < nper; ++i) {
      const int u = c.vcu * nper + i; if (u >= 512) break;
      int tid = threadIdx.x; asm volatile("" : "+v"(tid)); const int wid = tid >> 6, lane = tid & 63, r32 = lane & 31;
      const int bh = u >> 5, qb = u & 31, b = bh >> 3, h = bh & 7, kvh = h >> 2;
      const float sc = 0.08838834764831845f;
      const att::bf16* Q = (const att::bf16*)(ws + WS_QG) + ((size_t)bh * SEQ + qb * 256 + wid * 32 + r32) * 128;
      const att::bf16* K = (const att::bf16*)(ws + WS_KG) + (size_t)(b * 2 + kvh) * SEQ * 128;
      const att::bf16* V = (const att::bf16*)(ws + WS_VG) + (size_t)(b * 2 + kvh) * SEQ * 128;
      att::bf16* O = (att::bf16*)(ws + WS_MRG) + ((size_t)b * SEQ + qb * 256 + wid * 32) * 2048 + 1024 + h * 128;
#ifndef NO_A128
      att::attn_unit<128, 128, false, false, 2>(Q, K, V, O, 2048, 0, SEQ / 64, 0, SEQ, 0, -1e30f, 0.f, sc * L2E, 8.f / sc, (char*)lds);
#endif
    }
  }
  SEAM();
  { pg8::EpiResN E{a.in[0], X, (pg8::bf16_t*)(ws + WS_XN), RSS, DM}; GEMM_PHASE(pg8::EpiResN, E, WS_MRG, WS_WOE, DM, DM); }
  SEAM();
  { pg8::EpiB<2> E{(pg8::bf16_t*)(ws + WS_U), DFF, RSS, 1.f / DM, EPS}; GEMM_PHASE(pg8::EpiB<2>, E, WS_XN, WS_WUP, DFF, DM); }
#if REP_UP > 1
  MKCTX(); { pg8::EpiB<2> E{(pg8::bf16_t*)(ws + WS_U), DFF, RSS, 1.f / DM, EPS}; GEMM_PHASE(pg8::EpiB<2>, E, WS_XN, WS_WUP, DFF, DM); }
#endif
  SEAM();
#ifdef REP_DN
  { pg8::EpiB<0> E{(pg8::bf16_t*)(ws + AB + 256 * MiB), DM, nullptr, 0.f, 0.f}; GEMM_PHASE(pg8::EpiB<0>, E, WS_U, WS_WDN, DM, DFF); } MKCTX();
#endif
  { pg8::EpiResN E{X, X, (pg8::bf16_t*)(ws + WS_XN), RSS + T, DM}; GEMM_PHASE(pg8::EpiResN, E, WS_U, WS_WDN, DM, DFF); }
  SEAM();
  { pg8::EpiB<0> E{(pg8::bf16_t*)(ws + WS_PROJ), ODD_IN, RSS + T, 1.f / DM, EPS}; GEMM_PHASE(pg8::EpiB<0>, E, WS_XN, WS_WQKV, ODD_IN, DM); }
#ifndef NO_PRO
  { MKCTX(); const int rem = ((T / 256) * (ODD_IN / 256)) % c.G, first_idle = rem, n_idle = c.G - rem;
    if ((int)blockIdx.x >= first_idle) convert_tail<2>(((int)blockIdx.x - first_idle) * NWAVES + c.wave, n_idle * NWAVES, c.wave, c.lane, a, ws, ldsl); }
#endif
  SEAM();
#ifndef NO_POST
  for (int rep = 0; rep < REP_THIN3; ++rep) { MKCTX(); post_qkv(c, a); }
#endif
  SEAM();
  {
    constexpr float L2E = 1.4426950408889634f; const float sc = 0.125f;
    const int nper = (2048 + c.G - 1) / c.G;
    for (int rep = 0; rep < REP_SWA; ++rep)
    for (int i = 0; i < nper; ++i) {
      const int u = c.vcu * nper + i; if (u >= 2048) break;
      int tid = threadIdx.x; asm volatile("" : "+v"(tid)); const int wid = tid >> 6, lane = tid & 63, r32 = lane & 31;
      const int b = u >> 10, kvh = (u >> 8) & 3, rb = u & 255, h = kvh * 8 + wid;
      const att::bf16* Q = (const att::bf16*)(ws + WS_SQ) + ((size_t)(b * 32 + h) * SEQ + rb * 32 + r32) * 64;
      const att::bf16* K = (const att::bf16*)(ws + WS_SK) + (size_t)(b * 4 + kvh) * SEQ * 64;
      const att::bf16* V = (const att::bf16*)(ws + WS_SV) + (size_t)(b * 4 + kvh) * SEQ * 64;
      att::bf16* O = (att::bf16*)(ws + WS_MRG) + ((size_t)b * SEQ + rb * 32) * 2048 + h * 64;
      const float sink = a.in[17][h];
#ifndef NO_A64
      att::swa_unit<5>(Q, K, V, O, 2048, rb * 32 - 128, rb * 32 + r32, SEQ, 128, sink / sc, sc * L2E, 8.f / sc, (char*)lds);
#endif
    }
  }
  SEAM();
  { pg8::EpiResN E{X, X, (pg8::bf16_t*)(ws + WS_XN), RSS + 2 * T, DM}; GEMM_PHASE(pg8::EpiResN, E, WS_MRG, WS_WOO, DM, DM); }
  SEAM();
  { pg8::EpiB<2> E{(pg8::bf16_t*)(ws + WS_U), DFF, RSS + 2 * T, 1.f / DM, EPS}; GEMM_PHASE(pg8::EpiB<2>, E, WS_XN, WS_WUP, DFF, DM); }
#if REP_UP > 1
  MKCTX(); { pg8::EpiB<2> E{(pg8::bf16_t*)(ws + WS_U), DFF, RSS + 2 * T, 1.f / DM, EPS}; GEMM_PHASE(pg8::EpiB<2>, E, WS_XN, WS_WUP, DFF, DM); }
#endif
  SEAM();
#ifdef REP_DN
  { pg8::EpiB<0> E{(pg8::bf16_t*)(ws + AB + 256 * MiB), DM, nullptr, 0.f, 0.f}; GEMM_PHASE(pg8::EpiB<0>, E, WS_U, WS_WDN, DM, DFF); } MKCTX();
#endif
  { pg8::EpiRes E{X, X, DM}; GEMM_PHASE(pg8::EpiRes, E, WS_U, WS_WDN, DM, DFF); }
}

#ifdef PROBE_PRO_KERNEL
__global__ void __launch_bounds__(NWAVES * 64, 2) probe_prologue(Args a) {
  extern __shared__ __attribute__((aligned(16))) unsigned char lds[];
  LAS unsigned char* ldsl = (LAS unsigned char*)lds;
  Ctx c; { int t_ = threadIdx.x; c.lane = t_ & 63; c.wave = __builtin_amdgcn_readfirstlane(t_ >> 6); c.G = gridDim.x; c.vcu = blockIdx.x; c.gw = blockIdx.x * NWAVES + c.wave; c.NGW = c.G * NWAVES; c.ws = a.ws; }
  prologue(c, a, ldsl);
}
#endif
extern "C" void kernel_launch(void* const* d_in, const int* in_sizes, int n_in, void* d_out, int out_size, void* d_ws, size_t ws_size, hipStream_t stream) {
  static int grid = 0;
  if (grid == 0) {
    if (n_in != 22 || out_size != T * DM || ws_size < WS_NEED) { fprintf(stderr, "kernel_launch: unexpected shapes: n_in %d out %d ws %zu (need %zu)\n", n_in, out_size, ws_size, (size_t)WS_NEED); grid = -1; return; }
    int dev = 0, cus = 0, per_cu = 0;
    (void)hipGetDevice(&dev); (void)hipDeviceGetAttribute(&cus, hipDeviceAttributeMultiprocessorCount, dev);
    if (LDS_BYTES > 0 && hipFuncSetAttribute((const void*)fwd_megakernel, hipFuncAttributeMaxDynamicSharedMemorySize, LDS_BYTES) != hipSuccess) { fprintf(stderr, "kernel_launch: hipFuncSetAttribute failed\n"); grid = -1; return; }
    if (hipOccupancyMaxActiveBlocksPerMultiprocessor(&per_cu, (const void*)fwd_megakernel, NWAVES * 64, LDS_BYTES) != hipSuccess || per_cu < 1) { fprintf(stderr, "kernel_launch: occupancy query says %d\n", per_cu); per_cu = 1; }
    (void)hipGetLastError();
    grid = cus * 1;
    fprintf(stderr, "kernel_launch: grid %d (cus %d, per_cu %d)\n", grid, cus, per_cu);
  }
  if (grid < 0) return;
  Args a; memset(&a, 0, sizeof(a));
  for (int i = 0; i < 22; ++i) a.in[i] = (const float*)d_in[i];
  a.out = (float*)d_out; a.ws = (unsigned char*)d_ws;
  for (int f = 0; f < 32; ++f) { a.inv_mla[f] = (float)pow((double)500000.0f, -(double)(2 * f) / 64.0); a.inv_ax[f] = (float)pow((double)10000.0f, -(double)(2 * f) / 64.0); }
  for (int f = 0; f < 8; ++f) a.inv_swa[f] = (float)pow((double)500000.0f, -(double)(2 * f) / 16.0);
  if (hipMemsetAsync(d_ws, 0, 512 * 1024, stream) != hipSuccess) { fprintf(stderr, "kernel_launch: memset failed\n"); return; }
#ifdef PROBE_PRO_KERNEL
  (void)hipFuncSetAttribute((const void*)probe_prologue, hipFuncAttributeMaxDynamicSharedMemorySize, LDS_BYTES);
  hipLaunchKernelGGL(probe_prologue, dim3(grid), dim3(NWAVES * 64), LDS_BYTES, stream, a);
#endif
  void* args[] = {&a};
#ifdef PROBE_PLAIN
  hipLaunchKernelGGL(fwd_megakernel, dim3(grid), dim3(NWAVES * 64), LDS_BYTES, stream, a); hipError_t e = hipPeekAtLastError();
#else
  hipError_t e = hipLaunchCooperativeKernel((const void*)fwd_megakernel, dim3(grid), dim3(NWAVES * 64), args, LDS_BYTES, stream);
#endif
  if (e != hipSuccess) fprintf(stderr, "kernel_launch: cooperative launch failed: %s (grid %d)\n", hipGetErrorString(e), grid);
}
```

```cpp
#include <hip/hip_runtime.h>
#include <hip/hip_cooperative_groups.h>
#include <cstdio>
#include <cstdint>
#include <cmath>
#include <cstring>
namespace cg = cooperative_groups;

namespace pg8 {
#define PG8_LAS __attribute__((address_space(3)))
typedef unsigned short bf16_t;
typedef short bf16x8 __attribute__((ext_vector_type(8)));
typedef float f32x4 __attribute__((ext_vector_type(4)));
typedef unsigned u32x4 __attribute__((ext_vector_type(4)));
constexpr int BM = 256, BK = 64, HALF = 128, HTB = HALF * BK * 2  , STAGE_BYTES = 8 * HTB, NXCD = 8, WGM = 8;

__host__ __device__ __forceinline__ int lds_byte(int r, int c) { const int st = (r >> 4) * 2 + (c >> 5), rr = r & 15, cc = c & 31, ob = rr * 64 + cc * 2; return st * 1024 + (ob ^ (((ob >> 9) & 1) << 5)); }
__host__ __device__ __forceinline__ void stage_rc(int b, int& R, int& C) { const int st = b / 1024, sb = b % 1024, swz = sb ^ (((sb >> 9) & 1) << 5); R = (st >> 1) * 16 + swz / 64; C = (st & 1) * 32 + (swz % 64) / 2; }
__host__ __device__ __forceinline__ int perm32(int rho) { const int n = rho >> 4, i = rho & 15; return 8 * (i >> 2) + 4 * n + (i & 3); }

struct Unit { int pm, pn; };
struct Gemm { const bf16_t* A; const bf16_t* Bt; int M, N, K; };

struct StaticOrder {
    int nM, nN, nwg, G, c;
    __host__ __device__ void init(int M, int N, int G_, int c_) { nM = M / BM; nN = N / BM; nwg = nM * nN; G = G_; c = c_; }
    __host__ __device__ bool next(int i, Unit& u) const {
        const long L = (long)i * G + c; if (L >= nwg) return false;
        int wgid = (int)L; { const int q = nwg / NXCD, r = nwg % NXCD, xcd = wgid % NXCD, off = wgid / NXCD; wgid = (xcd < r ? xcd * (q + 1) : r * (q + 1) + (xcd - r) * q) + off; }
        const int nig = WGM * nN, gid = wgid / nig, fm = gid * WGM, gsz = (nM - fm) < WGM ? (nM - fm) : WGM;
        u.pm = fm + ((wgid % nig) % gsz); u.pn = (wgid % nig) / gsz; return true;
    }
    __device__ __forceinline__ void a_ready(const Unit&) const {}
    __device__ __forceinline__ void done(const Unit&) const {}
};
__device__ __forceinline__ unsigned cvt_pk_bf16(float lo, float hi) { unsigned r; asm volatile("v_cvt_pk_bf16_f32 %0, %1, %2" : "=v"(r) : "v"(lo), "v"(hi)); return r; }
typedef float f32x2 __attribute__((ext_vector_type(2)));
__device__ __forceinline__ f32x2 gelu_pk(f32x2 v) {
    const f32x2 av = __builtin_elementwise_abs(v), d = av * 0.2316418882f + 1.0f;
    f32x2 t; t.x = __builtin_amdgcn_rcpf(d.x); t.y = __builtin_amdgcn_rcpf(d.y);
    f32x2 q = t * 0.5307027145f + (-0.7265760135f); q = q * t + 0.7107068705f; q = q * t + (-0.142248368f); q = q * t + 0.127414796f; q = q * t;
    const f32x2 s = (v * v) * (-0.72134752044f);
    f32x2 e; e.x = __builtin_amdgcn_exp2f(s.x); e.y = __builtin_amdgcn_exp2f(s.y);
    const f32x2 m = v * (q * e), r = v - m;
    f32x2 o; o.x = v.x < 0.f ? m.x : r.x; o.y = v.y < 0.f ? m.y : r.y; return o;
}

template <int ACT  > struct EpiBf16 {
    static constexpr bool PERM = true, AFTER_DRAIN = false; static_assert(ACT == 0 || ACT == 1, "EpiBf16: ACT is 0 (none) or 1 (gelu_pk)");
    bf16_t* O; int ldc; const float* bias; int split_cols; size_t split_stride; float scale0;
    __device__ __forceinline__ void operator()(const f32x4 (&acc)[2][2][4][2], const Unit& u, int wr, int wc, int fr, int fq) const {
        const int row0 = u.pm * BM + wr * 64 + fr; int colt = u.pn * BM; bf16_t* base = O;
        float sc = 1.f; if (split_cols) { const int t = colt / split_cols; base += (size_t)t * split_stride; colt -= t * split_cols; if (t == 0) sc = scale0; }
        const int col0 = colt + wc * 32 + 8 * fq, bcol0 = u.pn * BM + wc * 32 + 8 * fq;
        f32x4 bv[2][2];
#pragma unroll
        for (int bj = 0; bj < 2; ++bj)
#pragma unroll
            for (int n = 0; n < 2; ++n) bv[bj][n] = bias ? *(const f32x4*)(bias + bcol0 + bj * HALF + 4 * n) : (f32x4){0.f, 0.f, 0.f, 0.f};
#pragma unroll
        for (int ai = 0; ai < 2; ++ai)
#pragma unroll
            for (int m = 0; m < 4; ++m) { bf16_t* rowp = base + (size_t)(row0 + ai * HALF + m * 16) * ldc + col0;
#pragma unroll
                for (int bj = 0; bj < 2; ++bj) { f32x4 v0 = acc[ai][bj][m][0] + bv[bj][0], v1 = acc[ai][bj][m][1] + bv[bj][1];
                    if (ACT == 1) { f32x2 a = gelu_pk((f32x2){v0[0], v0[1]}), b = gelu_pk((f32x2){v0[2], v0[3]}), c = gelu_pk((f32x2){v1[0], v1[1]}), d = gelu_pk((f32x2){v1[2], v1[3]});
                        v0 = (f32x4){a.x, a.y, b.x, b.y}; v1 = (f32x4){c.x, c.y, d.x, d.y}; }
                    v0 = v0 * sc; v1 = v1 * sc; u32x4 w; w.x = cvt_pk_bf16(v0[0], v0[1]); w.y = cvt_pk_bf16(v0[2], v0[3]); w.z = cvt_pk_bf16(v1[0], v1[1]); w.w = cvt_pk_bf16(v1[2], v1[3]);
                    *(u32x4*)(rowp + bj * HALF) = w; } }
    }
};

template <int ACT  > struct EpiB {
    static constexpr bool PERM = true, AFTER_DRAIN = false;
    bf16_t* O; int ldc; const float* rowss; float inv_n, eps;
    __device__ __forceinline__ void operator()(const f32x4 (&acc)[2][2][4][2], const Unit& u, int wr, int wc, int fr, int fq) const {
        const int row0 = u.pm * BM + wr * 64 + fr; const int col0 = u.pn * BM + wc * 32 + 8 * fq;
#pragma unroll
        for (int ai = 0; ai < 2; ++ai)
#pragma unroll
            for (int m = 0; m < 4; ++m) { bf16_t* rowp = O + (size_t)(row0 + ai * HALF + m * 16) * ldc + col0;
                const float rs = rowss ? 1.0f / sqrtf(rowss[row0 + ai * HALF + m * 16] * inv_n + eps) : 1.0f;
#pragma unroll
                for (int bj = 0; bj < 2; ++bj) { f32x4 v0 = acc[ai][bj][m][0] * rs, v1 = acc[ai][bj][m][1] * rs;
                    if (ACT == 2) {
#pragma unroll
                        for (int e = 0; e < 4; ++e) { float a = fmaxf(v0[e], 0.f), b = fmaxf(v1[e], 0.f); v0[e] = a * a; v1[e] = b * b; } }
                    u32x4 w; w.x = cvt_pk_bf16(v0[0], v0[1]); w.y = cvt_pk_bf16(v0[2], v0[3]); w.z = cvt_pk_bf16(v1[0], v1[1]); w.w = cvt_pk_bf16(v1[2], v1[3]);
                    *(u32x4*)(rowp + bj * HALF) = w; } }
    }
};
template <bool BASEBF> struct EpiRes {
    static constexpr bool PERM = true, AFTER_DRAIN = false;
    const void* base; float* out; int ldc; const float* sc_ss; float sc_inv_n, sc_eps;
    __device__ __forceinline__ void operator()(const f32x4 (&acc)[2][2][4][2], const Unit& u, int wr, int wc, int fr, int fq) const {
        const int row0 = u.pm * BM + wr * 64 + fr; const int col0 = u.pn * BM + wc * 32 + 8 * fq;
#pragma unroll
        for (int ai = 0; ai < 2; ++ai)
#pragma unroll
            for (int m = 0; m < 4; ++m) { const size_t off = (size_t)(row0 + ai * HALF + m * 16) * ldc + col0;
                const float sc = sc_ss ? 1.0f / (sc_ss[row0 + ai * HALF + m * 16] * sc_inv_n + sc_eps) : 1.0f;
#pragma unroll
                for (int bj = 0; bj < 2; ++bj) { f32x4 b0, b1;
                    if (BASEBF) { const u32x4 w = *(const u32x4*)((const bf16_t*)base + off + bj * HALF);
                        b0 = (f32x4){__uint_as_float(w.x << 16), __uint_as_float(w.x & 0xffff0000u), __uint_as_float(w.y << 16), __uint_as_float(w.y & 0xffff0000u)};
                        b1 = (f32x4){__uint_as_float(w.z << 16), __uint_as_float(w.z & 0xffff0000u), __uint_as_float(w.w << 16), __uint_as_float(w.w & 0xffff0000u)}; }
                    else { b0 = *(const f32x4*)((const float*)base + off + bj * HALF); b1 = *(const f32x4*)((const float*)base + off + bj * HALF + 4); }
                    *(f32x4*)(out + off + bj * HALF) = b0 + acc[ai][bj][m][0] * sc; *(f32x4*)(out + off + bj * HALF + 4) = b1 + acc[ai][bj][m][1] * sc; } }
    }
};
template <bool BASEBF> struct EpiResN {
    static constexpr bool PERM = true, AFTER_DRAIN = false;
    const void* base; bf16_t* xn; float* rowss; int ldc; const float* sc_ss; float sc_inv_n, sc_eps;
    __device__ __forceinline__ void operator()(const f32x4 (&acc)[2][2][4][2], const Unit& u, int wr, int wc, int fr, int fq) const {
        const int row0 = u.pm * BM + wr * 64 + fr; const int col0 = u.pn * BM + wc * 32 + 8 * fq;
#pragma unroll
        for (int ai = 0; ai < 2; ++ai)
#pragma unroll
            for (int m = 0; m < 4; ++m) { const int row = row0 + ai * HALF + m * 16; const size_t off = (size_t)row * ldc + col0; float ss = 0.f;
                const float sc = sc_ss ? 1.0f / (sc_ss[row] * sc_inv_n + sc_eps) : 1.0f;
#pragma unroll
                for (int bj = 0; bj < 2; ++bj) { f32x4 b0, b1;
                    if (BASEBF) { const u32x4 w = *(const u32x4*)((const bf16_t*)base + off + bj * HALF);
                        b0 = (f32x4){__uint_as_float(w.x << 16), __uint_as_float(w.x & 0xffff0000u), __uint_as_float(w.y << 16), __uint_as_float(w.y & 0xffff0000u)};
                        b1 = (f32x4){__uint_as_float(w.z << 16), __uint_as_float(w.z & 0xffff0000u), __uint_as_float(w.w << 16), __uint_as_float(w.w & 0xffff0000u)}; }
                    else { b0 = *(const f32x4*)((const float*)base + off + bj * HALF); b1 = *(const f32x4*)((const float*)base + off + bj * HALF + 4); }
                    const f32x4 o0 = b0 + acc[ai][bj][m][0] * sc, o1 = b1 + acc[ai][bj][m][1] * sc;
                    ss += ((o0[0] * o0[0] + o0[1] * o0[1]) + (o0[2] * o0[2] + o0[3] * o0[3])) + ((o1[0] * o1[0] + o1[1] * o1[1]) + (o1[2] * o1[2] + o1[3] * o1[3]));
                    u32x4 w; w.x = cvt_pk_bf16(o0[0], o0[1]); w.y = cvt_pk_bf16(o0[2], o0[3]); w.z = cvt_pk_bf16(o1[0], o1[1]); w.w = cvt_pk_bf16(o1[2], o1[3]);
                    *(u32x4*)(xn + off + bj * HALF) = w; }
                ss += __shfl_xor(ss, 16); ss += __shfl_xor(ss, 32);
                if (fq == 0) atomicAdd(rowss + row, ss); }
    }
};
struct EpiNone {
    static constexpr bool PERM = true, AFTER_DRAIN = false;
    __device__ __forceinline__ void operator()(const f32x4 (&acc)[2][2][4][2], const Unit& u, int wr, int wc, int fr, int fq) const {
#pragma unroll
        for (int ai = 0; ai < 2; ++ai)
#pragma unroll
            for (int bj = 0; bj < 2; ++bj)
#pragma unroll
                for (int m = 0; m < 4; ++m)
#pragma unroll
                    for (int n = 0; n < 2; ++n) asm volatile("" :: "v"(acc[ai][bj][m][n]));
    }
};
template <int ACT> struct EpiBL {
    static constexpr bool PERM = true, AFTER_DRAIN = false;
    static constexpr int ROWB = 528;
    bf16_t* O; int ldc; PG8_LAS unsigned char* est;
    __device__ __forceinline__ void operator()(const f32x4 (&acc)[2][2][4][2], const Unit& u, int wr, int wc, int fr, int fq) const {
        const int tid = (wr * 4 + wc) * 64 + fq * 16 + fr;
        PG8_LAS unsigned char* wp = est + (wr * 16 + fr) * ROWB + (wc * 32 + 8 * fq) * 2;
        const int rr = tid >> 5, ch = tid & 31;
        const PG8_LAS unsigned char* rp = est + rr * ROWB + ch * 16;
        bf16_t* gbase = O + (size_t)(u.pm * BM) * ldc + u.pn * BM + ch * 8;
#pragma unroll
        for (int ai = 0; ai < 2; ++ai)
#pragma unroll
            for (int m = 0; m < 4; ++m) {
#pragma unroll
                for (int bj = 0; bj < 2; ++bj) { f32x4 v0 = acc[ai][bj][m][0], v1 = acc[ai][bj][m][1];
                    if (ACT == 2) {
#pragma unroll
                        for (int q = 0; q < 4; ++q) { float a = fmaxf(v0[q], 0.f), b = fmaxf(v1[q], 0.f); v0[q] = a * a; v1[q] = b * b; } }
                    u32x4 w; w.x = cvt_pk_bf16(v0[0], v0[1]); w.y = cvt_pk_bf16(v0[2], v0[3]); w.z = cvt_pk_bf16(v1[0], v1[1]); w.w = cvt_pk_bf16(v1[2], v1[3]);
                    *(PG8_LAS u32x4*)(wp + bj * 256) = w; }
                asm volatile("s_waitcnt lgkmcnt(0)" ::: "memory"); __builtin_amdgcn_s_barrier(); asm volatile("" ::: "memory");
#pragma unroll
                for (int p = 0; p < 2; ++p) { const int r = p * 16 + rr;
                    const u32x4 v = *(const PG8_LAS u32x4*)(rp + p * 16 * ROWB);
                    *(u32x4*)(gbase + (size_t)(ai * HALF + (r >> 4) * 64 + m * 16 + (r & 15)) * ldc) = v; }
                asm volatile("s_waitcnt lgkmcnt(0)" ::: "memory"); __builtin_amdgcn_s_barrier(); asm volatile("" ::: "memory");
            }
    }
};
struct EpiQKV {
    static constexpr bool PERM = true, AFTER_DRAIN = false;
    bf16_t* SQ; long k_off, v_off; const float* rowss; float inv_n, eps; const float *gq, *gk; const float* tsw; int seq_shift;
    __device__ __forceinline__ void operator()(const f32x4 (&acc)[2][2][4][2], const Unit& u, int wr, int wc, int fr, int fq) const {
        const int pn = u.pn; const bool isv = pn == 9, isk = pn == 8;
        const float* g = gq; if (isk) g = gk;
        const int seq = 1 << seq_shift;
        long boff = 0; if (isk) boff = k_off; if (isv) boff = v_off;
        bf16_t* base = SQ + boff; const int nh = (isv || isk) ? 4 : 32, h = (isv || isk) ? wc : pn * 4 + wc;
        const float sg = fq ? 1.f : -1.f;
#pragma unroll
        for (int ai = 0; ai < 2; ++ai)
#pragma unroll
            for (int m = 0; m < 4; ++m) { const int t = u.pm * BM + ai * HALF + wr * 64 + m * 16 + fr; const int b = t >> seq_shift, s = t & (seq - 1);
                const float rs = 1.0f / sqrtf(rowss[t] * inv_n + eps);
                f32x4 x00 = acc[ai][0][m][0] * rs, x01 = acc[ai][0][m][1] * rs, x10 = acc[ai][1][m][0] * rs, x11 = acc[ai][1][m][1] * rs;
                if (!isv) {
                    float ss = ((x00[0] * x00[0] + x00[1] * x00[1]) + (x00[2] * x00[2] + x00[3] * x00[3])) + ((x01[0] * x01[0] + x01[1] * x01[1]) + (x01[2] * x01[2] + x01[3] * x01[3]))
                             + ((x10[0] * x10[0] + x10[1] * x10[1]) + (x10[2] * x10[2] + x10[3] * x10[3])) + ((x11[0] * x11[0] + x11[1] * x11[1]) + (x11[2] * x11[2] + x11[3] * x11[3]));
                    ss += __shfl_xor(ss, 16); ss += __shfl_xor(ss, 32);
                    const float hr = 1.0f / sqrtf(ss * (1.f / 64) + eps);
                    x00 = x00 * hr * *(const f32x4*)(g + 8 * fq); x01 = x01 * hr * *(const f32x4*)(g + 8 * fq + 4); x10 = x10 * hr * *(const f32x4*)(g + 32 + 8 * fq); x11 = x11 * hr * *(const f32x4*)(g + 36 + 8 * fq);
                    f32x4 p0, p1;
#pragma unroll
                    for (int q = 0; q < 4; ++q) { p0[q] = __shfl_xor(x00[q], 16); p1[q] = __shfl_xor(x01[q], 16); }
                    if (fq < 2) { const f32x4* cs = (const f32x4*)(tsw + (size_t)s * 16); const f32x4 c0 = cs[0], c1 = cs[1], c2 = cs[2], c3 = cs[3];
                        x00 = (f32x4){x00[0] * c0[0] + sg * p0[0] * c0[1], x00[1] * c0[2] + sg * p0[1] * c0[3], x00[2] * c1[0] + sg * p0[2] * c1[1], x00[3] * c1[2] + sg * p0[3] * c1[3]};
                        x01 = (f32x4){x01[0] * c2[0] + sg * p1[0] * c2[1], x01[1] * c2[2] + sg * p1[1] * c2[3], x01[2] * c3[0] + sg * p1[2] * c3[1], x01[3] * c3[2] + sg * p1[3] * c3[3]}; }
                }
                bf16_t* dst = base + ((size_t)(b * nh + h) * seq + s) * 64 + 8 * fq;
                u32x4 w; w.x = cvt_pk_bf16(x00[0], x00[1]); w.y = cvt_pk_bf16(x00[2], x00[3]); w.z = cvt_pk_bf16(x01[0], x01[1]); w.w = cvt_pk_bf16(x01[2], x01[3]);
                *(u32x4*)dst = w;
                w.x = cvt_pk_bf16(x10[0], x10[1]); w.y = cvt_pk_bf16(x10[2], x10[3]); w.z = cvt_pk_bf16(x11[0], x11[1]); w.w = cvt_pk_bf16(x11[2], x11[3]);
                *(u32x4*)(dst + 32) = w;
                asm volatile("" ::: "memory"); }
    }
};

template <class Epi, class Sched, bool ALIGN_EPI = false, bool SP2 = false>
__device__ __forceinline__ void gemm_phase(PG8_LAS unsigned char* lds, const Gemm g, const Sched& S, const Epi& E) {
    int tid = threadIdx.x; asm volatile("" : "+v"(tid));
    const int wid = __builtin_amdgcn_readfirstlane(tid >> 6), lane = tid & 63, wr = wid >> 2, wc = wid & 3, fr = lane & 15, fq = lane >> 4;
    const int K = g.K, nt = K / BK;
    unsigned voffA[2], voffB[2];
#pragma unroll
    for (int i = 0; i < 2; ++i) { int R, C; stage_rc(tid * 16 + i * 8192, R, C); const int Rb = Epi::PERM ? ((R & ~31) + perm32(R & 31)) : R;
        voffA[i] = (unsigned)(R * K + C) * 2u; voffB[i] = (unsigned)(Rb * K + C) * 2u; }
    const size_t kstep = (size_t)(BK * 2);
    const size_t hstep = (size_t)HALF * K * 2;
    const size_t tstep = 2 * hstep;
    const unsigned ldsw = (unsigned)wid * 1024u;
    const int aoff = lds_byte(wr * 64 + fr, fq * 8), boff = lds_byte(wc * 32 + fr, fq * 8);
#define PG8_SA(b, h) (((b) * 2 + (h)) * HTB)
#define PG8_SB(b, h) ((4 + (b) * 2 + (h)) * HTB)
#define PG8_STAGE(bufoff, gbase, voff) do { _Pragma("unroll") for (int _i = 0; _i < 2; ++_i) \
        __builtin_amdgcn_global_load_lds((const unsigned*)((const char*)(gbase) + (voff)[_i]), (PG8_LAS unsigned*)(lds + (bufoff) + ldsw + _i * 8192), 16, 0, 0); } while (0)
#define PG8_LDA(dst, b, h) do { _Pragma("unroll") for (int m = 0; m < 4; ++m) _Pragma("unroll") for (int k = 0; k < 2; ++k) dst[m][k] = *(const PG8_LAS bf16x8*)(lds + PG8_SA(b, h) + aoff + m * 2048 + k * 1024); } while (0)
#define PG8_LDB(dst, b, h) do { _Pragma("unroll") for (int n = 0; n < 2; ++n) _Pragma("unroll") for (int k = 0; k < 2; ++k) dst[n][k] = *(const PG8_LAS bf16x8*)(lds + PG8_SB(b, h) + boff + n * 2048 + k * 1024); } while (0)
#define PG8_MMA(ai, bj, At, Bt) do { __builtin_amdgcn_s_setprio(1); _Pragma("unroll") for (int m = 0; m < 4; ++m) _Pragma("unroll") for (int n = 0; n < 2; ++n) _Pragma("unroll") for (int k = 0; k < 2; ++k) \
        acc[ai][bj][m][n] = __builtin_amdgcn_mfma_f32_16x16x32_bf16(Bt[n][k], At[m][k], acc[ai][bj][m][n], 0, 0, 0); __builtin_amdgcn_s_setprio(0); } while (0)
#define PG8_WAIT_V(n) asm volatile("s_waitcnt vmcnt(" #n ")" ::: "memory")
#define PG8_WAIT_L(n) asm volatile("s_waitcnt lgkmcnt(" #n ")" ::: "memory")
#define PG8_BAR __builtin_amdgcn_s_barrier()
#define PG8_SCHED __builtin_amdgcn_sched_barrier(0)
    Unit cur, nxt; int ui = 0;
    if (!S.next(0, cur)) return;
    f32x4 acc[2][2][4][2];
#pragma unroll
    for (int a = 0; a < 2; ++a)
#pragma unroll
        for (int b = 0; b < 2; ++b)
#pragma unroll
            for (int m = 0; m < 4; ++m)
#pragma unroll
                for (int n = 0; n < 2; ++n) acc[a][b][m][n] = (f32x4){0.f, 0.f, 0.f, 0.f};
    bf16x8 At[4][2], B0[2][2], B1[2][2];
    const char* cA = (const char*)g.A + (size_t)cur.pm * tstep; const char* cB = (const char*)g.Bt + (size_t)cur.pn * tstep;
    S.a_ready(cur);
    if constexpr (SP2) {
        PG8_STAGE(PG8_SB(0, 0), cB, voffB); PG8_STAGE(PG8_SB(0, 1), cB + hstep, voffB); PG8_STAGE(PG8_SA(0, 0), cA, voffA); PG8_STAGE(PG8_SA(0, 1), cA + hstep, voffA);
        if (wr == 1) PG8_BAR;
        PG8_WAIT_V(2); PG8_BAR;
        PG8_STAGE(PG8_SB(1, 0), cB + kstep, voffB); PG8_STAGE(PG8_SA(1, 0), cA + kstep, voffA); PG8_STAGE(PG8_SB(1, 1), cB + hstep + kstep, voffB);
        PG8_WAIT_V(6); PG8_BAR;
    } else {
        PG8_STAGE(PG8_SB(0, 0), cB, voffB); PG8_STAGE(PG8_SA(0, 0), cA, voffA); PG8_STAGE(PG8_SB(0, 1), cB + hstep, voffB); PG8_STAGE(PG8_SA(0, 1), cA + hstep, voffA);
        if (wr == 1) PG8_BAR;
        PG8_WAIT_V(4); PG8_BAR;
        PG8_STAGE(PG8_SB(1, 0), cB + kstep, voffB); PG8_STAGE(PG8_SA(1, 0), cA + kstep, voffA); PG8_STAGE(PG8_SB(1, 1), cB + hstep + kstep, voffB);
        PG8_WAIT_V(6); PG8_BAR;
    }
    for (;;) {
        const bool has_next = S.next(ui + 1, nxt);
        const char* nA = has_next ? (const char*)g.A + (size_t)nxt.pm * tstep : cA; const char* nB = has_next ? (const char*)g.Bt + (size_t)nxt.pn * tstep : cB;
        for (int t = 0; t < nt; t += 2) {
            const bool last = (t == nt - 2);
            const char* a1 = cA + (size_t)(t + 1) * kstep;
            const char* a2 = last ? nA : cA + (size_t)(t + 2) * kstep; const char* b2 = last ? nB : cB + (size_t)(t + 2) * kstep;
            const char* a3 = a2 + kstep; const char* b3 = b2 + kstep;
            if (last && has_next) S.a_ready(nxt);
            if constexpr (SP2) {
            PG8_LDB(B0, 0, 0); PG8_LDB(B1, 0, 1); PG8_SCHED; PG8_LDA(At, 0, 0); PG8_STAGE(PG8_SA(1, 1), a1 + hstep, voffA);
            PG8_WAIT_V(8); PG8_WAIT_L(0); PG8_BAR; PG8_MMA(0, 0, At, B0); PG8_MMA(0, 1, At, B1); PG8_BAR; PG8_SCHED;
            PG8_LDA(At, 0, 1); PG8_STAGE(PG8_SB(0, 0), b2, voffB); PG8_STAGE(PG8_SB(0, 1), b2 + hstep, voffB); PG8_STAGE(PG8_SA(0, 0), a2, voffA);
            PG8_WAIT_V(8); PG8_WAIT_L(0); PG8_BAR; PG8_MMA(1, 0, At, B0); PG8_MMA(1, 1, At, B1); PG8_BAR; PG8_SCHED;
            PG8_LDB(B0, 1, 0); PG8_LDB(B1, 1, 1); PG8_SCHED; PG8_LDA(At, 1, 0); PG8_STAGE(PG8_SA(0, 1), a2 + hstep, voffA);
            PG8_WAIT_V(8); PG8_WAIT_L(0); PG8_BAR; PG8_MMA(0, 0, At, B0); PG8_MMA(0, 1, At, B1); PG8_BAR; PG8_SCHED;
            PG8_LDA(At, 1, 1); PG8_STAGE(PG8_SB(1, 0), b3, voffB); PG8_STAGE(PG8_SB(1, 1), b3 + hstep, voffB); PG8_STAGE(PG8_SA(1, 0), a3, voffA);
            PG8_WAIT_V(8); PG8_WAIT_L(0); PG8_BAR; PG8_MMA(1, 0, At, B0); PG8_MMA(1, 1, At, B1); PG8_BAR; PG8_SCHED;
            } else {
            PG8_LDB(B0, 0, 0); PG8_SCHED; PG8_LDA(At, 0, 0); PG8_STAGE(PG8_SA(1, 1), a1 + hstep, voffA);
            PG8_WAIT_L(8); PG8_BAR; PG8_WAIT_L(0); PG8_MMA(0, 0, At, B0); PG8_BAR; PG8_SCHED;
            PG8_LDB(B1, 0, 1); PG8_STAGE(PG8_SB(0, 0), b2, voffB);
            PG8_BAR; PG8_WAIT_L(0); PG8_MMA(0, 1, At, B1); PG8_BAR;
            PG8_LDA(At, 0, 1); PG8_STAGE(PG8_SA(0, 0), a2, voffA);
            PG8_BAR; PG8_WAIT_L(0); PG8_MMA(1, 0, At, B0); PG8_BAR; PG8_SCHED;
            PG8_STAGE(PG8_SB(0, 1), b2 + hstep, voffB);
            PG8_WAIT_V(6); PG8_BAR; PG8_MMA(1, 1, At, B1); PG8_BAR;
            PG8_LDB(B0, 1, 0); PG8_SCHED; PG8_LDA(At, 1, 0); PG8_STAGE(PG8_SA(0, 1), a2 + hstep, voffA);
            PG8_WAIT_L(8); PG8_BAR; PG8_WAIT_L(0); PG8_MMA(0, 0, At, B0); PG8_BAR; PG8_SCHED;
            PG8_LDB(B1, 1, 1); PG8_STAGE(PG8_SB(1, 0), b3, voffB);
            PG8_BAR; PG8_WAIT_L(0); PG8_MMA(0, 1, At, B1); PG8_BAR;
            PG8_LDA(At, 1, 1); PG8_STAGE(PG8_SA(1, 0), a3, voffA);
            PG8_BAR; PG8_WAIT_L(0); PG8_MMA(1, 0, At, B0); PG8_BAR; PG8_SCHED;
            PG8_STAGE(PG8_SB(1, 1), b3 + hstep, voffB);
            PG8_WAIT_V(6); PG8_BAR; PG8_MMA(1, 1, At, B1); PG8_BAR;
            }
        }
        if constexpr (ALIGN_EPI) { if (wr == 0) PG8_BAR; }
        if constexpr (!Epi::AFTER_DRAIN) { E(acc, cur, wr, wc, fr, fq); S.done(cur); }
        if (!has_next) break;
#pragma unroll
        for (int a = 0; a < 2; ++a)
#pragma unroll
            for (int b = 0; b < 2; ++b)
#pragma unroll
                for (int m = 0; m < 4; ++m)
#pragma unroll
                    for (int n = 0; n < 2; ++n) acc[a][b][m][n] = (f32x4){0.f, 0.f, 0.f, 0.f};
        cur = nxt; cA = nA; cB = nB; ++ui;
        if constexpr (ALIGN_EPI) { if (wr == 1) PG8_BAR; }
    }
    PG8_WAIT_V(0);
    if constexpr (!ALIGN_EPI) { if (wr == 0) PG8_BAR; }
    PG8_BAR;
    if constexpr (Epi::AFTER_DRAIN) { E.fused(acc, cur, wr, wc, fr, fq, lds, wid, lane); S.done(cur); }
#undef PG8_SA
#undef PG8_SB
#undef PG8_STAGE
#undef PG8_LDA
#undef PG8_LDB
#undef PG8_MMA
#undef PG8_WAIT_V
#undef PG8_WAIT_L
#undef PG8_BAR
#undef PG8_SCHED
}
}

namespace att {
typedef unsigned short bf16;
using bf16x8 = __attribute__((ext_vector_type(8))) short;
using s16x4  = __attribute__((ext_vector_type(4))) short;
using f32x16 = __attribute__((ext_vector_type(16))) float;
using u32x4  = __attribute__((ext_vector_type(4))) unsigned;
constexpr int NW = 8, QBLK = 32, KVBLK = 64;
#define SBAR() __builtin_amdgcn_sched_barrier(0)
__device__ __forceinline__ int crow(int r, int hi) { return (r & 3) + 8 * (r >> 2) + 4 * hi; }
__device__ __forceinline__ unsigned cvtpk(float lo, float hi) { unsigned r; asm volatile("v_cvt_pk_bf16_f32 %0, %1, %2" : "=v"(r) : "v"(lo), "v"(hi)); return r; }
template <int DK> __device__ __forceinline__ int kswz(int row, int colB) { const int f = (DK == 128) ? ((row & 7) | ((row & 16) >> 1)) : ((row >> 1) & 7); return row * (DK * 2) + (colB ^ (f << 4)); }

__device__ __forceinline__ void partialSM(f32x16& p0, f32x16& p1, float& m_reg, float& mn, float& alpha, const float C, const float thr_raw) {
  float pmax = p0[0];
#pragma unroll
  for (int r = 1; r < 16; ++r) pmax = fmaxf(pmax, p0[r]);
#pragma unroll
  for (int r = 0; r < 16; ++r) pmax = fmaxf(pmax, p1[r]);
  { auto rr = __builtin_amdgcn_permlane32_swap(__float_as_uint(pmax), __float_as_uint(pmax), false, false);
    pmax = fmaxf(__uint_as_float(rr[0]), __uint_as_float(rr[1])); }
  if (__builtin_expect(__all(pmax - m_reg <= thr_raw), 1)) { mn = m_reg; alpha = 1.f; }
  else { mn = fmaxf(m_reg, pmax); alpha = __builtin_amdgcn_exp2f((m_reg - mn) * C); m_reg = mn; }
  float mnC = -mn * C;
#pragma unroll
  for (int r = 0; r < 16; ++r) p0[r] = fmaf(p0[r], C, mnC);
#pragma unroll
  for (int r = 0; r < 16; ++r) p1[r] = fmaf(p1[r], C, mnC);
#pragma unroll
  for (int r = 0; r < 16; ++r) p0[r] = __builtin_amdgcn_exp2f(p0[r]);
}
__device__ __forceinline__ void finishSM(f32x16& p0, f32x16& p1, float alpha, float& l_reg, bf16x8& pa0, bf16x8& pa1, bf16x8& pa2, bf16x8& pa3) {
#pragma unroll
  for (int r = 0; r < 16; ++r) p1[r] = __builtin_amdgcn_exp2f(p1[r]);
  float ps = 0;
#pragma unroll
  for (int r = 0; r < 16; ++r) ps += p0[r];
#pragma unroll
  for (int r = 0; r < 16; ++r) ps += p1[r];
  { auto rr = __builtin_amdgcn_permlane32_swap(__float_as_uint(ps), __float_as_uint(ps), false, false);
    ps = __uint_as_float(rr[0]) + __uint_as_float(rr[1]); }
  l_reg = l_reg * alpha + ps;
#define PK4(P, BASE, OUT) do { unsigned a0 = cvtpk(P[BASE + 0], P[BASE + 1]), a1 = cvtpk(P[BASE + 2], P[BASE + 3]);   \
    unsigned b0 = cvtpk(P[BASE + 4], P[BASE + 5]), b1 = cvtpk(P[BASE + 6], P[BASE + 7]);                              \
    auto r0 = __builtin_amdgcn_permlane32_swap(a0, b0, false, false); auto r1 = __builtin_amdgcn_permlane32_swap(a1, b1, false, false); \
    u32x4 w = {r0[0], r1[0], r0[1], r1[1]}; OUT = *reinterpret_cast<bf16x8*>(&w); } while (0)
  PK4(p0, 0, pa0); PK4(p0, 8, pa1); PK4(p1, 0, pa2); PK4(p1, 8, pa3);
#undef PK4
}
template <int DK, int GS> __device__ __forceinline__ void qkt(f32x16& p0, f32x16& p1, const char* Ks, const int (&kb)[4], const int (&kbx)[4], const bf16x8* qr) {
  constexpr int ND = DK / 16, NG = ND / GS;
  static_assert(ND % GS == 0, "group size");
  p0 = f32x16{}; p1 = f32x16{};
  bf16x8 fa[2][GS], fb[2][GS];
#define QK_RD(buf, g) do { _Pragma("unroll") for (int s_ = 0; s_ < GS; ++s_) { const int d0_ = (g) * GS + s_, e_ = d0_ & 3, gg_ = d0_ >> 2; \
      const int ko_ = (DK == 128) ? (gg_ ? kbx[e_] : kb[e_]) : (kb[e_] + gg_ * 128); \
      fa[buf][s_] = *reinterpret_cast<const bf16x8*>(Ks + ko_); fb[buf][s_] = *reinterpret_cast<const bf16x8*>(Ks + ko_ + 32 * DK * 2); } } while (0)
  QK_RD(0, 0);
#pragma unroll
  for (int g = 0; g < NG; ++g) {
    if (g + 1 < NG) { QK_RD((g + 1) & 1, g + 1); }
    SBAR();
#pragma unroll
    for (int s_ = 0; s_ < GS; ++s_) {
      p0 = __builtin_amdgcn_mfma_f32_32x32x16_bf16(fa[g & 1][s_], qr[g * GS + s_], p0, 0, 0, 0);
      p1 = __builtin_amdgcn_mfma_f32_32x32x16_bf16(fb[g & 1][s_], qr[g * GS + s_], p1, 0, 0, 0); }
    SBAR();
  }
#undef QK_RD
}
template <int NCB> __device__ __forceinline__ int v_st(int k, int c) { const int kk = (k & ~0xC) | ((k & 4) << 1) | ((k & 8) >> 1); return ((kk >> 3) * NCB + (c >> 5)) * 512 + ((kk & 7) * 32 + (c & 31)) * 2; }
__device__ __forceinline__ int v_rd_base(int lane) { return ((lane & 3) << 3) | (((lane >> 2) & 3) << 6) | (((lane >> 4) & 1) << 5) | (((lane >> 5) & 1) << 8); }
template <int OFF> __device__ __forceinline__ s16x4 tr_read(int vb) {
  s16x4 r; asm volatile("ds_read_b64_tr_b16 %0, %1 offset:%2" : "=&v"(r) : "v"(vb), "i"(OFF) : "memory"); return r;
}
template <int D0, int NCB> __device__ __forceinline__ void pv_one(f32x16& od, int vb, bf16x8 pa0, bf16x8 pa1, bf16x8 pa2, bf16x8 pa3) {
#define VOFF(ks, half) (D0 * 512 + (ks) * (1024 * NCB) + (half) * (512 * NCB))
  const s16x4 l0 = tr_read<VOFF(0, 0)>(vb), h0 = tr_read<VOFF(0, 1)>(vb), l1 = tr_read<VOFF(1, 0)>(vb), h1 = tr_read<VOFF(1, 1)>(vb);
  const s16x4 l2 = tr_read<VOFF(2, 0)>(vb), h2 = tr_read<VOFF(2, 1)>(vb), l3 = tr_read<VOFF(3, 0)>(vb), h3 = tr_read<VOFF(3, 1)>(vb);
#undef VOFF
  asm volatile("s_waitcnt lgkmcnt(0)" ::: "memory"); SBAR();
#define PK(L, H) (bf16x8){L[0], L[1], L[2], L[3], H[0], H[1], H[2], H[3]}
  od = __builtin_amdgcn_mfma_f32_32x32x16_bf16(pa0, PK(l0, h0), od, 0, 0, 0);
  od = __builtin_amdgcn_mfma_f32_32x32x16_bf16(pa1, PK(l1, h1), od, 0, 0, 0);
  od = __builtin_amdgcn_mfma_f32_32x32x16_bf16(pa2, PK(l2, h2), od, 0, 0, 0);
  od = __builtin_amdgcn_mfma_f32_32x32x16_bf16(pa3, PK(l3, h3), od, 0, 0, 0);
#undef PK
}
template <int NCB> __device__ __forceinline__ void pv_all(f32x16* o, int vb, bf16x8 pa0, bf16x8 pa1, bf16x8 pa2, bf16x8 pa3) {
  pv_one<0, NCB>(o[0], vb, pa0, pa1, pa2, pa3); pv_one<1, NCB>(o[1], vb, pa0, pa1, pa2, pa3);
  if constexpr (NCB == 4) { pv_one<2, NCB>(o[2], vb, pa0, pa1, pa2, pa3); pv_one<3, NCB>(o[3], vb, pa0, pa1, pa2, pa3); }
}

template <int DK, int DV, bool SWA, bool TWO, int GS>
__device__ __forceinline__ void attn_unit(const bf16* __restrict__ Qrow, const bf16* __restrict__ Kh, const bf16* __restrict__ Vh, bf16* __restrict__ Ow, const int ldo,
                                          const int kstart, const int NT, const int qpos, const int seq, const int win,
                                          const float m_init, const float l_init, const float C, const float thr_raw, char* lds) {
  constexpr int NCB = DV / 32, SHM_V = KVBLK * DV * 2, SHM_K = KVBLK * DK * 2, KCH = DK / 8, VCH = DV / 8, NKC = DK / 64, NVC = DV / 64;
  int tid = threadIdx.x; asm volatile("" : "+v"(tid));
  const int wid = tid >> 6, lane = tid & 63, r32 = lane & 31, hi = lane >> 5;
  char* V_lds = lds; char* K_lds = lds + 2 * SHM_V;
  float* ws = (float*)(lds + 2 * SHM_V + 2 * SHM_K) + wid * 64; float* li_l = ws; float* al_l = ws + 32;
  float m_reg = m_init, l_reg = l_init; f32x16 o[NCB]; bf16x8 qr[DK / 16];
#pragma unroll
  for (int d = 0; d < NCB; ++d) o[d] = f32x16{};
#pragma unroll
  for (int d0 = 0; d0 < DK / 16; ++d0) qr[d0] = *reinterpret_cast<const bf16x8*>(Qrow + d0 * 16 + hi * 8);
  unsigned koff[NKC], voff[NVC]; int kdst[NKC], vdst[NVC], krow0 = 0;
#pragma unroll
  for (int i = 0; i < NKC; ++i) { const int c = tid + 512 * i, row = c / KCH, col = (c % KCH) * 8; koff[i] = (unsigned)(row * DK + col) * 2u; kdst[i] = kswz<DK>(row, col * 2); if (i == 0) krow0 = row; }
#pragma unroll
  for (int i = 0; i < NVC; ++i) { const int c = tid + 512 * i, row = c / VCH, col = (c % VCH) * 8; voff[i] = (unsigned)(row * DV + col) * 2u; vdst[i] = v_st<NCB>(row, col); }
  const int vb0 = (int)(uintptr_t)V_lds + v_rd_base(lane);
  int kb[4], kbx[4];
#pragma unroll
  for (int e = 0; e < 4; ++e) { kb[e] = kswz<DK>(r32, (e * 16 + hi * 8) * 2); kbx[e] = kb[e] ^ 128; }
  bf16x8 ks[NKC], vs[NVC], ks2[NKC], vs2[NVC];
#define SLOADX(ks, vs, k0) do { if constexpr (SWA) { static_assert(!SWA || (NKC == 1 && NVC == 1 && DK == DV), "SWA path: one chunk per thread"); \
      const int kr_ = min(max((k0) + krow0, 0), seq - 1) - krow0; const char* Kt = (const char*)Kh + (long)kr_ * (DK * 2); const char* Vt = (const char*)Vh + (long)kr_ * (DV * 2); \
      vs[0] = *reinterpret_cast<const bf16x8*>(Vt + voff[0]); ks[0] = *reinterpret_cast<const bf16x8*>(Kt + koff[0]); } \
    else { const char* Kt = (const char*)Kh + (long)(k0) * (DK * 2); const char* Vt = (const char*)Vh + (long)(k0) * (DV * 2); \
      _Pragma("unroll") for (int i = 0; i < NVC; ++i) vs[i] = *reinterpret_cast<const bf16x8*>(Vt + voff[i]); \
      _Pragma("unroll") for (int i = 0; i < NKC; ++i) ks[i] = *reinterpret_cast<const bf16x8*>(Kt + koff[i]); } } while (0)
#define SWRITEX(ks, vs, b) do { _Pragma("unroll") for (int i = 0; i < NVC; ++i) *(bf16x8*)(V_lds + (b) * SHM_V + vdst[i]) = vs[i]; \
    _Pragma("unroll") for (int i = 0; i < NKC; ++i) *(bf16x8*)(K_lds + (b) * SHM_K + kdst[i]) = ks[i]; } while (0)
#define SLOAD(k0) SLOADX(ks, vs, k0)
#define SWRITE(b) SWRITEX(ks, vs, b)
#define SWAIT() asm volatile("s_waitcnt vmcnt(0)" ::: "memory")
#define RESC(a) do { if (__any((a) < 1.f)) { if (hi == 0) al_l[r32] = (a); asm volatile("s_waitcnt lgkmcnt(0)" ::: "memory"); \
    _Pragma("unroll") for (int d = 0; d < NCB; ++d) _Pragma("unroll") for (int r = 0; r < 16; ++r) o[d][r] *= al_l[crow(r, hi)]; } } while (0)
#define MASK(P0, P1, k0) do { if constexpr (SWA) { const int kb = (k0) + 4 * hi; \
    _Pragma("unroll") for (int r = 0; r < 16; ++r) { const int kv = kb + (r & 3) + 8 * (r >> 2); const int dq = qpos - kv; \
      if (!(dq <= win && dq >= -win && kv >= 0 && kv < seq)) P0[r] = -INFINITY; \
      const int kv2 = kv + 32, dq2 = qpos - kv2; if (!(dq2 <= win && dq2 >= -win && kv2 >= 0 && kv2 < seq)) P1[r] = -INFINITY; } } } while (0)
  f32x16 pA0, pA1, pB0, pB1; float mnA, mnB, alA, alB; bf16x8 pa0, pa1, pa2, pa3;
  if constexpr (TWO) {
  SLOAD(kstart); SWAIT(); SWRITE(0); __syncthreads();
  qkt<DK, GS>(pA0, pA1, K_lds, kb, kbx, qr); MASK(pA0, pA1, kstart); partialSM(pA0, pA1, m_reg, mnA, alA, C, thr_raw);
  SLOAD(kstart + KVBLK);
  SWAIT(); SWRITE(1); __syncthreads();
  for (int j = 1; j + 1 < NT; j += 2) {
    SBAR(); qkt<DK, GS>(pB0, pB1, K_lds + SHM_K, kb, kbx, qr);
    finishSM(pA0, pA1, alA, l_reg, pa0, pa1, pa2, pa3); SBAR();
    SLOAD(kstart + (j + 1) * KVBLK); SBAR();
    pv_all<NCB>(o, vb0, pa0, pa1, pa2, pa3); MASK(pB0, pB1, kstart + j * KVBLK); partialSM(pB0, pB1, m_reg, mnB, alB, C, thr_raw);
    __syncthreads(); SWAIT(); SWRITE(0);
    RESC(alB); __syncthreads();
    SBAR(); qkt<DK, GS>(pA0, pA1, K_lds, kb, kbx, qr);
    finishSM(pB0, pB1, alB, l_reg, pa0, pa1, pa2, pa3); SBAR();
    SLOAD(kstart + (j + 2) * KVBLK); SBAR();
    pv_all<NCB>(o, vb0 + SHM_V, pa0, pa1, pa2, pa3); MASK(pA0, pA1, kstart + (j + 1) * KVBLK); partialSM(pA0, pA1, m_reg, mnA, alA, C, thr_raw);
    __syncthreads(); SWAIT(); SWRITE(1);
    RESC(alA); __syncthreads();
  }
  SBAR(); qkt<DK, GS>(pB0, pB1, K_lds + SHM_K, kb, kbx, qr);
  finishSM(pA0, pA1, alA, l_reg, pa0, pa1, pa2, pa3); SBAR();
  pv_all<NCB>(o, vb0, pa0, pa1, pa2, pa3); MASK(pB0, pB1, kstart + (NT - 1) * KVBLK); partialSM(pB0, pB1, m_reg, mnB, alB, C, thr_raw);
  RESC(alB);
  finishSM(pB0, pB1, alB, l_reg, pa0, pa1, pa2, pa3); SBAR();
  pv_all<NCB>(o, vb0 + SHM_V, pa0, pa1, pa2, pa3);
  } else {
#define TILE(bsel, jj) do { SBAR(); qkt<DK, GS>(pA0, pA1, K_lds + (bsel) * SHM_K, kb, kbx, qr); MASK(pA0, pA1, kstart + (jj) * KVBLK); partialSM(pA0, pA1, m_reg, mnA, alA, C, thr_raw); \
      RESC(alA); finishSM(pA0, pA1, alA, l_reg, pa0, pa1, pa2, pa3); SBAR(); pv_all<NCB>(o, vb0 + (bsel) * SHM_V, pa0, pa1, pa2, pa3); SBAR(); } while (0)
    SLOADX(ks, vs, kstart); SBAR(); SLOADX(ks2, vs2, kstart + KVBLK); SBAR();
    SWRITEX(ks, vs, 0); SBAR();
    SLOADX(ks, vs, kstart + 2 * KVBLK); SBAR();
    __syncthreads();
    for (int j = 0; j < NT; j += 2) {
      TILE(0, j);
      SWRITEX(ks2, vs2, 1); SBAR();
      if (j + 3 < NT) { SLOADX(ks2, vs2, kstart + (j + 3) * KVBLK); } SBAR();
      __syncthreads();
      TILE(1, j + 1);
      if (j + 2 < NT) { SWRITEX(ks, vs, 0); SBAR(); if (j + 4 < NT) { SLOADX(ks, vs, kstart + (j + 4) * KVBLK); } SBAR(); }
      __syncthreads();
    }
#undef TILE
  }
  if (hi == 0) li_l[r32] = l_reg; asm volatile("s_waitcnt lgkmcnt(0)" ::: "memory");
  float rli[16];
#pragma unroll
  for (int r = 0; r < 16; ++r) rli[r] = __builtin_amdgcn_rcpf(li_l[crow(r, hi)]);
  __syncthreads();
  { bf16* stg = (bf16*)lds + wid * (QBLK * DV);
#pragma unroll
    for (int r = 0; r < 16; ++r) { const int orow = crow(r, hi);
#pragma unroll
      for (int d0 = 0; d0 < NCB; ++d0) stg[orow * DV + d0 * 32 + r32] = (bf16)(cvtpk(o[d0][r] * rli[r], 0.f) & 0xffffu); }
    asm volatile("s_waitcnt lgkmcnt(0)" ::: "memory");
#pragma unroll
    for (int i = 0; i < (QBLK * VCH) / 64; ++i) { const int idx = i * 64 + lane, row = idx / VCH, ch = idx % VCH;
      const u32x4 v = *(const u32x4*)(stg + row * DV + ch * 8); *(u32x4*)(Ow + (long)row * ldo + ch * 8) = v; } }
  __syncthreads();
#undef SLOAD
#undef SLOADX
#undef SWRITEX
#undef SWRITE
#undef SWAIT
#undef RESC
#undef MASK
}
template <int NT, int NSUB>
__device__ __forceinline__ void swa_unit(const bf16* __restrict__ Qrow, const bf16* __restrict__ Kh, const bf16* __restrict__ Vh, bf16* __restrict__ Ow, const int ldo,
                                         const int kstart, const int qpos0, const int seq, const int win,
                                         const float m_init, const float C, const float thr_raw, char* lds) {
  constexpr int DK = 64, DV = 64, NCB = 2, SHM = KVBLK * 64 * 2, VCH = 8;
  int tid = threadIdx.x; asm volatile("" : "+v"(tid));
  const int wid = tid >> 6, lane = tid & 63, r32 = lane & 31, hi = lane >> 5;
  char* V_lds = lds; char* K_lds = lds + NT * SHM;
  float* ws = (float*)(lds + 2 * NT * SHM) + wid * 64; float* li_l = ws; float* al_l = ws + 32;
  bf16* stg = (bf16*)(lds + 2 * NT * SHM + NW * 256) + wid * (QBLK * DV);
  const int row = tid >> 3, col = (tid & 7) * 8;
  const int kdst = kswz<DK>(row, col * 2), vdst = v_st<NCB>(row, col);
  const int vb0 = (int)(uintptr_t)V_lds + v_rd_base(lane);
  int kb[4], kbx[4];
#pragma unroll
  for (int e = 0; e < 4; ++e) { kb[e] = kswz<DK>(r32, (e * 16 + hi * 8) * 2); kbx[e] = kb[e]; }
  { bf16x8 ksr[NT], vsr[NT];
#pragma unroll
    for (int t = 0; t < NT; ++t) { const int kr = min(max(kstart + t * KVBLK + row, 0), seq - 1);
      ksr[t] = *reinterpret_cast<const bf16x8*>(Kh + (long)kr * DK + col); vsr[t] = *reinterpret_cast<const bf16x8*>(Vh + (long)kr * DV + col); }
#pragma unroll
    for (int t = 0; t < NT; ++t) { *(bf16x8*)(K_lds + t * SHM + kdst) = ksr[t]; *(bf16x8*)(V_lds + t * SHM + vdst) = vsr[t]; } }
  __syncthreads();
#pragma unroll 1
  for (int sub = 0; sub < NSUB; ++sub) {
    const int qpos = qpos0 + sub * QBLK;
    float m_reg = m_init, l_reg = 1.f; f32x16 o[NCB]; bf16x8 qr[4];
    o[0] = f32x16{}; o[1] = f32x16{};
#pragma unroll
    for (int d0 = 0; d0 < 4; ++d0) qr[d0] = *reinterpret_cast<const bf16x8*>(Qrow + (long)sub * QBLK * DK + d0 * 16 + hi * 8);
    f32x16 p0, p1; float mn, al; bf16x8 pa0, pa1, pa2, pa3;
#pragma unroll
    for (int t = 0; t < NT; ++t) {
      const int k0 = kstart + t * KVBLK;
      SBAR(); qkt<DK, 2>(p0, p1, K_lds + t * SHM, kb, kbx, qr);
      { const int kbase = k0 + 4 * hi;
#pragma unroll
        for (int r = 0; r < 16; ++r) { const int kv = kbase + (r & 3) + 8 * (r >> 2); const int dq = qpos - kv;
          if (!(dq <= win && dq >= -win && kv >= 0 && kv < seq)) p0[r] = -INFINITY;
          const int kv2 = kv + 32, dq2 = qpos - kv2; if (!(dq2 <= win && dq2 >= -win && kv2 >= 0 && kv2 < seq)) p1[r] = -INFINITY; } }
      partialSM(p0, p1, m_reg, mn, al, C, thr_raw);
      if (__any(al < 1.f)) { if (hi == 0) al_l[r32] = al; asm volatile("s_waitcnt lgkmcnt(0)" ::: "memory");
#pragma unroll
        for (int d = 0; d < NCB; ++d)
#pragma unroll
          for (int r = 0; r < 16; ++r) o[d][r] *= al_l[crow(r, hi)]; }
      finishSM(p0, p1, al, l_reg, pa0, pa1, pa2, pa3); SBAR();
      pv_all<NCB>(o, vb0 + t * SHM, pa0, pa1, pa2, pa3);
    }
    if (hi == 0) li_l[r32] = l_reg; asm volatile("s_waitcnt lgkmcnt(0)" ::: "memory");
    float rli[16];
#pragma unroll
    for (int r = 0; r < 16; ++r) rli[r] = __builtin_amdgcn_rcpf(li_l[crow(r, hi)]);
#pragma unroll
    for (int r = 0; r < 16; ++r) { const int orow = crow(r, hi);
#pragma unroll
      for (int d0 = 0; d0 < NCB; ++d0) stg[orow * DV + d0 * 32 + r32] = (bf16)(cvtpk(o[d0][r] * rli[r], 0.f) & 0xffffu); }
    asm volatile("s_waitcnt lgkmcnt(0)" ::: "memory");
#pragma unroll
    for (int i = 0; i < (QBLK * VCH) / 64; ++i) { const int idx = i * 64 + lane, rw = idx / VCH, ch = idx % VCH;
      const u32x4 v = *(const u32x4*)(stg + rw * DV + ch * 8); *(u32x4*)(Ow + (long)(sub * QBLK + rw) * ldo + ch * 8) = v; }
    asm volatile("s_waitcnt lgkmcnt(0)" ::: "memory");
  }
  __syncthreads();
}
#undef SBAR
}

#define LAS __attribute__((address_space(3)))
typedef unsigned short bf16;
typedef unsigned v4u __attribute__((ext_vector_type(4)));
typedef unsigned v2u __attribute__((ext_vector_type(2)));
typedef float f32x4 __attribute__((ext_vector_type(4)));
typedef float f32x2 __attribute__((ext_vector_type(2)));
constexpr int NWAVES = 8;
constexpr int BATCH = 2, SEQ = 8192, T = BATCH * SEQ, DM = 2048, DFF = 8192;
constexpr int EVEN_IN = 2368, EVEN_IN_P = 2560, ODD_IN = 2560;
constexpr float EPS = 1e-6f;
constexpr size_t MiB = 1u << 20;
constexpr size_t WS_WIN = 1 * MiB, WS_WUQ = 11 * MiB, WS_WUKV = 13 * MiB, WS_WOE = 14 * MiB, WS_WUP = 22 * MiB, WS_WDN = 54 * MiB;
constexpr size_t WS_WQKV = 487 * MiB, WS_WOO = 497 * MiB;
constexpr size_t WS_TMLA = 86 * MiB, WS_TAX = 88 * MiB, WS_TSWA = 92 * MiB;
constexpr size_t WS_XN = 93 * MiB;
constexpr size_t WS_CNT = 48 * 1024;
constexpr size_t WS_ROWSS = 64 * 1024;
constexpr size_t AB = 157 * MiB;
constexpr size_t WS_MRG = AB;
constexpr size_t WS_U = AB;
constexpr size_t WS_PROJ = AB, WS_KVR = AB, WS_QAR = AB + 80 * MiB, WS_CQN = AB + 128 * MiB, WS_CKVN = AB + 144 * MiB, WS_KR = AB + 152 * MiB, WS_QG = AB + 154 * MiB,
                 WS_KG = AB + 186 * MiB, WS_VG = AB + 194 * MiB, WS_QA = AB + 202 * MiB, WS_KA = AB + 250 * MiB, WS_VA = AB + 298 * MiB;
constexpr size_t WS_SQ = AB + 80 * MiB, WS_SK = AB + 144 * MiB, WS_SV = AB + 152 * MiB;
constexpr size_t WS_END = AB + 330 * MiB;
static_assert(WS_END <= WS_WQKV && WS_WOO + 8 * MiB <= 512 * MiB && WS_U + 256 * MiB <= WS_WQKV, "workspace map");
constexpr size_t WS_NEED = 505 * MiB;
#ifdef PROBE_NOLDS
constexpr int LDS_BYTES = 0;
#else
constexpr int EST_OFF = 131072 + 1024, LDS_BYTES = EST_OFF + 32 * 528 + 512;
#endif

__device__ __forceinline__ unsigned cvtpk2(float lo, float hi) { unsigned r; asm volatile("v_cvt_pk_bf16_f32 %0, %1, %2" : "=v"(r) : "v"(lo), "v"(hi)); return r; }
__device__ __forceinline__ float bflo(unsigned w) { return __uint_as_float(w << 16); }
__device__ __forceinline__ float bfhi(unsigned w) { return __uint_as_float(w & 0xffff0000u); }
__device__ __forceinline__ void ld8(const bf16* p, float (&v)[8]) { const v4u w = *(const v4u*)p; v[0] = bflo(w.x); v[1] = bfhi(w.x); v[2] = bflo(w.y); v[3] = bfhi(w.y); v[4] = bflo(w.z); v[5] = bfhi(w.z); v[6] = bflo(w.w); v[7] = bfhi(w.w); }
__device__ __forceinline__ void st8(bf16* p, const float (&v)[8]) { v4u w; w.x = cvtpk2(v[0], v[1]); w.y = cvtpk2(v[2], v[3]); w.z = cvtpk2(v[4], v[5]); w.w = cvtpk2(v[6], v[7]); *(v4u*)p = w; }
__device__ __forceinline__ void up8(const v4u w, float (&v)[8]) { v[0] = bflo(w.x); v[1] = bfhi(w.x); v[2] = bflo(w.y); v[3] = bfhi(w.y); v[4] = bflo(w.z); v[5] = bfhi(w.z); v[6] = bflo(w.w); v[7] = bfhi(w.w); }
__device__ __forceinline__ void up4(const v2u w, float (&v)[4]) { v[0] = bflo(w.x); v[1] = bfhi(w.x); v[2] = bflo(w.y); v[3] = bfhi(w.y); }
__device__ __forceinline__ void ld4(const bf16* p, float (&v)[4]) { const v2u w = *(const v2u*)p; v[0] = bflo(w.x); v[1] = bfhi(w.x); v[2] = bflo(w.y); v[3] = bfhi(w.y); }
__device__ __forceinline__ void st4(bf16* p, const float (&v)[4]) { v2u w; w.x = cvtpk2(v[0], v[1]); w.y = cvtpk2(v[2], v[3]); *(v2u*)p = w; }
template <int W> __device__ __forceinline__ float grp_sum(float v) {
#pragma unroll
  for (int o = 1; o < W; o <<= 1) v += __shfl_xor(v, o);
  return v;
}
__device__ __forceinline__ float sumsq8(const float (&v)[8]) { float s = 0.f;
#pragma unroll
  for (int j = 0; j < 8; ++j) s += v[j] * v[j];
  return s; }

#define XB_TMO      128
#define XB_XCNT(j)  (256  + 64 * (j))
#define XB_XSUB(j)  (1280 + 64 * (j))
#define XB_XGEN(j)  (2304 + 64 * (j))
#define XB_TOP      3328
#define XB_TOPGEN   3392
#define XCD_BAR_WORDS 3456
#define XB_SPIN_CAP (1u << 18)

__device__ __forceinline__ unsigned xb_ld(unsigned* p)              { return __hip_atomic_load(p, __ATOMIC_RELAXED, __HIP_MEMORY_SCOPE_AGENT); }
__device__ __forceinline__ unsigned xb_add(unsigned* p, unsigned v) { return __hip_atomic_fetch_add(p, v, __ATOMIC_RELAXED, __HIP_MEMORY_SCOPE_AGENT); }
__device__ __forceinline__ unsigned xb_xcc_id() { return (unsigned)__builtin_amdgcn_s_getreg((3 << 11) | 20) & 0xFu; }
#define XB_SPIN(cond, bar) do { unsigned _sp = 0; while (cond) { __builtin_amdgcn_s_sleep(1); \
    if ((++_sp & 255u) == 0u) { if (xb_ld(&(bar)[XB_TMO])) break; if (_sp > XB_SPIN_CAP) { atomicAdd(&(bar)[XB_TMO], 1u); break; } } } } while (0)

struct XcdBarrier {
    unsigned* bar; unsigned x;
    volatile LAS unsigned* st;
};

__device__ __forceinline__ XcdBarrier xcd_barrier_post(unsigned* bar, volatile LAS unsigned* st) {
    XcdBarrier b; b.bar = bar; b.x = xb_xcc_id(); b.st = st;
    if (threadIdx.x == 0) (void)xb_add(&bar[XB_XCNT(b.x)], 1u);
    return b;
}
__device__ __forceinline__ void xcd_barrier_complete(unsigned* bar, unsigned x, unsigned& nloc, unsigned& nx) {
    const unsigned G = gridDim.x * gridDim.y * gridDim.z;
    unsigned sum, cnt, mine, sp = 0u;
    for (;;) {
        sum = 0u; cnt = 0u; mine = 0u;
#pragma unroll
        for (unsigned j = 0; j < 16; ++j) { const unsigned c = xb_ld(&bar[XB_XCNT(j)]); sum += c; cnt += (c > 0u) ? 1u : 0u; mine = (j == x) ? c : mine; }
        if (sum == G) break;
        __builtin_amdgcn_s_sleep(1);
        if ((++sp & 255u) == 0u) { if (xb_ld(&bar[XB_TMO])) break; if (sp > XB_SPIN_CAP) { atomicAdd(&bar[XB_TMO], 1u); break; } }
    }
    nloc = mine > 0u ? mine : 1u; nx = cnt > 0u ? cnt : 1u;
}

__device__ __forceinline__ void xcd_barrier(const XcdBarrier& b) {
    asm volatile("s_waitcnt vmcnt(0)" ::: "memory");
    __syncthreads();
    if (threadIdx.x == 0) {
        unsigned* bar = b.bar;
        __builtin_amdgcn_s_waitcnt(0);
        unsigned nloc = b.st[0], nx = b.st[1];
        if (nloc == 0u) { xcd_barrier_complete(bar, b.x, nloc, nx); b.st[0] = nloc; b.st[1] = nx; }
        const unsigned old = xb_add(&bar[XB_XSUB(b.x)], 1u);
        const unsigned gen = old / nloc;
        if (old + 1u == (gen + 1u) * nloc) {
            __builtin_amdgcn_fence(__ATOMIC_RELEASE, "agent");
            asm volatile("s_waitcnt vmcnt(0)" ::: "memory");
            const unsigned og = xb_add(&bar[XB_TOP], 1u);
            const unsigned tg = og / nx;
            if (og + 1u == (tg + 1u) * nx) xb_add(&bar[XB_TOPGEN], 1u);
            else XB_SPIN(xb_ld(&bar[XB_TOPGEN]) == tg, bar);
            __builtin_amdgcn_fence(__ATOMIC_ACQUIRE, "agent");
            xb_add(&bar[XB_XGEN(b.x)], 1u);
            asm volatile("s_waitcnt vmcnt(0)" ::: "memory");
        } else {
            XB_SPIN(xb_ld(&bar[XB_XGEN(b.x)]) == gen, bar);
            __builtin_amdgcn_fence(__ATOMIC_ACQUIRE, "agent");
            asm volatile("s_waitcnt vmcnt(0)" ::: "memory");
        }
    }
    __syncthreads();
}

struct Args {
  const float* in[22]; float* out; unsigned char* ws;
  float inv_mla[32], inv_ax[32], inv_swa[8];
};

struct Ctx { int lane, wave, gw, NGW, G, vcu; unsigned char* ws; };

__device__ __forceinline__ void transpose_stream(const float* __restrict__ W, const int K, const int N, bf16* __restrict__ WT, LAS float* scr, const int first, const int items, const int stride, const int lane, const float* __restrict__ gain, const bool permq = false) {
  const int nblk = N / 32, half = lane >> 5, l31 = lane & 31;
  float cur[32], nxt[32];
  if (first >= items) return;
#define TS_LOAD(dst, item_) do { const int kb_ = (item_) / nblk, nb_ = (item_) % nblk; const float* p_ = W + (size_t)(64 * kb_ + half) * N + 32 * nb_ + l31; \
    _Pragma("unroll") for (int i = 0; i < 32; ++i) dst[i] = p_[(size_t)(2 * i) * N]; } while (0)
  TS_LOAD(cur, first);
  for (int it = first; it < items; it += stride) {
    const bool more = it + stride < items;
    if (more) TS_LOAD(nxt, it + stride);
    const int kb = it / nblk, nb = it % nblk, k0 = 64 * kb, n0 = 32 * nb;
    const int n0p = permq ? ((n0 & ~255) | (((n0 >> 5) & 1) << 7) | (((n0 >> 6) & 3) << 5)) : n0;
    if (gain) {
#pragma unroll
      for (int i = 0; i < 32; ++i) cur[i] *= gain[k0 + 2 * i + half]; }
#pragma unroll
    for (int i = 0; i < 32; ++i) scr[(2 * i + half) * 33 + l31] = cur[i];
    asm volatile("s_waitcnt lgkmcnt(0)" ::: "memory");
    const int c = lane & 7;
#pragma unroll
    for (int j = 0; j < 4; ++j) { const int n = (lane >> 3) + 8 * j; const LAS float* s = scr + (8 * c) * 33 + n;
      v4u o; o.x = cvtpk2(s[0 * 33], s[1 * 33]); o.y = cvtpk2(s[2 * 33], s[3 * 33]); o.z = cvtpk2(s[4 * 33], s[5 * 33]); o.w = cvtpk2(s[6 * 33], s[7 * 33]);
      *(v4u*)(WT + (size_t)(n0p + n) * K + k0 + 8 * c) = o; }
    asm volatile("s_waitcnt lgkmcnt(0)" ::: "memory");
    if (more) {
#pragma unroll
      for (int i = 0; i < 32; ++i) cur[i] = nxt[i]; }
  }
#undef TS_LOAD
}
template <int SET> __device__ __forceinline__ void convert_dynamic(unsigned* counter, const int wave, const int lane, const Args& a, unsigned char* ws, LAS unsigned char* lds) {
  LAS float* scr = (LAS float*)(lds + wave * 16384);
  constexpr int CH = 8, C_OE = (DM / 64) * (DM / 32) / CH, C_UP = (DM / 64) * (DFF / 32) / CH, C_DN = (DFF / 64) * (DM / 32) / CH, C_QKV = (DM / 64) * (ODD_IN / 32) / CH;
#define CD_TS(W_, K_, N_, off_, gain_, perm_, ch_) transpose_stream((W_), (K_), (N_), (bf16*)(ws + (off_)), scr, (ch_) * CH, (ch_) * CH + CH, 1, lane, (gain_), (perm_))
  for (;;) {
    int chv = 0; if (lane == 0) chv = (int)__hip_atomic_fetch_add(counter, 1u, __ATOMIC_RELAXED, __HIP_MEMORY_SCOPE_AGENT);
    const int ch = __builtin_amdgcn_readfirstlane(chv);
    if constexpr (SET == 1) {
      if (ch < C_UP) CD_TS(a.in[20], DM, DFF, WS_WUP, a.in[19], false, ch);
      else if (ch < C_UP + C_DN) CD_TS(a.in[21], DFF, DM, WS_WDN, nullptr, false, ch - C_UP);
      else if (ch < C_UP + C_DN + C_OE) CD_TS(a.in[12], DM, DM, WS_WOE, nullptr, false, ch - C_UP - C_DN);
      else if (ch < C_UP + C_DN + C_OE + C_QKV) CD_TS(a.in[14], DM, ODD_IN, WS_WQKV, a.in[13], true, ch - C_UP - C_DN - C_OE);
      else if (ch < C_UP + C_DN + 2 * C_OE + C_QKV) CD_TS(a.in[18], DM, DM, WS_WOO, nullptr, false, ch - C_UP - C_DN - C_OE - C_QKV);
      else break;
    } else {
      if (ch < C_UP) CD_TS(a.in[20] + (size_t)DM * DFF, DM, DFF, WS_WUP, a.in[19] + DM, false, ch);
      else if (ch < C_UP + C_DN) CD_TS(a.in[21] + (size_t)DM * DFF, DFF, DM, WS_WDN, nullptr, false, ch - C_UP);
      else break;
    }
  }
#undef CD_TS
}
__device__ __forceinline__ void rms_row(const float* xrow, const float* gain, bf16* orow, int lane) {
  f32x4 v[8]; float s = 0.f;
#pragma unroll
  for (int j = 0; j < 4; ++j) { const f32x4* p = (const f32x4*)xrow + 2 * (64 * j + lane); v[2 * j] = p[0]; v[2 * j + 1] = p[1]; }
#pragma unroll
  for (int j = 0; j < 8; ++j) s += (v[j].x * v[j].x + v[j].y * v[j].y) + (v[j].z * v[j].z + v[j].w * v[j].w);
  const float rstd = 1.0f / sqrtf(grp_sum<64>(s) * (1.f / DM) + EPS);
#pragma unroll
  for (int j = 0; j < 4; ++j) { const f32x4* gp = (const f32x4*)gain + 2 * (64 * j + lane); const f32x4 g0 = gp[0], g1 = gp[1], a0 = v[2 * j], a1 = v[2 * j + 1];
    v4u w; w.x = cvtpk2(a0.x * rstd * g0.x, a0.y * rstd * g0.y); w.y = cvtpk2(a0.z * rstd * g0.z, a0.w * rstd * g0.w); w.z = cvtpk2(a1.x * rstd * g1.x, a1.y * rstd * g1.y); w.w = cvtpk2(a1.z * rstd * g1.z, a1.w * rstd * g1.w);
    *((v4u*)orow + 64 * j + lane) = w; }
}
__device__ __forceinline__ void norm_phase(const Ctx& c, const float* x, const float* gain, bf16* xn) {
  const int lane = c.lane; f32x4 cur[8], nxt[8];
  if (c.gw >= T) return;
#define NP_LOAD(dst, m_) do { const f32x4* p_ = (const f32x4*)(x + (size_t)(m_) * DM) + 2 * lane; _Pragma("unroll") for (int j = 0; j < 4; ++j) { dst[2 * j] = p_[128 * j]; dst[2 * j + 1] = p_[128 * j + 1]; } } while (0)
  NP_LOAD(cur, c.gw);
  for (int m = c.gw; m < T; m += c.NGW) {
    const bool more = m + c.NGW < T;
    if (more) NP_LOAD(nxt, m + c.NGW);
    float s = 0.f;
#pragma unroll
    for (int j = 0; j < 8; ++j) s += (cur[j].x * cur[j].x + cur[j].y * cur[j].y) + (cur[j].z * cur[j].z + cur[j].w * cur[j].w);
    const float rstd = 1.0f / sqrtf(grp_sum<64>(s) * (1.f / DM) + EPS);
    bf16* orow = xn + (size_t)m * DM;
#pragma unroll
    for (int j = 0; j < 4; ++j) { const f32x4* gp = (const f32x4*)gain + 2 * (64 * j + lane); const f32x4 g0 = gp[0], g1 = gp[1], a0 = cur[2 * j], a1 = cur[2 * j + 1];
      v4u w; w.x = cvtpk2(a0.x * rstd * g0.x, a0.y * rstd * g0.y); w.y = cvtpk2(a0.z * rstd * g0.z, a0.w * rstd * g0.w); w.z = cvtpk2(a1.x * rstd * g1.x, a1.y * rstd * g1.y); w.w = cvtpk2(a1.z * rstd * g1.z, a1.w * rstd * g1.w);
      *((v4u*)orow + 64 * j + lane) = w; }
    if (more) {
#pragma unroll
      for (int j = 0; j < 8; ++j) cur[j] = nxt[j]; }
  }
#undef NP_LOAD
}
__device__ __forceinline__ f32x2 sincos_rev(float ang) {
  double fr = (double)ang * 0.15915494309189533577; fr -= rint(fr); const float f = (float)fr;
  return (f32x2){__builtin_amdgcn_cosf(f), __builtin_amdgcn_sinf(f)};
}

__device__ __forceinline__ void prologue(const Ctx& c, const Args& a, LAS unsigned char* lds) {
  LAS float* scr = (LAS float*)(lds + c.wave * 16384);
  unsigned char* ws = c.ws;
  int base = 0;
#define DO_W(inidx, K_, N_, off, srcoff, gain_) do { const int items = ((K_) / 64) * ((N_) / 32); const float* W = a.in[inidx] + (srcoff); bf16* WT = (bf16*)(ws + (off)); \
    const int first = (c.gw - (base % c.NGW) + c.NGW) % c.NGW; \
    transpose_stream(W, (K_), (N_), WT, scr, first, items, c.NGW, c.lane, (gain_)); \
    base += items; } while (0)
  DO_W(2, DM, EVEN_IN, WS_WIN, 0, nullptr); DO_W(5, 512, 1536, WS_WUQ, 0, nullptr); DO_W(6, 256, 2048, WS_WUKV, 0, nullptr);
#undef DO_W
  { v4u* z = (v4u*)((bf16*)(ws + WS_WIN) + (size_t)EVEN_IN * DM); const int n16 = (EVEN_IN_P - EVEN_IN) * DM / 8;
    for (int i = c.gw * 64 + c.lane; i < n16; i += c.NGW * 64) z[i] = (v4u){0u, 0u, 0u, 0u}; }
  { f32x2* tm = (f32x2*)(ws + WS_TMLA); f32x2* ta = (f32x2*)(ws + WS_TAX); f32x2* tsw = (f32x2*)(ws + WS_TSWA);
    const int gt = c.gw * 64 + c.lane, NT_ = c.NGW * 64;
    for (int i = gt; i < SEQ * 32; i += NT_) { const int s = i >> 5, f = i & 31; tm[i] = sincos_rev((float)s * a.inv_mla[f]); }
    for (int i = gt; i < SEQ * 64; i += NT_) { const int s = i >> 6, f = i & 63; const int pos = (f < 32) ? (s >> 6) : (s & 63); ta[i] = sincos_rev((float)pos * a.inv_ax[f & 31]); }
    for (int i = gt; i < SEQ * 8; i += NT_) { const int s = i >> 3, f = i & 7; tsw[i] = sincos_rev((float)s * a.inv_swa[f]); } }
  norm_phase(c, a.in[0], a.in[1], (bf16*)(ws + WS_XN));
}

__device__ __forceinline__ void convert_layer1(const Ctx& c, const Args& a, LAS unsigned char* lds) {
  LAS float* scr = (LAS float*)(lds + c.wave * 16384);
  unsigned char* ws = c.ws;
  int base = 0;
#define DO_W(inidx, K_, N_, off, srcoff, gain_) do { const int items = ((K_) / 64) * ((N_) / 32); const float* W = a.in[inidx] + (srcoff); bf16* WT = (bf16*)(ws + (off)); \
    const int first = (c.gw - (base % c.NGW) + c.NGW) % c.NGW; \
    transpose_stream(W, (K_), (N_), WT, scr, first, items, c.NGW, c.lane, (gain_)); \
    base += items; } while (0)
  DO_W(20, DM, DFF, WS_WUP, (size_t)DM * DFF, a.in[19] + DM); DO_W(21, DFF, DM, WS_WDN, (size_t)DM * DFF, nullptr);
#undef DO_W
}
__device__ __forceinline__ void post_proj(const Ctx& c, const Args& a) {
  unsigned char* ws = c.ws; const int l = c.lane;
  const bf16* PROJ = (const bf16*)(ws + WS_PROJ);
  bf16* CQN = (bf16*)(ws + WS_CQN); bf16* CKVN = (bf16*)(ws + WS_CKVN); bf16* KR = (bf16*)(ws + WS_KR);
  bf16* QG = (bf16*)(ws + WS_QG); bf16* KG = (bf16*)(ws + WS_KG); bf16* VG = (bf16*)(ws + WS_VG);
  const f32x2* tm = (const f32x2*)(ws + WS_TMLA); const f32x2* ta = (const f32x2*)(ws + WS_TAX);
  const float* g_qlat = a.in[3]; const float* g_kvlat = a.in[4]; const float* g_krope = a.in[9]; const float* g_gq = a.in[10]; const float* g_gk = a.in[11];
  const v4u zero4 = {0u, 0u, 0u, 0u};
  v4u cA, cB, cC0, cC1, cC2, nA = zero4, nB = zero4, nC0 = zero4, nC1 = zero4, nC2 = zero4;
#define PP_LOAD(A_, B_, C0_, C1_, C2_, t_) do { const bf16* p_ = PROJ + (size_t)(t_) * EVEN_IN_P; A_ = *(const v4u*)(p_ + 8 * l); B_ = (l < 40) ? *(const v4u*)(p_ + 512 + 8 * l) : zero4; \
    C0_ = *(const v4u*)(p_ + 832 + 8 * l); C1_ = *(const v4u*)(p_ + 1344 + 8 * l); C2_ = *(const v4u*)(p_ + 1856 + 8 * l); } while (0)
  if (c.gw >= T) return;
  PP_LOAD(cA, cB, cC0, cC1, cC2, c.gw);
  for (int t = c.gw; t < T; t += c.NGW) {
    const bool more = t + c.NGW < T;
    if (more) PP_LOAD(nA, nB, nC0, nC1, nC2, t + c.NGW);
    const int b = t / SEQ, s = t % SEQ;
    float v[8], o[8];
    { up8(cA, v); const float rstd = 1.0f / sqrtf(grp_sum<64>(sumsq8(v)) * (1.f / 512) + EPS);
#pragma unroll
      for (int j = 0; j < 8; ++j) o[j] = v[j] * rstd * g_qlat[8 * l + j];
      st8(CQN + (size_t)t * 512 + 8 * l, o); }
    { up8(cB, v);
      float ss = grp_sum<8>(sumsq8(v)); const float ss8 = ss; ss += __shfl_xor(ss, 8); ss += __shfl_xor(ss, 16);
      if (l < 32) { const float rstd = 1.0f / sqrtf(ss * (1.f / 256) + EPS);
#pragma unroll
        for (int j = 0; j < 8; ++j) o[j] = v[j] * rstd * g_kvlat[8 * l + j];
        st8(CKVN + (size_t)t * 256 + 8 * l, o); }
      const int lr = l & 7; const float rstd8 = 1.0f / sqrtf(ss8 * (1.f / 64) + EPS); float nv[8], pv_[8];
#pragma unroll
      for (int j = 0; j < 8; ++j) nv[j] = v[j] * rstd8 * g_krope[(8 * lr + j) & 63];
#pragma unroll
      for (int j = 0; j < 8; ++j) pv_[j] = __shfl_xor(nv[j], 4);
      if (l >= 32 && l < 40) {
#pragma unroll
        for (int j = 0; j < 8; ++j) { const f32x2 cs = tm[s * 32 + 8 * (lr & 3) + j]; o[j] = (lr & 4) ? (nv[j] * cs.x + pv_[j] * cs.y) : (nv[j] * cs.x - pv_[j] * cs.y); }
        st8(KR + (size_t)t * 64 + 8 * lr, o); } }
#pragma unroll
    for (int pass = 0; pass < 3; ++pass) {
      const int hl = l >> 4, ll = l & 15;
      up8(pass == 0 ? cC0 : (pass == 1 ? cC1 : cC2), v);
      const float rstd = 1.0f / sqrtf(grp_sum<16>(sumsq8(v)) * (1.f / 128) + EPS);
      const float* g = (pass < 2) ? g_gq : g_gk; float nv[8], pv_[8];
#pragma unroll
      for (int j = 0; j < 8; ++j) nv[j] = v[j] * rstd * g[8 * ll + j];
#pragma unroll
      for (int j = 0; j < 8; ++j) pv_[j] = __shfl_xor(nv[j], 4);
#pragma unroll
      for (int j = 0; j < 8; ++j) { const f32x2 cs = ta[s * 64 + ((ll & 8) ? 32 : 0) + 8 * (ll & 3) + j]; o[j] = (ll & 4) ? (nv[j] * cs.x + pv_[j] * cs.y) : (nv[j] * cs.x - pv_[j] * cs.y); }
      if (pass < 2) st8(QG + ((size_t)(b * 8 + pass * 4 + hl) * SEQ + s) * 128 + 8 * ll, o);
      else if (hl < 2) st8(KG + ((size_t)(b * 2 + hl) * SEQ + s) * 128 + 8 * ll, o);
      else st8(VG + ((size_t)(b * 2 + (hl - 2)) * SEQ + s) * 128 + 8 * ll, v);
    }
    cA = nA; cB = nB; cC0 = nC0; cC1 = nC1; cC2 = nC2;
  }
#undef PP_LOAD
}
__device__ __forceinline__ void post_mla(const Ctx& c, const Args& a) {
  unsigned char* ws = c.ws; const int l = c.lane, hl = l >> 4, ll = l & 15;
  const bf16* QAR = (const bf16*)(ws + WS_QAR); const bf16* KVR = (const bf16*)(ws + WS_KVR); const bf16* KR = (const bf16*)(ws + WS_KR);
  bf16* QA = (bf16*)(ws + WS_QA); bf16* KA = (bf16*)(ws + WS_KA); bf16* VA = (bf16*)(ws + WS_VA);
  const f32x2* tm = (const f32x2*)(ws + WS_TMLA);
  const float* g_q = a.in[7]; const float* g_kn = a.in[8];
  const v4u z4 = {0u, 0u, 0u, 0u}; const v2u z2 = {0u, 0u};
  v4u cq0, cq1, ck0, ck1, cv0, cv1, nq0 = z4, nq1 = z4, nk0 = z4, nk1 = z4, nv0 = z4, nv1 = z4; v2u cr0, cr1, ckr, nr0 = z2, nr1 = z2, nkr = z2;
#define PM_LOAD(q0_, q1_, r0_, r1_, k0_, k1_, v0_, v1_, kr_, t_) do { const bf16* q_ = QAR + (size_t)(t_) * 1536 + hl * 192; const bf16* kv_ = KVR + (size_t)(t_) * 2048 + hl * 256; \
    q0_ = *(const v4u*)(q_ + 8 * ll); r0_ = *(const v2u*)(q_ + 128 + 4 * ll); q1_ = *(const v4u*)(q_ + 768 + 8 * ll); r1_ = *(const v2u*)(q_ + 896 + 4 * ll); \
    k0_ = *(const v4u*)(kv_ + 8 * ll); v0_ = *(const v4u*)(kv_ + 128 + 8 * ll); k1_ = *(const v4u*)(kv_ + 1024 + 8 * ll); v1_ = *(const v4u*)(kv_ + 1152 + 8 * ll); \
    kr_ = *(const v2u*)(KR + (size_t)(t_) * 64 + 4 * ll); } while (0)
  if (c.gw >= T) return;
  PM_LOAD(cq0, cq1, cr0, cr1, ck0, ck1, cv0, cv1, ckr, c.gw);
  for (int t = c.gw; t < T; t += c.NGW) {
    const bool more = t + c.NGW < T;
    if (more) PM_LOAD(nq0, nq1, nr0, nr1, nk0, nk1, nv0, nv1, nkr, t + c.NGW);
    const int b = t / SEQ, s = t % SEQ;
#pragma unroll
    for (int pass = 0; pass < 2; ++pass) {
      const int h = pass * 4 + hl;
      {
        float v[8], r[4], o[8], ro[4];
        up8(pass ? cq1 : cq0, v); up4(pass ? cr1 : cr0, r);
        float ss = sumsq8(v) + (r[0] * r[0] + r[1] * r[1]) + (r[2] * r[2] + r[3] * r[3]);
        const float rstd = 1.0f / sqrtf(grp_sum<16>(ss) * (1.f / 192) + EPS);
#pragma unroll
        for (int j = 0; j < 8; ++j) o[j] = v[j] * rstd * g_q[8 * ll + j];
        float nr[4], pr_[4];
#pragma unroll
        for (int j = 0; j < 4; ++j) nr[j] = r[j] * rstd * g_q[128 + 4 * ll + j];
#pragma unroll
        for (int j = 0; j < 4; ++j) pr_[j] = __shfl_xor(nr[j], 8);
#pragma unroll
        for (int j = 0; j < 4; ++j) { const f32x2 cs = tm[s * 32 + 4 * (ll & 7) + j]; ro[j] = (ll & 8) ? (nr[j] * cs.x + pr_[j] * cs.y) : (nr[j] * cs.x - pr_[j] * cs.y); }
        bf16* qo = QA + ((size_t)(b * 8 + h) * SEQ + s) * 192; st8(qo + 8 * ll, o); st4(qo + 128 + 4 * ll, ro); }
      {
        float v[8], o[8];
        up8(pass ? ck1 : ck0, v);
        const float rstd = 1.0f / sqrtf(grp_sum<16>(sumsq8(v)) * (1.f / 128) + EPS);
#pragma unroll
        for (int j = 0; j < 8; ++j) o[j] = v[j] * rstd * g_kn[8 * ll + j];
        bf16* ko = KA + ((size_t)(b * 8 + h) * SEQ + s) * 192; st8(ko + 8 * ll, o);
        *(v2u*)(ko + 128 + 4 * ll) = ckr;
        *(v4u*)(VA + ((size_t)(b * 8 + h) * SEQ + s) * 128 + 8 * ll) = pass ? cv1 : cv0; }
    }
    cq0 = nq0; cq1 = nq1; cr0 = nr0; cr1 = nr1; ck0 = nk0; ck1 = nk1; cv0 = nv0; cv1 = nv1; ckr = nkr;
  }
#undef PM_LOAD
}
__device__ __forceinline__ void post_qkv(const Ctx& c, const Args& a) {
  unsigned char* ws = c.ws; const int l = c.lane, hl = l >> 3, ll = l & 7;
  const bf16* QKV = (const bf16*)(ws + WS_PROJ);
  bf16* SQ = (bf16*)(ws + WS_SQ); bf16* SK = (bf16*)(ws + WS_SK); bf16* SV = (bf16*)(ws + WS_SV);
  const f32x2* tsw = (const f32x2*)(ws + WS_TSWA);
  const float* g_q = a.in[15]; const float* g_k = a.in[16];
  for (int t = c.gw; t < T; t += c.NGW) {
    const int b = t / SEQ, s = t % SEQ; const bf16* pr = QKV + (size_t)t * ODD_IN;
#pragma unroll
    for (int pass = 0; pass < 5; ++pass) {
      float v[8], o[8], nv[8], pv_[8];
      ld8(pr + pass * 512 + 8 * l, v);
      const float rstd = 1.0f / sqrtf(grp_sum<8>(sumsq8(v)) * (1.f / 64) + EPS);
      const float* g = (pass < 4) ? g_q : g_k;
#pragma unroll
      for (int j = 0; j < 8; ++j) nv[j] = v[j] * rstd * g[8 * ll + j];
#pragma unroll
      for (int j = 0; j < 8; ++j) pv_[j] = __shfl_xor(nv[j], 1);
#pragma unroll
      for (int j = 0; j < 8; ++j) { const f32x2 cs = tsw[s * 8 + j]; o[j] = (ll >= 2) ? nv[j] : ((ll & 1) ? (nv[j] * cs.x + pv_[j] * cs.y) : (nv[j] * cs.x - pv_[j] * cs.y)); }
      if (pass < 4) st8(SQ + ((size_t)(b * 32 + pass * 8 + hl) * SEQ + s) * 64 + 8 * ll, o);
      else if (hl < 4) st8(SK + ((size_t)(b * 4 + hl) * SEQ + s) * 64 + 8 * ll, o);
      else st8(SV + ((size_t)(b * 4 + (hl - 4)) * SEQ + s) * 64 + 8 * ll, v);
    }
  }
}

#ifdef NO_GEMM
#define GEMM_PHASE(EPI_T, epi, Aoff, Boff, N_, K_) do { (void)(epi); } while (0)
#else
#define GEMM_PHASE(EPI_T, epi, Aoff, Boff, N_, K_) do { \
    pg8::Gemm g_{(const pg8::bf16_t*)(ws + (Aoff)), (const pg8::bf16_t*)(ws + (Boff)), T, (N_), (K_)}; pg8::StaticOrder S_; S_.init(T, (N_), c.G, (int)blockIdx.x); \
    pg8::gemm_phase<EPI_T, pg8::StaticOrder, true, true>(ldsl, g_, S_, (epi)); } while (0)
#endif

#ifndef STAG_TICKS
#define STAG_TICKS 0
#endif
#define STAGGER() do { if (STAG_TICKS > 0) { const unsigned long long t0_ = __builtin_amdgcn_s_memrealtime(); const unsigned long long d_ = (unsigned long long)((blockIdx.x >> 3) & 3) * STAG_TICKS; \
    while (__builtin_amdgcn_s_memrealtime() - t0_ < d_) __builtin_amdgcn_s_sleep(8); } } while (0)
#ifndef REP_THIN2
#define REP_THIN2 1
#endif
#ifndef REP_THIN3
#define REP_THIN3 1
#endif
#ifndef REP_SWA
#define REP_SWA 1
#endif
#ifndef REP_PRO
#define REP_PRO 1
#endif
#ifndef REP_THIN
#define REP_THIN 1
#endif
#ifndef REP_MLA
#define REP_MLA 1
#endif
#ifndef REP_GQA
#define REP_GQA 1
#endif
#ifndef REP_UP
#define REP_UP 1
#endif
__global__ void __launch_bounds__(NWAVES * 64, 2) fwd_megakernel(Args a) {
  extern __shared__ __attribute__((aligned(16))) unsigned char lds[];
#ifdef NO_SYNC
  struct { __device__ void sync() const { __syncthreads(); } } grid;
#else
  cg::grid_group grid = cg::this_grid();
#endif
  LAS unsigned char* ldsl = (LAS unsigned char*)lds;
#define MKCTX() do { int t_ = threadIdx.x; asm volatile("" : "+v"(t_)); c.lane = t_ & 63; c.wave = __builtin_amdgcn_readfirstlane(t_ >> 6); c.G = gridDim.x; \
    { const int bx = blockIdx.x; c.vcu = (c.G % 8 == 0) ? (bx % 8) * (c.G / 8) + bx / 8 : bx; } \
    c.gw = blockIdx.x * NWAVES + c.wave; c.NGW = c.G * NWAVES; c.ws = a.ws; } while (0)
  Ctx c; MKCTX();
  volatile LAS unsigned* bst = (volatile LAS unsigned*)(ldsl + 131072 + 512);
  if (threadIdx.x < 2) bst[threadIdx.x] = 0u;
  __syncthreads();
  XcdBarrier xbar = xcd_barrier_post((unsigned*)a.ws, bst);
#ifdef USE_CG_ALL
#define SEAM() do { grid.sync(); MKCTX(); } while (0)
#else
#define SEAM() do { xcd_barrier(xbar); MKCTX(); } while (0)
#endif
  unsigned char* ws = a.ws;
  float* X = a.out; float* RSS = (float*)(a.ws + WS_ROWSS);

#ifndef NO_PRO
  prologue(c, a, ldsl);

#endif
  grid.sync(); MKCTX();
  { pg8::EpiB<0> E{(pg8::bf16_t*)(ws + WS_PROJ), EVEN_IN_P, nullptr, 0.f, 0.f}; GEMM_PHASE(pg8::EpiB<0>, E, WS_XN, WS_WIN, EVEN_IN_P, DM); }
#ifndef NO_PRO
  MKCTX(); convert_dynamic<1>((unsigned*)(ws + WS_CNT), c.wave, c.lane, a, ws, ldsl);
#endif
  SEAM();
#ifndef NO_POST
  for (int rep = 0; rep < REP_THIN; ++rep) { MKCTX(); post_proj(c, a); }
#endif
  SEAM();
  { pg8::EpiB<0> E{(pg8::bf16_t*)(ws + WS_QAR), 1536, nullptr, 0.f, 0.f}; GEMM_PHASE(pg8::EpiB<0>, E, WS_CQN, WS_WUQ, 1536, 512); }
  { pg8::EpiB<0> E{(pg8::bf16_t*)(ws + WS_KVR), 2048, nullptr, 0.f, 0.f}; GEMM_PHASE(pg8::EpiB<0>, E, WS_CKVN, WS_WUKV, 2048, 256); }
  SEAM();
#ifndef NO_POST
  for (int rep = 0; rep < REP_THIN2; ++rep) { MKCTX(); post_mla(c, a); }
#endif
  SEAM();
  {
    constexpr float L2E = 1.4426950408889634f;
    const int nper = (512 + c.G - 1) / c.G;
    for (int rep = 0; rep < REP_MLA; ++rep)
    for (int i = 0; i < nper; ++i) {
      const int u = c.vcu * nper + i; if (u >= 512) break;
      int tid = threadIdx.x; asm volatile("" : "+v"(tid)); const int wid = tid >> 6, lane = tid & 63, r32 = lane & 31;
      const int bh = u >> 5, qb = u & 31, b = bh >> 3, h = bh & 7;
      const float sc = 0.07216878364870322f;
      const att::bf16* Q = (const att::bf16*)(ws + WS_QA) + ((size_t)bh * SEQ + qb * 256 + wid * 32 + r32) * 192;
      const att::bf16* K = (const att::bf16*)(ws + WS_KA) + (size_t)bh * SEQ * 192;
      const att::bf16* V = (const att::bf16*)(ws + WS_VA) + (size_t)bh * SEQ * 128;
      att::bf16* O = (att::bf16*)(ws + WS_MRG) + ((size_t)b * SEQ + qb * 256 + wid * 32) * 2048 + h * 128;
#ifndef NO_A192
      att::attn_unit<192, 128, false, false, 1>(Q, K, V, O, 2048, 0, SEQ / 64, 0, SEQ, 0, -1e30f, 0.f, sc * L2E, 8.f / sc, (char*)lds);
#endif
    }
    for (int rep = 0; rep < REP_GQA; ++rep)
    for (int i = 0; i < nper; ++i) {
      const int u = c.vcu * nper + i; if (u >= 512) break;
      int tid = threadIdx.x; asm volatile("" : "+v"(tid)); const int wid = tid >> 6, lane = tid & 63, r32 = lane & 31;
      const int bh = u >> 5, qb = u & 31, b = bh >> 3, h = bh & 7, kvh = h >> 2;
      const float sc = 0.08838834764831845f;
      const att::bf16* Q = (const att::bf16*)(ws + WS_QG) + ((size_t)bh * SEQ + qb * 256 + wid * 32 + r32) * 128;
      const att::bf16* K = (const att::bf16*)(ws + WS_KG) + (size_t)(b * 2 + kvh) * SEQ * 128;
      const att::bf16* V = (const att::bf16*)(ws + WS_VG) + (size_t)(b * 2 + kvh) * SEQ * 128;
      att::bf16* O = (att::bf16*)(ws + WS_MRG) + ((size_t)b * SEQ + qb * 256 + wid * 32) * 2048 + 1024 + h * 128;
#ifndef NO_A128
      att::attn_unit<128, 128, false, false, 2>(Q, K, V, O, 2048, 0, SEQ / 64, 0, SEQ, 0, -1e30f, 0.f, sc * L2E, 8.f / sc, (char*)lds);
#endif
    }
  }
  SEAM();
  { pg8::EpiResN<false> E{a.in[0], (pg8::bf16_t*)(ws + WS_XN), RSS, DM, nullptr, 0.f, 0.f}; GEMM_PHASE(pg8::EpiResN<false>, E, WS_MRG, WS_WOE, DM, DM); }
  SEAM();
  STAGGER();
  { pg8::EpiBL<2> E{(pg8::bf16_t*)(ws + WS_U), DFF, ldsl + EST_OFF}; GEMM_PHASE(pg8::EpiBL<2>, E, WS_XN, WS_WUP, DFF, DM); }
#if REP_UP > 1
#ifdef PROBE_NOEPI
  MKCTX(); { pg8::EpiNone E{}; GEMM_PHASE(pg8::EpiNone, E, WS_XN, WS_WUP, DFF, DM); }
#else
  MKCTX(); { pg8::EpiBL<2> E{(pg8::bf16_t*)(ws + WS_U), DFF, ldsl + EST_OFF}; GEMM_PHASE(pg8::EpiBL<2>, E, WS_XN, WS_WUP, DFF, DM); }
#endif
#endif
#if REP_UP > 2
#ifdef PROBE_NOEPI
  MKCTX(); { pg8::EpiNone E{}; GEMM_PHASE(pg8::EpiNone, E, WS_XN, WS_WUP, DFF, DM); }
#else
  MKCTX(); { pg8::EpiBL<2> E{(pg8::bf16_t*)(ws + WS_U), DFF, ldsl + EST_OFF}; GEMM_PHASE(pg8::EpiBL<2>, E, WS_XN, WS_WUP, DFF, DM); }
#endif
#endif
  SEAM();
#ifdef REP_DN
  { pg8::EpiB<0> E{(pg8::bf16_t*)(ws + AB + 256 * MiB), DM, nullptr, 0.f, 0.f}; GEMM_PHASE(pg8::EpiB<0>, E, WS_U, WS_WDN, DM, DFF); } MKCTX();
#endif
  { pg8::EpiResN<true> E{ws + WS_XN, (pg8::bf16_t*)(ws + WS_XN), RSS + T, DM, RSS, 1.f / DM, EPS}; GEMM_PHASE(pg8::EpiResN<true>, E, WS_U, WS_WDN, DM, DFF); }
  SEAM();
  { pg8::EpiQKV E{(pg8::bf16_t*)(ws + WS_SQ), (long)((WS_SK - WS_SQ) / 2), (long)((WS_SV - WS_SQ) / 2), RSS + T, 1.f / DM, EPS, a.in[15], a.in[16], (const float*)(ws + WS_TSWA), 13};
    GEMM_PHASE(pg8::EpiQKV, E, WS_XN, WS_WQKV, ODD_IN, DM); }
#ifndef NO_PRO
  MKCTX(); convert_dynamic<2>((unsigned*)(ws + WS_CNT) + 64, c.wave, c.lane, a, ws, ldsl);
#endif
  SEAM();
  {
    constexpr float L2E = 1.4426950408889634f; const float sc = 0.125f;
    const int nper = (1024 + c.G - 1) / c.G;
    for (int rep = 0; rep < REP_SWA; ++rep)
    for (int i = 0; i < nper; ++i) {
      const int u = c.vcu * nper + i; if (u >= 1024) break;
      int tid = threadIdx.x; asm volatile("" : "+v"(tid)); const int wid = tid >> 6, lane = tid & 63, r32 = lane & 31;
      const int b = u >> 9, kvh = (u >> 7) & 3, rb = u & 127, h = kvh * 8 + wid;
      const att::bf16* Q = (const att::bf16*)(ws + WS_SQ) + ((size_t)(b * 32 + h) * SEQ + rb * 64 + r32) * 64;
      const att::bf16* K = (const att::bf16*)(ws + WS_SK) + (size_t)(b * 4 + kvh) * SEQ * 64;
      const att::bf16* V = (const att::bf16*)(ws + WS_SV) + (size_t)(b * 4 + kvh) * SEQ * 64;
      att::bf16* O = (att::bf16*)(ws + WS_MRG) + ((size_t)b * SEQ + rb * 64) * 2048 + h * 64;
      const float sink = a.in[17][h];
#ifndef NO_A64
      att::swa_unit<5, 2>(Q, K, V, O, 2048, rb * 64 - 128, rb * 64 + r32, SEQ, 128, sink / sc, sc * L2E, 8.f / sc, (char*)lds);
#endif
    }
  }
  SEAM();
  { pg8::EpiResN<true> E{ws + WS_XN, (pg8::bf16_t*)(ws + WS_XN), RSS + 2 * T, DM, nullptr, 0.f, 0.f}; GEMM_PHASE(pg8::EpiResN<true>, E, WS_MRG, WS_WOO, DM, DM); }
  SEAM();
  STAGGER();
  { pg8::EpiBL<2> E{(pg8::bf16_t*)(ws + WS_U), DFF, ldsl + EST_OFF}; GEMM_PHASE(pg8::EpiBL<2>, E, WS_XN, WS_WUP, DFF, DM); }
#if REP_UP > 1
#ifdef PROBE_NOEPI
  MKCTX(); { pg8::EpiNone E{}; GEMM_PHASE(pg8::EpiNone, E, WS_XN, WS_WUP, DFF, DM); }
#else
  MKCTX(); { pg8::EpiBL<2> E{(pg8::bf16_t*)(ws + WS_U), DFF, ldsl + EST_OFF}; GEMM_PHASE(pg8::EpiBL<2>, E, WS_XN, WS_WUP, DFF, DM); }
#endif
#endif
#if REP_UP > 2
#ifdef PROBE_NOEPI
  MKCTX(); { pg8::EpiNone E{}; GEMM_PHASE(pg8::EpiNone, E, WS_XN, WS_WUP, DFF, DM); }
#else
  MKCTX(); { pg8::EpiBL<2> E{(pg8::bf16_t*)(ws + WS_U), DFF, ldsl + EST_OFF}; GEMM_PHASE(pg8::EpiBL<2>, E, WS_XN, WS_WUP, DFF, DM); }
#endif
#endif
  SEAM();
#ifdef REP_DN
  { pg8::EpiB<0> E{(pg8::bf16_t*)(ws + AB + 256 * MiB), DM, nullptr, 0.f, 0.f}; GEMM_PHASE(pg8::EpiB<0>, E, WS_U, WS_WDN, DM, DFF); } MKCTX();
#endif
  { pg8::EpiRes<true> E{ws + WS_XN, X, DM, RSS + 2 * T, 1.f / DM, EPS}; GEMM_PHASE(pg8::EpiRes<true>, E, WS_U, WS_WDN, DM, DFF); }
}

#ifdef PROBE_PRO_KERNEL
__global__ void __launch_bounds__(NWAVES * 64, 2) probe_prologue(Args a) {
  extern __shared__ __attribute__((aligned(16))) unsigned char lds[];
  LAS unsigned char* ldsl = (LAS unsigned char*)lds;
  Ctx c; { int t_ = threadIdx.x; c.lane = t_ & 63; c.wave = __builtin_amdgcn_readfirstlane(t_ >> 6); c.G = gridDim.x; c.vcu = blockIdx.x; c.gw = blockIdx.x * NWAVES + c.wave; c.NGW = c.G * NWAVES; c.ws = a.ws; }
  prologue(c, a, ldsl);
}
#endif
extern "C" void kernel_launch(void* const* d_in, const int* in_sizes, int n_in, void* d_out, int out_size, void* d_ws, size_t ws_size, hipStream_t stream) {
  static int grid = 0;
  if (grid == 0) {
    if (n_in != 22 || out_size != T * DM || ws_size < WS_NEED) { fprintf(stderr, "kernel_launch: unexpected shapes: n_in %d out %d ws %zu (need %zu)\n", n_in, out_size, ws_size, (size_t)WS_NEED); grid = -1; return; }
    int dev = 0, cus = 0, per_cu = 0;
    (void)hipGetDevice(&dev); (void)hipDeviceGetAttribute(&cus, hipDeviceAttributeMultiprocessorCount, dev);
    if (LDS_BYTES > 0 && hipFuncSetAttribute((const void*)fwd_megakernel, hipFuncAttributeMaxDynamicSharedMemorySize, LDS_BYTES) != hipSuccess) { fprintf(stderr, "kernel_launch: hipFuncSetAttribute failed\n"); grid = -1; return; }
    if (hipOccupancyMaxActiveBlocksPerMultiprocessor(&per_cu, (const void*)fwd_megakernel, NWAVES * 64, LDS_BYTES) != hipSuccess || per_cu < 1) { fprintf(stderr, "kernel_launch: occupancy query says %d\n", per_cu); per_cu = 1; }
    (void)hipGetLastError();
    grid = cus * 1;
    fprintf(stderr, "kernel_launch: grid %d (cus %d, per_cu %d)\n", grid, cus, per_cu);
  }
  if (grid < 0) return;
  Args a; memset(&a, 0, sizeof(a));
  for (int i = 0; i < 22; ++i) a.in[i] = (const float*)d_in[i];
  a.out = (float*)d_out; a.ws = (unsigned char*)d_ws;
  for (int f = 0; f < 32; ++f) { a.inv_mla[f] = (float)pow((double)500000.0f, -(double)(2 * f) / 64.0); a.inv_ax[f] = (float)pow((double)10000.0f, -(double)(2 * f) / 64.0); }
  for (int f = 0; f < 8; ++f) a.inv_swa[f] = (float)pow((double)500000.0f, -(double)(2 * f) / 16.0);
  if (hipMemsetAsync(d_ws, 0, 512 * 1024, stream) != hipSuccess) { fprintf(stderr, "kernel_launch: memset failed\n"); return; }
#ifdef PROBE_PRO_KERNEL
  (void)hipFuncSetAttribute((const void*)probe_prologue, hipFuncAttributeMaxDynamicSharedMemorySize, LDS_BYTES);
  hipLaunchKernelGGL(probe_prologue, dim3(grid), dim3(NWAVES * 64), LDS_BYTES, stream, a);
#endif
  void* args[] = {&a};
#ifdef PROBE_PLAIN
  hipLaunchKernelGGL(fwd_megakernel, dim3(grid), dim3(NWAVES * 64), LDS_BYTES, stream, a); hipError_t e = hipPeekAtLastError();
#else
  hipError_t e = hipLaunchCooperativeKernel((const void*)fwd_megakernel, dim3(grid), dim3(NWAVES * 64), args, LDS_BYTES, stream);
#endif
  if (e != hipSuccess) fprintf(stderr, "kernel_launch: cooperative launch failed: %s (grid %d)\n", hipGetErrorString(e), grid);
}
```

```cpp
#include <hip/hip_runtime.h>
#include <hip/hip_cooperative_groups.h>
#include <cstdio>
#include <cstdint>
#include <cmath>
#include <cstring>
namespace cg = cooperative_groups;

namespace pg8 {
#define PG8_LAS __attribute__((address_space(3)))
typedef unsigned short bf16_t;
typedef short bf16x8 __attribute__((ext_vector_type(8)));
typedef float f32x4 __attribute__((ext_vector_type(4)));
typedef unsigned u32x4 __attribute__((ext_vector_type(4)));
constexpr int BM = 256, BK = 64, HALF = 128, HTB = HALF * BK * 2  , STAGE_BYTES = 8 * HTB, NXCD = 8, WGM = 8;

__host__ __device__ __forceinline__ int lds_byte(int r, int c) { const int st = (r >> 4) * 2 + (c >> 5), rr = r & 15, cc = c & 31, ob = rr * 64 + cc * 2; return st * 1024 + (ob ^ (((ob >> 9) & 1) << 5)); }
__host__ __device__ __forceinline__ void stage_rc(int b, int& R, int& C) { const int st = b / 1024, sb = b % 1024, swz = sb ^ (((sb >> 9) & 1) << 5); R = (st >> 1) * 16 + swz / 64; C = (st & 1) * 32 + (swz % 64) / 2; }
__host__ __device__ __forceinline__ int perm32(int rho) { const int n = rho >> 4, i = rho & 15; return 8 * (i >> 2) + 4 * n + (i & 3); }

struct Unit { int pm, pn; };
struct Gemm { const bf16_t* A; const bf16_t* Bt; int M, N, K; };

struct StaticOrder {
    int nM, nN, nwg, G, c;
    __host__ __device__ void init(int M, int N, int G_, int c_) { nM = M / BM; nN = N / BM; nwg = nM * nN; G = G_; c = c_; }
    __host__ __device__ bool next(int i, Unit& u) const {
        const long L = (long)i * G + c; if (L >= nwg) return false;
        int wgid = (int)L; { const int q = nwg / NXCD, r = nwg % NXCD, xcd = wgid % NXCD, off = wgid / NXCD; wgid = (xcd < r ? xcd * (q + 1) : r * (q + 1) + (xcd - r) * q) + off; }
        const int nig = WGM * nN, gid = wgid / nig, fm = gid * WGM, gsz = (nM - fm) < WGM ? (nM - fm) : WGM;
        u.pm = fm + ((wgid % nig) % gsz); u.pn = (wgid % nig) / gsz; return true;
    }
    __device__ __forceinline__ void a_ready(const Unit&) const {}
    __device__ __forceinline__ void done(const Unit&) const {}
};
__device__ __forceinline__ unsigned cvt_pk_bf16(float lo, float hi) { unsigned r; asm volatile("v_cvt_pk_bf16_f32 %0, %1, %2" : "=v"(r) : "v"(lo), "v"(hi)); return r; }
typedef float f32x2 __attribute__((ext_vector_type(2)));
__device__ __forceinline__ f32x2 gelu_pk(f32x2 v) {
    const f32x2 av = __builtin_elementwise_abs(v), d = av * 0.2316418882f + 1.0f;
    f32x2 t; t.x = __builtin_amdgcn_rcpf(d.x); t.y = __builtin_amdgcn_rcpf(d.y);
    f32x2 q = t * 0.5307027145f + (-0.7265760135f); q = q * t + 0.7107068705f; q = q * t + (-0.142248368f); q = q * t + 0.127414796f; q = q * t;
    const f32x2 s = (v * v) * (-0.72134752044f);
    f32x2 e; e.x = __builtin_amdgcn_exp2f(s.x); e.y = __builtin_amdgcn_exp2f(s.y);
    const f32x2 m = v * (q * e), r = v - m;
    f32x2 o; o.x = v.x < 0.f ? m.x : r.x; o.y = v.y < 0.f ? m.y : r.y; return o;
}

template <int ACT  > struct EpiBf16 {
    static constexpr bool PERM = true, AFTER_DRAIN = false; static_assert(ACT == 0 || ACT == 1, "EpiBf16: ACT is 0 (none) or 1 (gelu_pk)");
    bf16_t* O; int ldc; const float* bias; int split_cols; size_t split_stride; float scale0;
    __device__ __forceinline__ void operator()(const f32x4 (&acc)[2][2][4][2], const Unit& u, int wr, int wc, int fr, int fq) const {
        const int row0 = u.pm * BM + wr * 64 + fr; int colt = u.pn * BM; bf16_t* base = O;
        float sc = 1.f; if (split_cols) { const int t = colt / split_cols; base += (size_t)t * split_stride; colt -= t * split_cols; if (t == 0) sc = scale0; }
        const int col0 = colt + wc * 32 + 8 * fq, bcol0 = u.pn * BM + wc * 32 + 8 * fq;
        f32x4 bv[2][2];
#pragma unroll
        for (int bj = 0; bj < 2; ++bj)
#pragma unroll
            for (int n = 0; n < 2; ++n) bv[bj][n] = bias ? *(const f32x4*)(bias + bcol0 + bj * HALF + 4 * n) : (f32x4){0.f, 0.f, 0.f, 0.f};
#pragma unroll
        for (int ai = 0; ai < 2; ++ai)
#pragma unroll
            for (int m = 0; m < 4; ++m) { bf16_t* rowp = base + (size_t)(row0 + ai * HALF + m * 16) * ldc + col0;
#pragma unroll
                for (int bj = 0; bj < 2; ++bj) { f32x4 v0 = acc[ai][bj][m][0] + bv[bj][0], v1 = acc[ai][bj][m][1] + bv[bj][1];
                    if (ACT == 1) { f32x2 a = gelu_pk((f32x2){v0[0], v0[1]}), b = gelu_pk((f32x2){v0[2], v0[3]}), c = gelu_pk((f32x2){v1[0], v1[1]}), d = gelu_pk((f32x2){v1[2], v1[3]});
                        v0 = (f32x4){a.x, a.y, b.x, b.y}; v1 = (f32x4){c.x, c.y, d.x, d.y}; }
                    v0 = v0 * sc; v1 = v1 * sc; u32x4 w; w.x = cvt_pk_bf16(v0[0], v0[1]); w.y = cvt_pk_bf16(v0[2], v0[3]); w.z = cvt_pk_bf16(v1[0], v1[1]); w.w = cvt_pk_bf16(v1[2], v1[3]);
                    *(u32x4*)(rowp + bj * HALF) = w; } }
    }
};

template <int ACT  > struct EpiB {
    static constexpr bool PERM = true, AFTER_DRAIN = false;
    bf16_t* O; int ldc; const float* rowss; float inv_n, eps;
    __device__ __forceinline__ void operator()(const f32x4 (&acc)[2][2][4][2], const Unit& u, int wr, int wc, int fr, int fq) const {
        const int row0 = u.pm * BM + wr * 64 + fr; const int col0 = u.pn * BM + wc * 32 + 8 * fq;
#pragma unroll
        for (int ai = 0; ai < 2; ++ai)
#pragma unroll
            for (int m = 0; m < 4; ++m) { bf16_t* rowp = O + (size_t)(row0 + ai * HALF + m * 16) * ldc + col0;
                const float rs = rowss ? 1.0f / sqrtf(rowss[row0 + ai * HALF + m * 16] * inv_n + eps) : 1.0f;
#pragma unroll
                for (int bj = 0; bj < 2; ++bj) { f32x4 v0 = acc[ai][bj][m][0] * rs, v1 = acc[ai][bj][m][1] * rs;
                    if (ACT == 2) {
#pragma unroll
                        for (int e = 0; e < 4; ++e) { float a = fmaxf(v0[e], 0.f), b = fmaxf(v1[e], 0.f); v0[e] = a * a; v1[e] = b * b; } }
                    u32x4 w; w.x = cvt_pk_bf16(v0[0], v0[1]); w.y = cvt_pk_bf16(v0[2], v0[3]); w.z = cvt_pk_bf16(v1[0], v1[1]); w.w = cvt_pk_bf16(v1[2], v1[3]);
                    *(u32x4*)(rowp + bj * HALF) = w; } }
    }
};
template <bool BASEBF> struct EpiRes {
    static constexpr bool PERM = true, AFTER_DRAIN = false;
    const void* base; float* out; int ldc; const float* sc_ss; float sc_inv_n, sc_eps;
    __device__ __forceinline__ void operator()(const f32x4 (&acc)[2][2][4][2], const Unit& u, int wr, int wc, int fr, int fq) const {
        const int row0 = u.pm * BM + wr * 64 + fr; const int col0 = u.pn * BM + wc * 32 + 8 * fq;
#pragma unroll
        for (int ai = 0; ai < 2; ++ai)
#pragma unroll
            for (int m = 0; m < 4; ++m) { const size_t off = (size_t)(row0 + ai * HALF + m * 16) * ldc + col0;
                const float sc = sc_ss ? 1.0f / (sc_ss[row0 + ai * HALF + m * 16] * sc_inv_n + sc_eps) : 1.0f;
#pragma unroll
                for (int bj = 0; bj < 2; ++bj) { f32x4 b0, b1;
                    if (BASEBF) { const u32x4 w = *(const u32x4*)((const bf16_t*)base + off + bj * HALF);
                        b0 = (f32x4){__uint_as_float(w.x << 16), __uint_as_float(w.x & 0xffff0000u), __uint_as_float(w.y << 16), __uint_as_float(w.y & 0xffff0000u)};
                        b1 = (f32x4){__uint_as_float(w.z << 16), __uint_as_float(w.z & 0xffff0000u), __uint_as_float(w.w << 16), __uint_as_float(w.w & 0xffff0000u)}; }
                    else { b0 = *(const f32x4*)((const float*)base + off + bj * HALF); b1 = *(const f32x4*)((const float*)base + off + bj * HALF + 4); }
                    *(f32x4*)(out + off + bj * HALF) = b0 + acc[ai][bj][m][0] * sc; *(f32x4*)(out + off + bj * HALF + 4) = b1 + acc[ai][bj][m][1] * sc; } }
    }
};
template <bool BASEBF> struct EpiResN {
    static constexpr bool PERM = true, AFTER_DRAIN = false;
    const void* base; bf16_t* xn; float* rowss; int ldc; const float* sc_ss; float sc_inv_n, sc_eps;
    __device__ __forceinline__ void operator()(const f32x4 (&acc)[2][2][4][2], const Unit& u, int wr, int wc, int fr, int fq) const {
        const int row0 = u.pm * BM + wr * 64 + fr; const int col0 = u.pn * BM + wc * 32 + 8 * fq;
#pragma unroll
        for (int ai = 0; ai < 2; ++ai)
#pragma unroll
            for (int m = 0; m < 4; ++m) { const int row = row0 + ai * HALF + m * 16; const size_t off = (size_t)row * ldc + col0; float ss = 0.f;
                const float sc = sc_ss ? 1.0f / (sc_ss[row] * sc_inv_n + sc_eps) : 1.0f;
#pragma unroll
                for (int bj = 0; bj < 2; ++bj) { f32x4 b0, b1;
                    if (BASEBF) { const u32x4 w = *(const u32x4*)((const bf16_t*)base + off + bj * HALF);
                        b0 = (f32x4){__uint_as_float(w.x << 16), __uint_as_float(w.x & 0xffff0000u), __uint_as_float(w.y << 16), __uint_as_float(w.y & 0xffff0000u)};
                        b1 = (f32x4){__uint_as_float(w.z << 16), __uint_as_float(w.z & 0xffff0000u), __uint_as_float(w.w << 16), __uint_as_float(w.w & 0xffff0000u)}; }
                    else { b0 = *(const f32x4*)((const float*)base + off + bj * HALF); b1 = *(const f32x4*)((const float*)base + off + bj * HALF + 4); }
                    const f32x4 o0 = b0 + acc[ai][bj][m][0] * sc, o1 = b1 + acc[ai][bj][m][1] * sc;
                    ss += ((o0[0] * o0[0] + o0[1] * o0[1]) + (o0[2] * o0[2] + o0[3] * o0[3])) + ((o1[0] * o1[0] + o1[1] * o1[1]) + (o1[2] * o1[2] + o1[3] * o1[3]));
                    u32x4 w; w.x = cvt_pk_bf16(o0[0], o0[1]); w.y = cvt_pk_bf16(o0[2], o0[3]); w.z = cvt_pk_bf16(o1[0], o1[1]); w.w = cvt_pk_bf16(o1[2], o1[3]);
                    *(u32x4*)(xn + off + bj * HALF) = w; }
                ss += __shfl_xor(ss, 16); ss += __shfl_xor(ss, 32);
                if (fq == 0) atomicAdd(rowss + row, ss); }
    }
};
struct EpiNone {
    static constexpr bool PERM = true, AFTER_DRAIN = false;
    __device__ __forceinline__ void operator()(const f32x4 (&acc)[2][2][4][2], const Unit& u, int wr, int wc, int fr, int fq) const {
#pragma unroll
        for (int ai = 0; ai < 2; ++ai)
#pragma unroll
            for (int bj = 0; bj < 2; ++bj)
#pragma unroll
                for (int m = 0; m < 4; ++m)
#pragma unroll
                    for (int n = 0; n < 2; ++n) asm volatile("" :: "v"(acc[ai][bj][m][n]));
    }
};
template <int ACT> struct EpiBL {
    static constexpr bool PERM = true, AFTER_DRAIN = false;
    static constexpr int ROWB = 528;
    bf16_t* O; int ldc; PG8_LAS unsigned char* est;
    __device__ __forceinline__ void operator()(const f32x4 (&acc)[2][2][4][2], const Unit& u, int wr, int wc, int fr, int fq) const {
        const int tid = (wr * 4 + wc) * 64 + fq * 16 + fr;
        PG8_LAS unsigned char* wp = est + (wr * 16 + fr) * ROWB + (wc * 32 + 8 * fq) * 2;
        const int rr = tid >> 5, ch = tid & 31;
        const PG8_LAS unsigned char* rp = est + rr * ROWB + ch * 16;
        bf16_t* gbase = O + (size_t)(u.pm * BM) * ldc + u.pn * BM + ch * 8;
#pragma unroll
        for (int ai = 0; ai < 2; ++ai)
#pragma unroll
            for (int m = 0; m < 4; ++m) {
#pragma unroll
                for (int bj = 0; bj < 2; ++bj) { f32x4 v0 = acc[ai][bj][m][0], v1 = acc[ai][bj][m][1];
                    if (ACT == 2) {
#pragma unroll
                        for (int q = 0; q < 4; ++q) { float a = fmaxf(v0[q], 0.f), b = fmaxf(v1[q], 0.f); v0[q] = a * a; v1[q] = b * b; } }
                    u32x4 w; w.x = cvt_pk_bf16(v0[0], v0[1]); w.y = cvt_pk_bf16(v0[2], v0[3]); w.z = cvt_pk_bf16(v1[0], v1[1]); w.w = cvt_pk_bf16(v1[2], v1[3]);
                    *(PG8_LAS u32x4*)(wp + bj * 256) = w; }
                asm volatile("s_waitcnt lgkmcnt(0)" ::: "memory"); __builtin_amdgcn_s_barrier(); asm volatile("" ::: "memory");
#pragma unroll
                for (int p = 0; p < 2; ++p) { const int r = p * 16 + rr;
                    const u32x4 v = *(const PG8_LAS u32x4*)(rp + p * 16 * ROWB);
                    *(u32x4*)(gbase + (size_t)(ai * HALF + (r >> 4) * 64 + m * 16 + (r & 15)) * ldc) = v; }
                asm volatile("s_waitcnt lgkmcnt(0)" ::: "memory"); __builtin_amdgcn_s_barrier(); asm volatile("" ::: "memory");
            }
    }
};
struct EpiQKV {
    static constexpr bool PERM = true, AFTER_DRAIN = false;
    bf16_t* SQ; long k_off, v_off; const float* rowss; float inv_n, eps; const float *gq, *gk; const float* tsw; int seq_shift;
    __device__ __forceinline__ void operator()(const f32x4 (&acc)[2][2][4][2], const Unit& u, int wr, int wc, int fr, int fq) const {
        const int pn = u.pn; const bool isv = pn == 9, isk = pn == 8;
        const float* g = gq; if (isk) g = gk;
        const int seq = 1 << seq_shift;
        long boff = 0; if (isk) boff = k_off; if (isv) boff = v_off;
        bf16_t* base = SQ + boff; const int nh = (isv || isk) ? 4 : 32, h = (isv || isk) ? wc : pn * 4 + wc;
        const float sg = fq ? 1.f : -1.f;
#pragma unroll
        for (int ai = 0; ai < 2; ++ai)
#pragma unroll
            for (int m = 0; m < 4; ++m) { const int t = u.pm * BM + ai * HALF + wr * 64 + m * 16 + fr; const int b = t >> seq_shift, s = t & (seq - 1);
                const float rs = 1.0f / sqrtf(rowss[t] * inv_n + eps);
                f32x4 x00 = acc[ai][0][m][0] * rs, x01 = acc[ai][0][m][1] * rs, x10 = acc[ai][1][m][0] * rs, x11 = acc[ai][1][m][1] * rs;
                if (!isv) {
                    float ss = ((x00[0] * x00[0] + x00[1] * x00[1]) + (x00[2] * x00[2] + x00[3] * x00[3])) + ((x01[0] * x01[0] + x01[1] * x01[1]) + (x01[2] * x01[2] + x01[3] * x01[3]))
                             + ((x10[0] * x10[0] + x10[1] * x10[1]) + (x10[2] * x10[2] + x10[3] * x10[3])) + ((x11[0] * x11[0] + x11[1] * x11[1]) + (x11[2] * x11[2] + x11[3] * x11[3]));
                    ss += __shfl_xor(ss, 16); ss += __shfl_xor(ss, 32);
                    const float hr = 1.0f / sqrtf(ss * (1.f / 64) + eps);
                    x00 = x00 * hr * *(const f32x4*)(g + 8 * fq); x01 = x01 * hr * *(const f32x4*)(g + 8 * fq + 4); x10 = x10 * hr * *(const f32x4*)(g + 32 + 8 * fq); x11 = x11 * hr * *(const f32x4*)(g + 36 + 8 * fq);
                    f32x4 p0, p1;
#pragma unroll
                    for (int q = 0; q < 4; ++q) { p0[q] = __shfl_xor(x00[q], 16); p1[q] = __shfl_xor(x01[q], 16); }
                    if (fq < 2) { const f32x4* cs = (const f32x4*)(tsw + (size_t)s * 16); const f32x4 c0 = cs[0], c1 = cs[1], c2 = cs[2], c3 = cs[3];
                        x00 = (f32x4){x00[0] * c0[0] + sg * p0[0] * c0[1], x00[1] * c0[2] + sg * p0[1] * c0[3], x00[2] * c1[0] + sg * p0[2] * c1[1], x00[3] * c1[2] + sg * p0[3] * c1[3]};
                        x01 = (f32x4){x01[0] * c2[0] + sg * p1[0] * c2[1], x01[1] * c2[2] + sg * p1[1] * c2[3], x01[2] * c3[0] + sg * p1[2] * c3[1], x01[3] * c3[2] + sg * p1[3] * c3[3]}; }
                }
                bf16_t* dst = base + ((size_t)(b * nh + h) * seq + s) * 64 + 8 * fq;
                u32x4 w; w.x = cvt_pk_bf16(x00[0], x00[1]); w.y = cvt_pk_bf16(x00[2], x00[3]); w.z = cvt_pk_bf16(x01[0], x01[1]); w.w = cvt_pk_bf16(x01[2], x01[3]);
                *(u32x4*)dst = w;
                w.x = cvt_pk_bf16(x10[0], x10[1]); w.y = cvt_pk_bf16(x10[2], x10[3]); w.z = cvt_pk_bf16(x11[0], x11[1]); w.w = cvt_pk_bf16(x11[2], x11[3]);
                *(u32x4*)(dst + 32) = w;
                asm volatile("" ::: "memory"); }
    }
};
template <size_t KA_OFF, size_t VA_OFF, size_t KR_OFF, int XCH_OFF, int SEQ_SHIFT> struct EpiKV {
    static constexpr bool PERM = true, AFTER_DRAIN = false;
    unsigned char* wsb; const float* gkn; PG8_LAS unsigned char* ldsb; float eps;
    __device__ __forceinline__ void operator()(const f32x4 (&acc)[2][2][4][2], const Unit& u, int wr, int wc, int fr, int fq) const {
        { int t_ = threadIdx.x; asm volatile("" : "+v"(t_)); fr = t_ & 15; fq = (t_ >> 4) & 3; }
        constexpr int seq_shift = SEQ_SHIFT; const int h = u.pn, seq = 1 << seq_shift;
        bf16_t* KA = (bf16_t*)(wsb + KA_OFF); bf16_t* VA = (bf16_t*)(wsb + VA_OFF); PG8_LAS float* xch = (PG8_LAS float*)(ldsb + XCH_OFF);
#pragma unroll
        for (int ai = 0; ai < 2; ++ai)
#pragma unroll
            for (int m = 0; m < 4; ++m) { const f32x4 a0 = acc[ai][0][m][0], a1 = acc[ai][0][m][1];
                float ss = ((a0[0] * a0[0] + a0[1] * a0[1]) + (a0[2] * a0[2] + a0[3] * a0[3])) + ((a1[0] * a1[0] + a1[1] * a1[1]) + (a1[2] * a1[2] + a1[3] * a1[3]));
                ss += __int_as_float(__builtin_amdgcn_ds_swizzle(__float_as_int(ss), 0x401F));
                { auto rr = __builtin_amdgcn_permlane32_swap(__float_as_uint(ss), __float_as_uint(ss), false, false); ss = __uint_as_float(rr[0]) + __uint_as_float(rr[1]); }
                if (fq == 0) xch[(ai * HALF + wr * 64 + m * 16 + fr) * 4 + wc] = ss; }
        asm volatile("s_waitcnt lgkmcnt(0)" ::: "memory"); __builtin_amdgcn_s_barrier(); asm volatile("" ::: "memory");
        const f32x4 g0 = *(const f32x4*)(gkn + wc * 32 + 8 * fq), g1 = *(const f32x4*)(gkn + wc * 32 + 8 * fq + 4);
#pragma unroll
        for (int ai = 0; ai < 2; ++ai)
#pragma unroll
            for (int m = 0; m < 4; ++m) { const int r = ai * HALF + wr * 64 + m * 16 + fr, t = u.pm * BM + r, b = t >> seq_shift, s = t & (seq - 1);
                const f32x4 p = *(const PG8_LAS f32x4*)(xch + r * 4);
                const float rstd = 1.0f / sqrtf(((p[0] + p[1]) + (p[2] + p[3])) * (1.f / 128) + eps);
                const f32x4 k0 = acc[ai][0][m][0] * rstd * g0, k1 = acc[ai][0][m][1] * rstd * g1, v0 = acc[ai][1][m][0], v1 = acc[ai][1][m][1];
                const size_t row = (size_t)(b * 8 + h) * seq + s;
                u32x4 w; w.x = cvt_pk_bf16(k0[0], k0[1]); w.y = cvt_pk_bf16(k0[2], k0[3]); w.z = cvt_pk_bf16(k1[0], k1[1]); w.w = cvt_pk_bf16(k1[2], k1[3]);
                *(u32x4*)(KA + row * 192 + wc * 32 + 8 * fq) = w;
                w.x = cvt_pk_bf16(v0[0], v0[1]); w.y = cvt_pk_bf16(v0[2], v0[3]); w.z = cvt_pk_bf16(v1[0], v1[1]); w.w = cvt_pk_bf16(v1[2], v1[3]);
                *(u32x4*)(VA + row * 128 + wc * 32 + 8 * fq) = w;
                asm volatile("" ::: "memory"); }
    }
};

template <class Epi, class Sched, bool ALIGN_EPI = false, bool SP2 = false>
__device__ __forceinline__ void gemm_phase(PG8_LAS unsigned char* lds, const Gemm g, const Sched& S, const Epi& E) {
    int tid = threadIdx.x; asm volatile("" : "+v"(tid));
    const int wid = __builtin_amdgcn_readfirstlane(tid >> 6), lane = tid & 63, wr = wid >> 2, wc = wid & 3, fr = lane & 15, fq = lane >> 4;
    const int K = g.K, nt = K / BK;
    unsigned voffA[2], voffB[2];
#pragma unroll
    for (int i = 0; i < 2; ++i) { int R, C; stage_rc(tid * 16 + i * 8192, R, C); const int Rb = Epi::PERM ? ((R & ~31) + perm32(R & 31)) : R;
        voffA[i] = (unsigned)(R * K + C) * 2u; voffB[i] = (unsigned)(Rb * K + C) * 2u; }
    const size_t kstep = (size_t)(BK * 2);
    const size_t hstep = (size_t)HALF * K * 2;
    const size_t tstep = 2 * hstep;
    const unsigned ldsw = (unsigned)wid * 1024u;
    const int aoff = lds_byte(wr * 64 + fr, fq * 8), boff = lds_byte(wc * 32 + fr, fq * 8);
#define PG8_SA(b, h) (((b) * 2 + (h)) * HTB)
#define PG8_SB(b, h) ((4 + (b) * 2 + (h)) * HTB)
#define PG8_STAGE(bufoff, gbase, voff) do { _Pragma("unroll") for (int _i = 0; _i < 2; ++_i) \
        __builtin_amdgcn_global_load_lds((const unsigned*)((const char*)(gbase) + (voff)[_i]), (PG8_LAS unsigned*)(lds + (bufoff) + ldsw + _i * 8192), 16, 0, 0); } while (0)
#define PG8_LDA(dst, b, h) do { _Pragma("unroll") for (int m = 0; m < 4; ++m) _Pragma("unroll") for (int k = 0; k < 2; ++k) dst[m][k] = *(const PG8_LAS bf16x8*)(lds + PG8_SA(b, h) + aoff + m * 2048 + k * 1024); } while (0)
#define PG8_LDB(dst, b, h) do { _Pragma("unroll") for (int n = 0; n < 2; ++n) _Pragma("unroll") for (int k = 0; k < 2; ++k) dst[n][k] = *(const PG8_LAS bf16x8*)(lds + PG8_SB(b, h) + boff + n * 2048 + k * 1024); } while (0)
#define PG8_MMA(ai, bj, At, Bt) do { __builtin_amdgcn_s_setprio(1); _Pragma("unroll") for (int m = 0; m < 4; ++m) _Pragma("unroll") for (int n = 0; n < 2; ++n) _Pragma("unroll") for (int k = 0; k < 2; ++k) \
        acc[ai][bj][m][n] = __builtin_amdgcn_mfma_f32_16x16x32_bf16(Bt[n][k], At[m][k], acc[ai][bj][m][n], 0, 0, 0); __builtin_amdgcn_s_setprio(0); } while (0)
#define PG8_WAIT_V(n) asm volatile("s_waitcnt vmcnt(" #n ")" ::: "memory")
#define PG8_WAIT_L(n) asm volatile("s_waitcnt lgkmcnt(" #n ")" ::: "memory")
#define PG8_BAR __builtin_amdgcn_s_barrier()
#define PG8_SCHED __builtin_amdgcn_sched_barrier(0)
    Unit cur, nxt; int ui = 0;
    if (!S.next(0, cur)) return;
    f32x4 acc[2][2][4][2];
#pragma unroll
    for (int a = 0; a < 2; ++a)
#pragma unroll
        for (int b = 0; b < 2; ++b)
#pragma unroll
            for (int m = 0; m < 4; ++m)
#pragma unroll
                for (int n = 0; n < 2; ++n) acc[a][b][m][n] = (f32x4){0.f, 0.f, 0.f, 0.f};
    bf16x8 At[4][2], B0[2][2], B1[2][2];
    const char* cA = (const char*)g.A + (size_t)cur.pm * tstep; const char* cB = (const char*)g.Bt + (size_t)cur.pn * tstep;
    S.a_ready(cur);
    if constexpr (SP2) {
        PG8_STAGE(PG8_SB(0, 0), cB, voffB); PG8_STAGE(PG8_SB(0, 1), cB + hstep, voffB); PG8_STAGE(PG8_SA(0, 0), cA, voffA); PG8_STAGE(PG8_SA(0, 1), cA + hstep, voffA);
        if (wr == 1) PG8_BAR;
        PG8_WAIT_V(2); PG8_BAR;
        PG8_STAGE(PG8_SB(1, 0), cB + kstep, voffB); PG8_STAGE(PG8_SA(1, 0), cA + kstep, voffA); PG8_STAGE(PG8_SB(1, 1), cB + hstep + kstep, voffB);
        PG8_WAIT_V(6); PG8_BAR;
    } else {
        PG8_STAGE(PG8_SB(0, 0), cB, voffB); PG8_STAGE(PG8_SA(0, 0), cA, voffA); PG8_STAGE(PG8_SB(0, 1), cB + hstep, voffB); PG8_STAGE(PG8_SA(0, 1), cA + hstep, voffA);
        if (wr == 1) PG8_BAR;
        PG8_WAIT_V(4); PG8_BAR;
        PG8_STAGE(PG8_SB(1, 0), cB + kstep, voffB); PG8_STAGE(PG8_SA(1, 0), cA + kstep, voffA); PG8_STAGE(PG8_SB(1, 1), cB + hstep + kstep, voffB);
        PG8_WAIT_V(6); PG8_BAR;
    }
    for (;;) {
        const bool has_next = S.next(ui + 1, nxt);
        const char* nA = has_next ? (const char*)g.A + (size_t)nxt.pm * tstep : cA; const char* nB = has_next ? (const char*)g.Bt + (size_t)nxt.pn * tstep : cB;
        for (int t = 0; t < nt; t += 2) {
            const bool last = (t == nt - 2);
            const char* a1 = cA + (size_t)(t + 1) * kstep;
            const char* a2 = last ? nA : cA + (size_t)(t + 2) * kstep; const char* b2 = last ? nB : cB + (size_t)(t + 2) * kstep;
            const char* a3 = a2 + kstep; const char* b3 = b2 + kstep;
            if (last && has_next) S.a_ready(nxt);
            if constexpr (SP2) {
            PG8_LDB(B0, 0, 0); PG8_LDB(B1, 0, 1); PG8_SCHED; PG8_LDA(At, 0, 0); PG8_STAGE(PG8_SA(1, 1), a1 + hstep, voffA);
            PG8_WAIT_V(8); PG8_WAIT_L(0); PG8_BAR; PG8_MMA(0, 0, At, B0); PG8_MMA(0, 1, At, B1); PG8_BAR; PG8_SCHED;
            PG8_LDA(At, 0, 1); PG8_STAGE(PG8_SB(0, 0), b2, voffB); PG8_STAGE(PG8_SB(0, 1), b2 + hstep, voffB); PG8_STAGE(PG8_SA(0, 0), a2, voffA);
            PG8_WAIT_V(8); PG8_WAIT_L(0); PG8_BAR; PG8_MMA(1, 0, At, B0); PG8_MMA(1, 1, At, B1); PG8_BAR; PG8_SCHED;
            PG8_LDB(B0, 1, 0); PG8_LDB(B1, 1, 1); PG8_SCHED; PG8_LDA(At, 1, 0); PG8_STAGE(PG8_SA(0, 1), a2 + hstep, voffA);
            PG8_WAIT_V(8); PG8_WAIT_L(0); PG8_BAR; PG8_MMA(0, 0, At, B0); PG8_MMA(0, 1, At, B1); PG8_BAR; PG8_SCHED;
            PG8_LDA(At, 1, 1); PG8_STAGE(PG8_SB(1, 0), b3, voffB); PG8_STAGE(PG8_SB(1, 1), b3 + hstep, voffB); PG8_STAGE(PG8_SA(1, 0), a3, voffA);
            PG8_WAIT_V(8); PG8_WAIT_L(0); PG8_BAR; PG8_MMA(1, 0, At, B0); PG8_MMA(1, 1, At, B1); PG8_BAR; PG8_SCHED;
            } else {
            PG8_LDB(B0, 0, 0); PG8_SCHED; PG8_LDA(At, 0, 0); PG8_STAGE(PG8_SA(1, 1), a1 + hstep, voffA);
            PG8_WAIT_L(8); PG8_BAR; PG8_WAIT_L(0); PG8_MMA(0, 0, At, B0); PG8_BAR; PG8_SCHED;
            PG8_LDB(B1, 0, 1); PG8_STAGE(PG8_SB(0, 0), b2, voffB);
            PG8_BAR; PG8_WAIT_L(0); PG8_MMA(0, 1, At, B1); PG8_BAR;
            PG8_LDA(At, 0, 1); PG8_STAGE(PG8_SA(0, 0), a2, voffA);
            PG8_BAR; PG8_WAIT_L(0); PG8_MMA(1, 0, At, B0); PG8_BAR; PG8_SCHED;
            PG8_STAGE(PG8_SB(0, 1), b2 + hstep, voffB);
            PG8_WAIT_V(6); PG8_BAR; PG8_MMA(1, 1, At, B1); PG8_BAR;
            PG8_LDB(B0, 1, 0); PG8_SCHED; PG8_LDA(At, 1, 0); PG8_STAGE(PG8_SA(0, 1), a2 + hstep, voffA);
            PG8_WAIT_L(8); PG8_BAR; PG8_WAIT_L(0); PG8_MMA(0, 0, At, B0); PG8_BAR; PG8_SCHED;
            PG8_LDB(B1, 1, 1); PG8_STAGE(PG8_SB(1, 0), b3, voffB);
            PG8_BAR; PG8_WAIT_L(0); PG8_MMA(0, 1, At, B1); PG8_BAR;
            PG8_LDA(At, 1, 1); PG8_STAGE(PG8_SA(1, 0), a3, voffA);
            PG8_BAR; PG8_WAIT_L(0); PG8_MMA(1, 0, At, B0); PG8_BAR; PG8_SCHED;
            PG8_STAGE(PG8_SB(1, 1), b3 + hstep, voffB);
            PG8_WAIT_V(6); PG8_BAR; PG8_MMA(1, 1, At, B1); PG8_BAR;
            }
        }
        if constexpr (ALIGN_EPI) { if (wr == 0) PG8_BAR; }
        if constexpr (!Epi::AFTER_DRAIN) { E(acc, cur, wr, wc, fr, fq); S.done(cur); }
        if (!has_next) break;
#pragma unroll
        for (int a = 0; a < 2; ++a)
#pragma unroll
            for (int b = 0; b < 2; ++b)
#pragma unroll
                for (int m = 0; m < 4; ++m)
#pragma unroll
                    for (int n = 0; n < 2; ++n) acc[a][b][m][n] = (f32x4){0.f, 0.f, 0.f, 0.f};
        cur = nxt; cA = nA; cB = nB; ++ui;
        if constexpr (ALIGN_EPI) { if (wr == 1) PG8_BAR; }
    }
    PG8_WAIT_V(0);
    if constexpr (!ALIGN_EPI) { if (wr == 0) PG8_BAR; }
    PG8_BAR;
    if constexpr (Epi::AFTER_DRAIN) { E.fused(acc, cur, wr, wc, fr, fq, lds, wid, lane); S.done(cur); }
#undef PG8_SA
#undef PG8_SB
#undef PG8_STAGE
#undef PG8_LDA
#undef PG8_LDB
#undef PG8_MMA
#undef PG8_WAIT_V
#undef PG8_WAIT_L
#undef PG8_BAR
#undef PG8_SCHED
}
}

namespace att {
typedef unsigned short bf16;
using bf16x8 = __attribute__((ext_vector_type(8))) short;
using s16x4  = __attribute__((ext_vector_type(4))) short;
using f32x16 = __attribute__((ext_vector_type(16))) float;
using u32x4  = __attribute__((ext_vector_type(4))) unsigned;
constexpr int NW = 8, QBLK = 32, KVBLK = 64;
#define SBAR() __builtin_amdgcn_sched_barrier(0)
__device__ __forceinline__ int crow(int r, int hi) { return (r & 3) + 8 * (r >> 2) + 4 * hi; }
__device__ __forceinline__ unsigned cvtpk(float lo, float hi) { unsigned r; asm volatile("v_cvt_pk_bf16_f32 %0, %1, %2" : "=v"(r) : "v"(lo), "v"(hi)); return r; }
template <int DK> __device__ __forceinline__ int kswz(int row, int colB) { const int f = (DK == 128) ? ((row & 7) | ((row & 16) >> 1)) : ((row >> 1) & 7); return row * (DK * 2) + (colB ^ (f << 4)); }

__device__ __forceinline__ void partialSM(f32x16& p0, f32x16& p1, float& m_reg, float& mn, float& alpha, const float C, const float thr_raw) {
  float pmax = p0[0];
#pragma unroll
  for (int r = 1; r < 16; ++r) pmax = fmaxf(pmax, p0[r]);
#pragma unroll
  for (int r = 0; r < 16; ++r) pmax = fmaxf(pmax, p1[r]);
  { auto rr = __builtin_amdgcn_permlane32_swap(__float_as_uint(pmax), __float_as_uint(pmax), false, false);
    pmax = fmaxf(__uint_as_float(rr[0]), __uint_as_float(rr[1])); }
  if (__builtin_expect(__all(pmax - m_reg <= thr_raw), 1)) { mn = m_reg; alpha = 1.f; }
  else { mn = fmaxf(m_reg, pmax); alpha = __builtin_amdgcn_exp2f((m_reg - mn) * C); m_reg = mn; }
  float mnC = -mn * C;
#pragma unroll
  for (int r = 0; r < 16; ++r) p0[r] = fmaf(p0[r], C, mnC);
#pragma unroll
  for (int r = 0; r < 16; ++r) p1[r] = fmaf(p1[r], C, mnC);
#pragma unroll
  for (int r = 0; r < 16; ++r) p0[r] = __builtin_amdgcn_exp2f(p0[r]);
}
__device__ __forceinline__ void finishSM(f32x16& p0, f32x16& p1, float alpha, float& l_reg, bf16x8& pa0, bf16x8& pa1, bf16x8& pa2, bf16x8& pa3) {
#pragma unroll
  for (int r = 0; r < 16; ++r) p1[r] = __builtin_amdgcn_exp2f(p1[r]);
  float ps = 0;
#pragma unroll
  for (int r = 0; r < 16; ++r) ps += p0[r];
#pragma unroll
  for (int r = 0; r < 16; ++r) ps += p1[r];
  { auto rr = __builtin_amdgcn_permlane32_swap(__float_as_uint(ps), __float_as_uint(ps), false, false);
    ps = __uint_as_float(rr[0]) + __uint_as_float(rr[1]); }
  l_reg = l_reg * alpha + ps;
#define PK4(P, BASE, OUT) do { unsigned a0 = cvtpk(P[BASE + 0], P[BASE + 1]), a1 = cvtpk(P[BASE + 2], P[BASE + 3]);   \
    unsigned b0 = cvtpk(P[BASE + 4], P[BASE + 5]), b1 = cvtpk(P[BASE + 6], P[BASE + 7]);                              \
    auto r0 = __builtin_amdgcn_permlane32_swap(a0, b0, false, false); auto r1 = __builtin_amdgcn_permlane32_swap(a1, b1, false, false); \
    u32x4 w = {r0[0], r1[0], r0[1], r1[1]}; OUT = *reinterpret_cast<bf16x8*>(&w); } while (0)
  PK4(p0, 0, pa0); PK4(p0, 8, pa1); PK4(p1, 0, pa2); PK4(p1, 8, pa3);
#undef PK4
}
template <int DK, int GS> __device__ __forceinline__ void qkt(f32x16& p0, f32x16& p1, const char* Ks, const int (&kb)[4], const int (&kbx)[4], const bf16x8* qr) {
  constexpr int ND = DK / 16, NG = ND / GS;
  static_assert(ND % GS == 0, "group size");
  p0 = f32x16{}; p1 = f32x16{};
  bf16x8 fa[2][GS], fb[2][GS];
#define QK_RD(buf, g) do { _Pragma("unroll") for (int s_ = 0; s_ < GS; ++s_) { const int d0_ = (g) * GS + s_, e_ = d0_ & 3, gg_ = d0_ >> 2; \
      const int ko_ = (DK == 128) ? (gg_ ? kbx[e_] : kb[e_]) : (kb[e_] + gg_ * 128); \
      fa[buf][s_] = *reinterpret_cast<const bf16x8*>(Ks + ko_); fb[buf][s_] = *reinterpret_cast<const bf16x8*>(Ks + ko_ + 32 * DK * 2); } } while (0)
  QK_RD(0, 0);
#pragma unroll
  for (int g = 0; g < NG; ++g) {
    if (g + 1 < NG) { QK_RD((g + 1) & 1, g + 1); }
    SBAR();
#pragma unroll
    for (int s_ = 0; s_ < GS; ++s_) {
      p0 = __builtin_amdgcn_mfma_f32_32x32x16_bf16(fa[g & 1][s_], qr[g * GS + s_], p0, 0, 0, 0);
      p1 = __builtin_amdgcn_mfma_f32_32x32x16_bf16(fb[g & 1][s_], qr[g * GS + s_], p1, 0, 0, 0); }
    SBAR();
  }
#undef QK_RD
}
template <int NCB> __device__ __forceinline__ int v_st(int k, int c) { const int kk = (k & ~0xC) | ((k & 4) << 1) | ((k & 8) >> 1); return ((kk >> 3) * NCB + (c >> 5)) * 512 + ((kk & 7) * 32 + (c & 31)) * 2; }
__device__ __forceinline__ int v_rd_base(int lane) { return ((lane & 3) << 3) | (((lane >> 2) & 3) << 6) | (((lane >> 4) & 1) << 5) | (((lane >> 5) & 1) << 8); }
template <int OFF> __device__ __forceinline__ s16x4 tr_read(int vb) {
  s16x4 r; asm volatile("ds_read_b64_tr_b16 %0, %1 offset:%2" : "=&v"(r) : "v"(vb), "i"(OFF) : "memory"); return r;
}
template <int D0, int NCB> __device__ __forceinline__ void pv_one(f32x16& od, int vb, bf16x8 pa0, bf16x8 pa1, bf16x8 pa2, bf16x8 pa3) {
#define VOFF(ks, half) (D0 * 512 + (ks) * (1024 * NCB) + (half) * (512 * NCB))
  const s16x4 l0 = tr_read<VOFF(0, 0)>(vb), h0 = tr_read<VOFF(0, 1)>(vb), l1 = tr_read<VOFF(1, 0)>(vb), h1 = tr_read<VOFF(1, 1)>(vb);
  const s16x4 l2 = tr_read<VOFF(2, 0)>(vb), h2 = tr_read<VOFF(2, 1)>(vb), l3 = tr_read<VOFF(3, 0)>(vb), h3 = tr_read<VOFF(3, 1)>(vb);
#undef VOFF
  asm volatile("s_waitcnt lgkmcnt(0)" ::: "memory"); SBAR();
#define PK(L, H) (bf16x8){L[0], L[1], L[2], L[3], H[0], H[1], H[2], H[3]}
  od = __builtin_amdgcn_mfma_f32_32x32x16_bf16(pa0, PK(l0, h0), od, 0, 0, 0);
  od = __builtin_amdgcn_mfma_f32_32x32x16_bf16(pa1, PK(l1, h1), od, 0, 0, 0);
  od = __builtin_amdgcn_mfma_f32_32x32x16_bf16(pa2, PK(l2, h2), od, 0, 0, 0);
  od = __builtin_amdgcn_mfma_f32_32x32x16_bf16(pa3, PK(l3, h3), od, 0, 0, 0);
#undef PK
}
template <int NCB> __device__ __forceinline__ void pv_all(f32x16* o, int vb, bf16x8 pa0, bf16x8 pa1, bf16x8 pa2, bf16x8 pa3) {
  pv_one<0, NCB>(o[0], vb, pa0, pa1, pa2, pa3); pv_one<1, NCB>(o[1], vb, pa0, pa1, pa2, pa3);
  if constexpr (NCB == 4) { pv_one<2, NCB>(o[2], vb, pa0, pa1, pa2, pa3); pv_one<3, NCB>(o[3], vb, pa0, pa1, pa2, pa3); }
}

template <int DK, int DV, bool SWA, bool TWO, int GS, bool MLAQ = false>
__device__ __forceinline__ void attn_unit(const bf16* __restrict__ Qrow, const bf16* __restrict__ Kh, const bf16* __restrict__ Vh, bf16* __restrict__ Ow, const int ldo,
                                          const int kstart, const int NT, const int qpos, const int seq, const int win,
                                          const float m_init, const float l_init, const float C, const float thr_raw, char* lds,
                                          const float* __restrict__ mq_gain = nullptr, const float* __restrict__ mq_tm = nullptr) {
  constexpr int NCB = DV / 32, SHM_V = KVBLK * DV * 2, SHM_K = KVBLK * DK * 2, KCH = DK / 8, VCH = DV / 8, NKC = DK / 64, NVC = DV / 64;
  int tid = threadIdx.x; asm volatile("" : "+v"(tid));
  const int wid = tid >> 6, lane = tid & 63, r32 = lane & 31, hi = lane >> 5;
  char* V_lds = lds; char* K_lds = lds + 2 * SHM_V;
  float* ws = (float*)(lds + 2 * SHM_V + 2 * SHM_K) + wid * 64; float* li_l = ws; float* al_l = ws + 32;
  float m_reg = m_init, l_reg = l_init; f32x16 o[NCB]; bf16x8 qr[DK / 16];
#pragma unroll
  for (int d = 0; d < NCB; ++d) o[d] = f32x16{};
#pragma unroll
  for (int d0 = 0; d0 < DK / 16; ++d0) qr[d0] = *reinterpret_cast<const bf16x8*>(Qrow + d0 * 16 + hi * 8);
  if constexpr (MLAQ) {
    static_assert(DK == 192, "MLA q prologue");
#define BFV(v_, e_) __uint_as_float(((unsigned)(unsigned short)(v_)[e_]) << 16)
#define PACK8(o_) __builtin_bit_cast(bf16x8, (u32x4){cvtpk(o_[0], o_[1]), cvtpk(o_[2], o_[3]), cvtpk(o_[4], o_[5]), cvtpk(o_[6], o_[7])})
    float ss = 0.f;
#pragma unroll
    for (int d0 = 0; d0 < 12; ++d0)
#pragma unroll
      for (int e = 0; e < 8; ++e) { const float x = BFV(qr[d0], e); ss += x * x; }
    ss += __shfl_xor(ss, 32);
    const float rstd = 1.0f / sqrtf(ss * (1.f / 192) + 1e-6f);
#pragma unroll
    for (int d0 = 0; d0 < 8; ++d0) { float y[8];
#pragma unroll
      for (int e = 0; e < 8; ++e) y[e] = BFV(qr[d0], e) * rstd * mq_gain[d0 * 16 + hi * 8 + e];
      qr[d0] = PACK8(y); }
#pragma unroll
    for (int dd = 0; dd < 2; ++dd) { float o1[8], o2[8];
#pragma unroll
      for (int e = 0; e < 8; ++e) { const int i = dd * 16 + hi * 8 + e; const float x1 = BFV(qr[8 + dd], e) * rstd * mq_gain[128 + i], x2 = BFV(qr[10 + dd], e) * rstd * mq_gain[160 + i];
        const float cc = mq_tm[2 * i], sn = mq_tm[2 * i + 1]; o1[e] = x1 * cc - x2 * sn; o2[e] = x2 * cc + x1 * sn; }
      qr[8 + dd] = PACK8(o1); qr[10 + dd] = PACK8(o2); }
#undef BFV
#undef PACK8
  }
  unsigned koff[NKC], voff[NVC]; int kdst[NKC], vdst[NVC], krow0 = 0;
#pragma unroll
  for (int i = 0; i < NKC; ++i) { const int c = tid + 512 * i, row = c / KCH, col = (c % KCH) * 8; koff[i] = (unsigned)(row * DK + col) * 2u; kdst[i] = kswz<DK>(row, col * 2); if (i == 0) krow0 = row; }
#pragma unroll
  for (int i = 0; i < NVC; ++i) { const int c = tid + 512 * i, row = c / VCH, col = (c % VCH) * 8; voff[i] = (unsigned)(row * DV + col) * 2u; vdst[i] = v_st<NCB>(row, col); }
  const int vb0 = (int)(uintptr_t)V_lds + v_rd_base(lane);
  int kb[4], kbx[4];
#pragma unroll
  for (int e = 0; e < 4; ++e) { kb[e] = kswz<DK>(r32, (e * 16 + hi * 8) * 2); kbx[e] = kb[e] ^ 128; }
  bf16x8 ks[NKC], vs[NVC], ks2[NKC], vs2[NVC];
#define SLOADX(ks, vs, k0) do { if constexpr (SWA) { static_assert(!SWA || (NKC == 1 && NVC == 1 && DK == DV), "SWA path: one chunk per thread"); \
      const int kr_ = min(max((k0) + krow0, 0), seq - 1) - krow0; const char* Kt = (const char*)Kh + (long)kr_ * (DK * 2); const char* Vt = (const char*)Vh + (long)kr_ * (DV * 2); \
      vs[0] = *reinterpret_cast<const bf16x8*>(Vt + voff[0]); ks[0] = *reinterpret_cast<const bf16x8*>(Kt + koff[0]); } \
    else { const char* Kt = (const char*)Kh + (long)(k0) * (DK * 2); const char* Vt = (const char*)Vh + (long)(k0) * (DV * 2); \
      _Pragma("unroll") for (int i = 0; i < NVC; ++i) vs[i] = *reinterpret_cast<const bf16x8*>(Vt + voff[i]); \
      _Pragma("unroll") for (int i = 0; i < NKC; ++i) ks[i] = *reinterpret_cast<const bf16x8*>(Kt + koff[i]); } } while (0)
#define SWRITEX(ks, vs, b) do { _Pragma("unroll") for (int i = 0; i < NVC; ++i) *(bf16x8*)(V_lds + (b) * SHM_V + vdst[i]) = vs[i]; \
    _Pragma("unroll") for (int i = 0; i < NKC; ++i) *(bf16x8*)(K_lds + (b) * SHM_K + kdst[i]) = ks[i]; } while (0)
#define SLOAD(k0) SLOADX(ks, vs, k0)
#define SWRITE(b) SWRITEX(ks, vs, b)
#define SWAIT() asm volatile("s_waitcnt vmcnt(0)" ::: "memory")
#define RESC(a) do { if (__any((a) < 1.f)) { if (hi == 0) al_l[r32] = (a); asm volatile("s_waitcnt lgkmcnt(0)" ::: "memory"); \
    _Pragma("unroll") for (int d = 0; d < NCB; ++d) _Pragma("unroll") for (int r = 0; r < 16; ++r) o[d][r] *= al_l[crow(r, hi)]; } } while (0)
#define MASK(P0, P1, k0) do { if constexpr (SWA) { const int kb = (k0) + 4 * hi; \
    _Pragma("unroll") for (int r = 0; r < 16; ++r) { const int kv = kb + (r & 3) + 8 * (r >> 2); const int dq = qpos - kv; \
      if (!(dq <= win && dq >= -win && kv >= 0 && kv < seq)) P0[r] = -INFINITY; \
      const int kv2 = kv + 32, dq2 = qpos - kv2; if (!(dq2 <= win && dq2 >= -win && kv2 >= 0 && kv2 < seq)) P1[r] = -INFINITY; } } } while (0)
  f32x16 pA0, pA1, pB0, pB1; float mnA, mnB, alA, alB; bf16x8 pa0, pa1, pa2, pa3;
  if constexpr (TWO) {
  SLOAD(kstart); SWAIT(); SWRITE(0); __syncthreads();
  qkt<DK, GS>(pA0, pA1, K_lds, kb, kbx, qr); MASK(pA0, pA1, kstart); partialSM(pA0, pA1, m_reg, mnA, alA, C, thr_raw);
  SLOAD(kstart + KVBLK);
  SWAIT(); SWRITE(1); __syncthreads();
  for (int j = 1; j + 1 < NT; j += 2) {
    SBAR(); qkt<DK, GS>(pB0, pB1, K_lds + SHM_K, kb, kbx, qr);
    finishSM(pA0, pA1, alA, l_reg, pa0, pa1, pa2, pa3); SBAR();
    SLOAD(kstart + (j + 1) * KVBLK); SBAR();
    pv_all<NCB>(o, vb0, pa0, pa1, pa2, pa3); MASK(pB0, pB1, kstart + j * KVBLK); partialSM(pB0, pB1, m_reg, mnB, alB, C, thr_raw);
    __syncthreads(); SWAIT(); SWRITE(0);
    RESC(alB); __syncthreads();
    SBAR(); qkt<DK, GS>(pA0, pA1, K_lds, kb, kbx, qr);
    finishSM(pB0, pB1, alB, l_reg, pa0, pa1, pa2, pa3); SBAR();
    SLOAD(kstart + (j + 2) * KVBLK); SBAR();
    pv_all<NCB>(o, vb0 + SHM_V, pa0, pa1, pa2, pa3); MASK(pA0, pA1, kstart + (j + 1) * KVBLK); partialSM(pA0, pA1, m_reg, mnA, alA, C, thr_raw);
    __syncthreads(); SWAIT(); SWRITE(1);
    RESC(alA); __syncthreads();
  }
  SBAR(); qkt<DK, GS>(pB0, pB1, K_lds + SHM_K, kb, kbx, qr);
  finishSM(pA0, pA1, alA, l_reg, pa0, pa1, pa2, pa3); SBAR();
  pv_all<NCB>(o, vb0, pa0, pa1, pa2, pa3); MASK(pB0, pB1, kstart + (NT - 1) * KVBLK); partialSM(pB0, pB1, m_reg, mnB, alB, C, thr_raw);
  RESC(alB);
  finishSM(pB0, pB1, alB, l_reg, pa0, pa1, pa2, pa3); SBAR();
  pv_all<NCB>(o, vb0 + SHM_V, pa0, pa1, pa2, pa3);
  } else {
#define TILE(bsel, jj) do { SBAR(); qkt<DK, GS>(pA0, pA1, K_lds + (bsel) * SHM_K, kb, kbx, qr); MASK(pA0, pA1, kstart + (jj) * KVBLK); partialSM(pA0, pA1, m_reg, mnA, alA, C, thr_raw); \
      RESC(alA); finishSM(pA0, pA1, alA, l_reg, pa0, pa1, pa2, pa3); SBAR(); pv_all<NCB>(o, vb0 + (bsel) * SHM_V, pa0, pa1, pa2, pa3); SBAR(); } while (0)
    SLOADX(ks, vs, kstart); SBAR(); SLOADX(ks2, vs2, kstart + KVBLK); SBAR();
    SWRITEX(ks, vs, 0); SBAR();
    SLOADX(ks, vs, kstart + 2 * KVBLK); SBAR();
    __syncthreads();
    for (int j = 0; j < NT; j += 2) {
      TILE(0, j);
      SWRITEX(ks2, vs2, 1); SBAR();
      if (j + 3 < NT) { SLOADX(ks2, vs2, kstart + (j + 3) * KVBLK); } SBAR();
      __syncthreads();
      TILE(1, j + 1);
      if (j + 2 < NT) { SWRITEX(ks, vs, 0); SBAR(); if (j + 4 < NT) { SLOADX(ks, vs, kstart + (j + 4) * KVBLK); } SBAR(); }
      __syncthreads();
    }
#undef TILE
  }
  if (hi == 0) li_l[r32] = l_reg; asm volatile("s_waitcnt lgkmcnt(0)" ::: "memory");
  float rli[16];
#pragma unroll
  for (int r = 0; r < 16; ++r) rli[r] = __builtin_amdgcn_rcpf(li_l[crow(r, hi)]);
  __syncthreads();
  { bf16* stg = (bf16*)lds + wid * (QBLK * DV);
#pragma unroll
    for (int r = 0; r < 16; ++r) { const int orow = crow(r, hi);
#pragma unroll
      for (int d0 = 0; d0 < NCB; ++d0) stg[orow * DV + d0 * 32 + r32] = (bf16)(cvtpk(o[d0][r] * rli[r], 0.f) & 0xffffu); }
    asm volatile("s_waitcnt lgkmcnt(0)" ::: "memory");
#pragma unroll
    for (int i = 0; i < (QBLK * VCH) / 64; ++i) { const int idx = i * 64 + lane, row = idx / VCH, ch = idx % VCH;
      const u32x4 v = *(const u32x4*)(stg + row * DV + ch * 8); *(u32x4*)(Ow + (long)row * ldo + ch * 8) = v; } }
  __syncthreads();
#undef SLOAD
#undef SLOADX
#undef SWRITEX
#undef SWRITE
#undef SWAIT
#undef RESC
#undef MASK
}
template <int NT, int NSUB>
__device__ __forceinline__ void swa_unit(const bf16* __restrict__ Qrow, const bf16* __restrict__ Kh, const bf16* __restrict__ Vh, bf16* __restrict__ Ow, const int ldo,
                                         const int kstart, const int qpos0, const int seq, const int win,
                                         const float m_init, const float C, const float thr_raw, char* lds) {
  constexpr int DK = 64, DV = 64, NCB = 2, SHM = KVBLK * 64 * 2, VCH = 8;
  int tid = threadIdx.x; asm volatile("" : "+v"(tid));
  const int wid = tid >> 6, lane = tid & 63, r32 = lane & 31, hi = lane >> 5;
  char* V_lds = lds; char* K_lds = lds + NT * SHM;
  float* ws = (float*)(lds + 2 * NT * SHM) + wid * 64; float* li_l = ws; float* al_l = ws + 32;
  bf16* stg = (bf16*)(lds + 2 * NT * SHM + NW * 256) + wid * (QBLK * DV);
  const int row = tid >> 3, col = (tid & 7) * 8;
  const int kdst = kswz<DK>(row, col * 2), vdst = v_st<NCB>(row, col);
  const int vb0 = (int)(uintptr_t)V_lds + v_rd_base(lane);
  int kb[4], kbx[4];
#pragma unroll
  for (int e = 0; e < 4; ++e) { kb[e] = kswz<DK>(r32, (e * 16 + hi * 8) * 2); kbx[e] = kb[e]; }
  { bf16x8 ksr[NT], vsr[NT];
#pragma unroll
    for (int t = 0; t < NT; ++t) { const int kr = min(max(kstart + t * KVBLK + row, 0), seq - 1);
      ksr[t] = *reinterpret_cast<const bf16x8*>(Kh + (long)kr * DK + col); vsr[t] = *reinterpret_cast<const bf16x8*>(Vh + (long)kr * DV + col); }
#pragma unroll
    for (int t = 0; t < NT; ++t) { *(bf16x8*)(K_lds + t * SHM + kdst) = ksr[t]; *(bf16x8*)(V_lds + t * SHM + vdst) = vsr[t]; } }
  __syncthreads();
#pragma unroll 1
  for (int sub = 0; sub < NSUB; ++sub) {
    const int qpos = qpos0 + sub * QBLK;
    float m_reg = m_init, l_reg = 1.f; f32x16 o[NCB]; bf16x8 qr[4];
    o[0] = f32x16{}; o[1] = f32x16{};
#pragma unroll
    for (int d0 = 0; d0 < 4; ++d0) qr[d0] = *reinterpret_cast<const bf16x8*>(Qrow + (long)sub * QBLK * DK + d0 * 16 + hi * 8);
    f32x16 p0, p1; float mn, al; bf16x8 pa0, pa1, pa2, pa3;
#pragma unroll
    for (int t = 0; t < NT; ++t) {
      const int k0 = kstart + t * KVBLK;
      SBAR(); qkt<DK, 2>(p0, p1, K_lds + t * SHM, kb, kbx, qr);
      { const int kbase = k0 + 4 * hi;
#pragma unroll
        for (int r = 0; r < 16; ++r) { const int kv = kbase + (r & 3) + 8 * (r >> 2); const int dq = qpos - kv;
          if (!(dq <= win && dq >= -win && kv >= 0 && kv < seq)) p0[r] = -INFINITY;
          const int kv2 = kv + 32, dq2 = qpos - kv2; if (!(dq2 <= win && dq2 >= -win && kv2 >= 0 && kv2 < seq)) p1[r] = -INFINITY; } }
      partialSM(p0, p1, m_reg, mn, al, C, thr_raw);
      if (__any(al < 1.f)) { if (hi == 0) al_l[r32] = al; asm volatile("s_waitcnt lgkmcnt(0)" ::: "memory");
#pragma unroll
        for (int d = 0; d < NCB; ++d)
#pragma unroll
          for (int r = 0; r < 16; ++r) o[d][r] *= al_l[crow(r, hi)]; }
      finishSM(p0, p1, al, l_reg, pa0, pa1, pa2, pa3); SBAR();
      pv_all<NCB>(o, vb0 + t * SHM, pa0, pa1, pa2, pa3);
    }
    if (hi == 0) li_l[r32] = l_reg; asm volatile("s_waitcnt lgkmcnt(0)" ::: "memory");
    float rli[16];
#pragma unroll
    for (int r = 0; r < 16; ++r) rli[r] = __builtin_amdgcn_rcpf(li_l[crow(r, hi)]);
#pragma unroll
    for (int r = 0; r < 16; ++r) { const int orow = crow(r, hi);
#pragma unroll
      for (int d0 = 0; d0 < NCB; ++d0) stg[orow * DV + d0 * 32 + r32] = (bf16)(cvtpk(o[d0][r] * rli[r], 0.f) & 0xffffu); }
    asm volatile("s_waitcnt lgkmcnt(0)" ::: "memory");
#pragma unroll
    for (int i = 0; i < (QBLK * VCH) / 64; ++i) { const int idx = i * 64 + lane, rw = idx / VCH, ch = idx % VCH;
      const u32x4 v = *(const u32x4*)(stg + rw * DV + ch * 8); *(u32x4*)(Ow + (long)(sub * QBLK + rw) * ldo + ch * 8) = v; }
    asm volatile("s_waitcnt lgkmcnt(0)" ::: "memory");
  }
  __syncthreads();
}
#undef SBAR
}

#define LAS __attribute__((address_space(3)))
typedef unsigned short bf16;
typedef unsigned v4u __attribute__((ext_vector_type(4)));
typedef unsigned v2u __attribute__((ext_vector_type(2)));
typedef float f32x4 __attribute__((ext_vector_type(4)));
typedef float f32x2 __attribute__((ext_vector_type(2)));
constexpr int NWAVES = 8;
constexpr int BATCH = 2, SEQ = 8192, T = BATCH * SEQ, DM = 2048, DFF = 8192;
constexpr int EVEN_IN = 2368, EVEN_IN_P = 2560, ODD_IN = 2560;
constexpr float EPS = 1e-6f;
constexpr size_t MiB = 1u << 20;
constexpr size_t WS_WIN = 1 * MiB, WS_WUQ = 11 * MiB, WS_WUKV = 13 * MiB, WS_WOE = 14 * MiB, WS_WUP = 22 * MiB, WS_WDN = 54 * MiB;
constexpr size_t WS_WQKV = 487 * MiB, WS_WOO = 497 * MiB;
constexpr size_t WS_TMLA = 86 * MiB, WS_TAX = 88 * MiB, WS_TSWA = 92 * MiB;
constexpr size_t WS_XN = 93 * MiB;
constexpr size_t WS_CNT = 48 * 1024;
constexpr size_t WS_ROWSS = 64 * 1024;
constexpr size_t AB = 157 * MiB;
constexpr size_t WS_MRG = AB;
constexpr size_t WS_U = AB;
constexpr size_t WS_PROJ = AB, WS_KVR = AB, WS_QAR = AB + 80 * MiB, WS_CQN = AB + 128 * MiB, WS_CKVN = AB + 144 * MiB, WS_KR = AB + 152 * MiB, WS_QG = AB + 154 * MiB,
                 WS_KG = AB + 186 * MiB, WS_VG = AB + 194 * MiB, WS_QA = AB + 202 * MiB, WS_KA = AB + 250 * MiB, WS_VA = AB + 298 * MiB;
constexpr size_t WS_SQ = AB + 80 * MiB, WS_SK = AB + 144 * MiB, WS_SV = AB + 152 * MiB;
constexpr size_t WS_END = AB + 330 * MiB;
static_assert(WS_END <= WS_WQKV && WS_WOO + 8 * MiB <= 512 * MiB && WS_U + 256 * MiB <= WS_WQKV, "workspace map");
constexpr size_t WS_NEED = 505 * MiB;
#ifdef PROBE_NOLDS
constexpr int LDS_BYTES = 0;
#else
constexpr int EST_OFF = 131072 + 1024, LDS_BYTES = EST_OFF + 32 * 528 + 512;
#endif

__device__ __forceinline__ unsigned cvtpk2(float lo, float hi) { unsigned r; asm volatile("v_cvt_pk_bf16_f32 %0, %1, %2" : "=v"(r) : "v"(lo), "v"(hi)); return r; }
__device__ __forceinline__ float bflo(unsigned w) { return __uint_as_float(w << 16); }
__device__ __forceinline__ float bfhi(unsigned w) { return __uint_as_float(w & 0xffff0000u); }
__device__ __forceinline__ void ld8(const bf16* p, float (&v)[8]) { const v4u w = *(const v4u*)p; v[0] = bflo(w.x); v[1] = bfhi(w.x); v[2] = bflo(w.y); v[3] = bfhi(w.y); v[4] = bflo(w.z); v[5] = bfhi(w.z); v[6] = bflo(w.w); v[7] = bfhi(w.w); }
__device__ __forceinline__ void st8(bf16* p, const float (&v)[8]) { v4u w; w.x = cvtpk2(v[0], v[1]); w.y = cvtpk2(v[2], v[3]); w.z = cvtpk2(v[4], v[5]); w.w = cvtpk2(v[6], v[7]); *(v4u*)p = w; }
__device__ __forceinline__ void ld4(const bf16* p, float (&v)[4]) { const v2u w = *(const v2u*)p; v[0] = bflo(w.x); v[1] = bfhi(w.x); v[2] = bflo(w.y); v[3] = bfhi(w.y); }
__device__ __forceinline__ void st4(bf16* p, const float (&v)[4]) { v2u w; w.x = cvtpk2(v[0], v[1]); w.y = cvtpk2(v[2], v[3]); *(v2u*)p = w; }
template <int W> __device__ __forceinline__ float grp_sum(float v) {
#pragma unroll
  for (int o = 1; o < W; o <<= 1) v += __shfl_xor(v, o);
  return v;
}
__device__ __forceinline__ float sumsq8(const float (&v)[8]) { float s = 0.f;
#pragma unroll
  for (int j = 0; j < 8; ++j) s += v[j] * v[j];
  return s; }

#define XB_TMO      128
#define XB_XCNT(j)  (256  + 64 * (j))
#define XB_XSUB(j)  (1280 + 64 * (j))
#define XB_XGEN(j)  (2304 + 64 * (j))
#define XB_TOP      3328
#define XB_TOPGEN   3392
#define XCD_BAR_WORDS 3456
#define XB_SPIN_CAP (1u << 18)

__device__ __forceinline__ unsigned xb_ld(unsigned* p)              { return __hip_atomic_load(p, __ATOMIC_RELAXED, __HIP_MEMORY_SCOPE_AGENT); }
__device__ __forceinline__ unsigned xb_add(unsigned* p, unsigned v) { return __hip_atomic_fetch_add(p, v, __ATOMIC_RELAXED, __HIP_MEMORY_SCOPE_AGENT); }
__device__ __forceinline__ unsigned xb_xcc_id() { return (unsigned)__builtin_amdgcn_s_getreg((3 << 11) | 20) & 0xFu; }
#define XB_SPIN(cond, bar) do { unsigned _sp = 0; while (cond) { __builtin_amdgcn_s_sleep(1); \
    if ((++_sp & 255u) == 0u) { if (xb_ld(&(bar)[XB_TMO])) break; if (_sp > XB_SPIN_CAP) { atomicAdd(&(bar)[XB_TMO], 1u); break; } } } } while (0)

struct XcdBarrier {
    unsigned* bar; unsigned x;
    volatile LAS unsigned* st;
};

__device__ __forceinline__ XcdBarrier xcd_barrier_post(unsigned* bar, volatile LAS unsigned* st) {
    XcdBarrier b; b.bar = bar; b.x = xb_xcc_id(); b.st = st;
    if (threadIdx.x == 0) (void)xb_add(&bar[XB_XCNT(b.x)], 1u);
    return b;
}
__device__ __forceinline__ void xcd_barrier_complete(unsigned* bar, unsigned x, unsigned& nloc, unsigned& nx) {
    const unsigned G = gridDim.x * gridDim.y * gridDim.z;
    unsigned sum, cnt, mine, sp = 0u;
    for (;;) {
        sum = 0u; cnt = 0u; mine = 0u;
#pragma unroll
        for (unsigned j = 0; j < 16; ++j) { const unsigned c = xb_ld(&bar[XB_XCNT(j)]); sum += c; cnt += (c > 0u) ? 1u : 0u; mine = (j == x) ? c : mine; }
        if (sum == G) break;
        __builtin_amdgcn_s_sleep(1);
        if ((++sp & 255u) == 0u) { if (xb_ld(&bar[XB_TMO])) break; if (sp > XB_SPIN_CAP) { atomicAdd(&bar[XB_TMO], 1u); break; } }
    }
    nloc = mine > 0u ? mine : 1u; nx = cnt > 0u ? cnt : 1u;
}

__device__ __forceinline__ void xcd_barrier(const XcdBarrier& b) {
    asm volatile("s_waitcnt vmcnt(0)" ::: "memory");
    __syncthreads();
    if (threadIdx.x == 0) {
        unsigned* bar = b.bar;
        __builtin_amdgcn_s_waitcnt(0);
        unsigned nloc = b.st[0], nx = b.st[1];
        if (nloc == 0u) { xcd_barrier_complete(bar, b.x, nloc, nx); b.st[0] = nloc; b.st[1] = nx; }
        const unsigned old = xb_add(&bar[XB_XSUB(b.x)], 1u);
        const unsigned gen = old / nloc;
        if (old + 1u == (gen + 1u) * nloc) {
            __builtin_amdgcn_fence(__ATOMIC_RELEASE, "agent");
            asm volatile("s_waitcnt vmcnt(0)" ::: "memory");
            const unsigned og = xb_add(&bar[XB_TOP], 1u);
            const unsigned tg = og / nx;
            if (og + 1u == (tg + 1u) * nx) xb_add(&bar[XB_TOPGEN], 1u);
            else XB_SPIN(xb_ld(&bar[XB_TOPGEN]) == tg, bar);
            __builtin_amdgcn_fence(__ATOMIC_ACQUIRE, "agent");
            xb_add(&bar[XB_XGEN(b.x)], 1u);
            asm volatile("s_waitcnt vmcnt(0)" ::: "memory");
        } else {
            XB_SPIN(xb_ld(&bar[XB_XGEN(b.x)]) == gen, bar);
            __builtin_amdgcn_fence(__ATOMIC_ACQUIRE, "agent");
            asm volatile("s_waitcnt vmcnt(0)" ::: "memory");
        }
    }
    __syncthreads();
}

struct Args {
  const float* in[22]; float* out; unsigned char* ws;
  float inv_mla[32], inv_ax[32], inv_swa[8];
};

struct Ctx { int lane, wave, gw, NGW, G, vcu; unsigned char* ws; };

__device__ __forceinline__ void transpose_stream(const float* __restrict__ W, const int K, const int N, bf16* __restrict__ WT, LAS float* scr, const int first, const int items, const int stride, const int lane, const float* __restrict__ gain, const bool permq = false) {
  const int nblk = N / 32, half = lane >> 5, l31 = lane & 31;
  float cur[32], nxt[32];
  if (first >= items) return;
#define TS_LOAD(dst, item_) do { const int kb_ = (item_) / nblk, nb_ = (item_) % nblk; const float* p_ = W + (size_t)(64 * kb_ + half) * N + 32 * nb_ + l31; \
    _Pragma("unroll") for (int i = 0; i < 32; ++i) dst[i] = p_[(size_t)(2 * i) * N]; } while (0)
  TS_LOAD(cur, first);
  for (int it = first; it < items; it += stride) {
    const bool more = it + stride < items;
    if (more) TS_LOAD(nxt, it + stride);
    const int kb = it / nblk, nb = it % nblk, k0 = 64 * kb, n0 = 32 * nb;
    const int n0p = permq ? ((n0 & ~255) | (((n0 >> 5) & 1) << 7) | (((n0 >> 6) & 3) << 5)) : n0;
    if (gain) {
#pragma unroll
      for (int i = 0; i < 32; ++i) cur[i] *= gain[k0 + 2 * i + half]; }
#pragma unroll
    for (int i = 0; i < 32; ++i) scr[(2 * i + half) * 33 + l31] = cur[i];
    asm volatile("s_waitcnt lgkmcnt(0)" ::: "memory");
    const int c = lane & 7;
#pragma unroll
    for (int j = 0; j < 4; ++j) { const int n = (lane >> 3) + 8 * j; const LAS float* s = scr + (8 * c) * 33 + n;
      v4u o; o.x = cvtpk2(s[0 * 33], s[1 * 33]); o.y = cvtpk2(s[2 * 33], s[3 * 33]); o.z = cvtpk2(s[4 * 33], s[5 * 33]); o.w = cvtpk2(s[6 * 33], s[7 * 33]);
      *(v4u*)(WT + (size_t)(n0p + n) * K + k0 + 8 * c) = o; }
    asm volatile("s_waitcnt lgkmcnt(0)" ::: "memory");
    if (more) {
#pragma unroll
      for (int i = 0; i < 32; ++i) cur[i] = nxt[i]; }
  }
#undef TS_LOAD
}
template <int SET> __device__ __forceinline__ void convert_dynamic(unsigned* counter, const int wave, const int lane, const Args& a, unsigned char* ws, LAS unsigned char* lds) {
  LAS float* scr = (LAS float*)(lds + wave * 16384);
  constexpr int CH = 8, C_OE = (DM / 64) * (DM / 32) / CH, C_UP = (DM / 64) * (DFF / 32) / CH, C_DN = (DFF / 64) * (DM / 32) / CH, C_QKV = (DM / 64) * (ODD_IN / 32) / CH;
#define CD_TS(W_, K_, N_, off_, gain_, perm_, ch_) transpose_stream((W_), (K_), (N_), (bf16*)(ws + (off_)), scr, (ch_) * CH, (ch_) * CH + CH, 1, lane, (gain_), (perm_))
  for (;;) {
    int chv = 0; if (lane == 0) chv = (int)__hip_atomic_fetch_add(counter, 1u, __ATOMIC_RELAXED, __HIP_MEMORY_SCOPE_AGENT);
    const int ch = __builtin_amdgcn_readfirstlane(chv);
    if constexpr (SET == 1) {
      if (ch < C_UP) CD_TS(a.in[20], DM, DFF, WS_WUP, a.in[19], false, ch);
      else if (ch < C_UP + C_DN) CD_TS(a.in[21], DFF, DM, WS_WDN, nullptr, false, ch - C_UP);
      else if (ch < C_UP + C_DN + C_OE) CD_TS(a.in[12], DM, DM, WS_WOE, nullptr, false, ch - C_UP - C_DN);
      else if (ch < C_UP + C_DN + C_OE + C_QKV) CD_TS(a.in[14], DM, ODD_IN, WS_WQKV, a.in[13], true, ch - C_UP - C_DN - C_OE);
      else if (ch < C_UP + C_DN + 2 * C_OE + C_QKV) CD_TS(a.in[18], DM, DM, WS_WOO, nullptr, false, ch - C_UP - C_DN - C_OE - C_QKV);
      else break;
    } else {
      if (ch < C_UP) CD_TS(a.in[20] + (size_t)DM * DFF, DM, DFF, WS_WUP, a.in[19] + DM, false, ch);
      else if (ch < C_UP + C_DN) CD_TS(a.in[21] + (size_t)DM * DFF, DFF, DM, WS_WDN, nullptr, false, ch - C_UP);
      else break;
    }
  }
#undef CD_TS
}
__device__ __forceinline__ void rms_row(const float* xrow, const float* gain, bf16* orow, int lane) {
  f32x4 v[8]; float s = 0.f;
#pragma unroll
  for (int j = 0; j < 4; ++j) { const f32x4* p = (const f32x4*)xrow + 2 * (64 * j + lane); v[2 * j] = p[0]; v[2 * j + 1] = p[1]; }
#pragma unroll
  for (int j = 0; j < 8; ++j) s += (v[j].x * v[j].x + v[j].y * v[j].y) + (v[j].z * v[j].z + v[j].w * v[j].w);
  const float rstd = 1.0f / sqrtf(grp_sum<64>(s) * (1.f / DM) + EPS);
#pragma unroll
  for (int j = 0; j < 4; ++j) { const f32x4* gp = (const f32x4*)gain + 2 * (64 * j + lane); const f32x4 g0 = gp[0], g1 = gp[1], a0 = v[2 * j], a1 = v[2 * j + 1];
    v4u w; w.x = cvtpk2(a0.x * rstd * g0.x, a0.y * rstd * g0.y); w.y = cvtpk2(a0.z * rstd * g0.z, a0.w * rstd * g0.w); w.z = cvtpk2(a1.x * rstd * g1.x, a1.y * rstd * g1.y); w.w = cvtpk2(a1.z * rstd * g1.z, a1.w * rstd * g1.w);
    *((v4u*)orow + 64 * j + lane) = w; }
}
__device__ __forceinline__ void norm_phase(const Ctx& c, const float* x, const float* gain, bf16* xn) {
  for (int m = c.gw; m < T; m += c.NGW) rms_row(x + (size_t)m * DM, gain, xn + (size_t)m * DM, c.lane);
}
__device__ __forceinline__ f32x2 sincos_rev(float ang) {
  double fr = (double)ang * 0.15915494309189533577; fr -= rint(fr); const float f = (float)fr;
  return (f32x2){__builtin_amdgcn_cosf(f), __builtin_amdgcn_sinf(f)};
}

__device__ __forceinline__ void prologue(const Ctx& c, const Args& a, LAS unsigned char* lds) {
  LAS float* scr = (LAS float*)(lds + c.wave * 16384);
  unsigned char* ws = c.ws;
  int base = 0;
#define DO_W(inidx, K_, N_, off, srcoff, gain_) do { const int items = ((K_) / 64) * ((N_) / 32); const float* W = a.in[inidx] + (srcoff); bf16* WT = (bf16*)(ws + (off)); \
    const int first = (c.gw - (base % c.NGW) + c.NGW) % c.NGW; \
    transpose_stream(W, (K_), (N_), WT, scr, first, items, c.NGW, c.lane, (gain_)); \
    base += items; } while (0)
  DO_W(2, DM, EVEN_IN, WS_WIN, 0, nullptr); DO_W(5, 512, 1536, WS_WUQ, 0, nullptr); DO_W(6, 256, 2048, WS_WUKV, 0, nullptr);
#undef DO_W
  { v4u* z = (v4u*)((bf16*)(ws + WS_WIN) + (size_t)EVEN_IN * DM); const int n16 = (EVEN_IN_P - EVEN_IN) * DM / 8;
    for (int i = c.gw * 64 + c.lane; i < n16; i += c.NGW * 64) z[i] = (v4u){0u, 0u, 0u, 0u}; }
  { f32x2* tm = (f32x2*)(ws + WS_TMLA); f32x2* ta = (f32x2*)(ws + WS_TAX); f32x2* tsw = (f32x2*)(ws + WS_TSWA);
    const int gt = c.gw * 64 + c.lane, NT_ = c.NGW * 64;
    for (int i = gt; i < SEQ * 32; i += NT_) { const int s = i >> 5, f = i & 31; tm[i] = sincos_rev((float)s * a.inv_mla[f]); }
    for (int i = gt; i < SEQ * 64; i += NT_) { const int s = i >> 6, f = i & 63; const int pos = (f < 32) ? (s >> 6) : (s & 63); ta[i] = sincos_rev((float)pos * a.inv_ax[f & 31]); }
    for (int i = gt; i < SEQ * 8; i += NT_) { const int s = i >> 3, f = i & 7; tsw[i] = sincos_rev((float)s * a.inv_swa[f]); } }
  norm_phase(c, a.in[0], a.in[1], (bf16*)(ws + WS_XN));
}

__device__ __forceinline__ void convert_layer1(const Ctx& c, const Args& a, LAS unsigned char* lds) {
  LAS float* scr = (LAS float*)(lds + c.wave * 16384);
  unsigned char* ws = c.ws;
  int base = 0;
#define DO_W(inidx, K_, N_, off, srcoff, gain_) do { const int items = ((K_) / 64) * ((N_) / 32); const float* W = a.in[inidx] + (srcoff); bf16* WT = (bf16*)(ws + (off)); \
    const int first = (c.gw - (base % c.NGW) + c.NGW) % c.NGW; \
    transpose_stream(W, (K_), (N_), WT, scr, first, items, c.NGW, c.lane, (gain_)); \
    base += items; } while (0)
  DO_W(20, DM, DFF, WS_WUP, (size_t)DM * DFF, a.in[19] + DM); DO_W(21, DFF, DM, WS_WDN, (size_t)DM * DFF, nullptr);
#undef DO_W
}
__device__ __forceinline__ void post_proj(const Ctx& c, const Args& a) {
  unsigned char* ws = c.ws; const int l = c.lane;
  const bf16* PROJ = (const bf16*)(ws + WS_PROJ);
  bf16* CQN = (bf16*)(ws + WS_CQN); bf16* CKVN = (bf16*)(ws + WS_CKVN); bf16* KR = (bf16*)(ws + WS_KR);
  bf16* QG = (bf16*)(ws + WS_QG); bf16* KG = (bf16*)(ws + WS_KG); bf16* VG = (bf16*)(ws + WS_VG);
  const f32x2* tm = (const f32x2*)(ws + WS_TMLA); const f32x2* ta = (const f32x2*)(ws + WS_TAX);
  const float* g_qlat = a.in[3]; const float* g_kvlat = a.in[4]; const float* g_krope = a.in[9]; const float* g_gq = a.in[10]; const float* g_gk = a.in[11];
  for (int t = c.gw; t < T; t += c.NGW) {
    const int b = t / SEQ, s = t % SEQ; const bf16* pr = PROJ + (size_t)t * EVEN_IN_P;
    float v[8], o[8];
    { ld8(pr + 8 * l, v); const float rstd = 1.0f / sqrtf(grp_sum<64>(sumsq8(v)) * (1.f / 512) + EPS);
#pragma unroll
      for (int j = 0; j < 8; ++j) o[j] = v[j] * rstd * g_qlat[8 * l + j];
      st8(CQN + (size_t)t * 512 + 8 * l, o); }
    { const bool act = l < 40; if (act) ld8(pr + 512 + 8 * l, v); else {
#pragma unroll
        for (int j = 0; j < 8; ++j) v[j] = 0.f; }
      float ss = grp_sum<8>(sumsq8(v)); const float ss8 = ss; ss += __shfl_xor(ss, 8); ss += __shfl_xor(ss, 16);
      if (l < 32) { const float rstd = 1.0f / sqrtf(ss * (1.f / 256) + EPS);
#pragma unroll
        for (int j = 0; j < 8; ++j) o[j] = v[j] * rstd * g_kvlat[8 * l + j];
        st8(CKVN + (size_t)t * 256 + 8 * l, o); }
      const int lr = l & 7; const float rstd8 = 1.0f / sqrtf(ss8 * (1.f / 64) + EPS); float nv[8], pv_[8];
#pragma unroll
      for (int j = 0; j < 8; ++j) nv[j] = v[j] * rstd8 * g_krope[(8 * lr + j) & 63];
#pragma unroll
      for (int j = 0; j < 8; ++j) pv_[j] = __shfl_xor(nv[j], 4);
      if (l >= 32 && l < 40) {
#pragma unroll
        for (int j = 0; j < 8; ++j) { const f32x2 cs = tm[s * 32 + 8 * (lr & 3) + j]; o[j] = (lr & 4) ? (nv[j] * cs.x + pv_[j] * cs.y) : (nv[j] * cs.x - pv_[j] * cs.y); }
        bf16* KAr = (bf16*)(ws + WS_KA) + ((size_t)(b * 8) * SEQ + s) * 192 + 128 + 8 * lr;
#pragma unroll
        for (int hh = 0; hh < 8; ++hh) st8(KAr + (size_t)hh * SEQ * 192, o); } }
#pragma unroll
    for (int pass = 0; pass < 3; ++pass) {
      const int hl = l >> 4, ll = l & 15;
      ld8(pr + 832 + pass * 512 + 8 * l, v);
      const float rstd = 1.0f / sqrtf(grp_sum<16>(sumsq8(v)) * (1.f / 128) + EPS);
      const float* g = (pass < 2) ? g_gq : g_gk; float nv[8], pv_[8];
#pragma unroll
      for (int j = 0; j < 8; ++j) nv[j] = v[j] * rstd * g[8 * ll + j];
#pragma unroll
      for (int j = 0; j < 8; ++j) pv_[j] = __shfl_xor(nv[j], 4);
#pragma unroll
      for (int j = 0; j < 8; ++j) { const f32x2 cs = ta[s * 64 + ((ll & 8) ? 32 : 0) + 8 * (ll & 3) + j]; o[j] = (ll & 4) ? (nv[j] * cs.x + pv_[j] * cs.y) : (nv[j] * cs.x - pv_[j] * cs.y); }
      if (pass < 2) st8(QG + ((size_t)(b * 8 + pass * 4 + hl) * SEQ + s) * 128 + 8 * ll, o);
      else if (hl < 2) st8(KG + ((size_t)(b * 2 + hl) * SEQ + s) * 128 + 8 * ll, o);
      else st8(VG + ((size_t)(b * 2 + (hl - 2)) * SEQ + s) * 128 + 8 * ll, v);
    }
  }
}
__device__ __forceinline__ void post_mla(const Ctx& c, const Args& a) {
  unsigned char* ws = c.ws; const int l = c.lane, hl = l >> 4, ll = l & 15;
  const bf16* QAR = (const bf16*)(ws + WS_QAR); const bf16* KVR = (const bf16*)(ws + WS_KVR); const bf16* KR = (const bf16*)(ws + WS_KR);
  bf16* QA = (bf16*)(ws + WS_QA); bf16* KA = (bf16*)(ws + WS_KA); bf16* VA = (bf16*)(ws + WS_VA);
  const f32x2* tm = (const f32x2*)(ws + WS_TMLA);
  const float* g_q = a.in[7]; const float* g_kn = a.in[8];
  for (int t = c.gw; t < T; t += c.NGW) {
    const int b = t / SEQ, s = t % SEQ;
#pragma unroll
    for (int pass = 0; pass < 2; ++pass) {
      const int h = pass * 4 + hl;
      {
        const bf16* q = QAR + (size_t)t * 1536 + h * 192; float v[8], r[4], o[8], ro[4];
        ld8(q + 8 * ll, v); ld4(q + 128 + 4 * ll, r);
        float ss = sumsq8(v) + (r[0] * r[0] + r[1] * r[1]) + (r[2] * r[2] + r[3] * r[3]);
        const float rstd = 1.0f / sqrtf(grp_sum<16>(ss) * (1.f / 192) + EPS);
#pragma unroll
        for (int j = 0; j < 8; ++j) o[j] = v[j] * rstd * g_q[8 * ll + j];
        float nr[4], pr_[4];
#pragma unroll
        for (int j = 0; j < 4; ++j) nr[j] = r[j] * rstd * g_q[128 + 4 * ll + j];
#pragma unroll
        for (int j = 0; j < 4; ++j) pr_[j] = __shfl_xor(nr[j], 8);
#pragma unroll
        for (int j = 0; j < 4; ++j) { const f32x2 cs = tm[s * 32 + 4 * (ll & 7) + j]; ro[j] = (ll & 8) ? (nr[j] * cs.x + pr_[j] * cs.y) : (nr[j] * cs.x - pr_[j] * cs.y); }
        bf16* qo = QA + ((size_t)(b * 8 + h) * SEQ + s) * 192; st8(qo + 8 * ll, o); st4(qo + 128 + 4 * ll, ro); }
      {
        const bf16* kv = KVR + (size_t)t * 2048 + h * 256; float v[8], o[8];
        ld8(kv + 8 * ll, v);
        const float rstd = 1.0f / sqrtf(grp_sum<16>(sumsq8(v)) * (1.f / 128) + EPS);
#pragma unroll
        for (int j = 0; j < 8; ++j) o[j] = v[j] * rstd * g_kn[8 * ll + j];
        bf16* ko = KA + ((size_t)(b * 8 + h) * SEQ + s) * 192; st8(ko + 8 * ll, o);
        *(v2u*)(ko + 128 + 4 * ll) = *(const v2u*)(KR + (size_t)t * 64 + 4 * ll);
        *(v4u*)(VA + ((size_t)(b * 8 + h) * SEQ + s) * 128 + 8 * ll) = *(const v4u*)(kv + 128 + 8 * ll); }
    }
  }
}
__device__ __forceinline__ void post_qkv(const Ctx& c, const Args& a) {
  unsigned char* ws = c.ws; const int l = c.lane, hl = l >> 3, ll = l & 7;
  const bf16* QKV = (const bf16*)(ws + WS_PROJ);
  bf16* SQ = (bf16*)(ws + WS_SQ); bf16* SK = (bf16*)(ws + WS_SK); bf16* SV = (bf16*)(ws + WS_SV);
  const f32x2* tsw = (const f32x2*)(ws + WS_TSWA);
  const float* g_q = a.in[15]; const float* g_k = a.in[16];
  for (int t = c.gw; t < T; t += c.NGW) {
    const int b = t / SEQ, s = t % SEQ; const bf16* pr = QKV + (size_t)t * ODD_IN;
#pragma unroll
    for (int pass = 0; pass < 5; ++pass) {
      float v[8], o[8], nv[8], pv_[8];
      ld8(pr + pass * 512 + 8 * l, v);
      const float rstd = 1.0f / sqrtf(grp_sum<8>(sumsq8(v)) * (1.f / 64) + EPS);
      const float* g = (pass < 4) ? g_q : g_k;
#pragma unroll
      for (int j = 0; j < 8; ++j) nv[j] = v[j] * rstd * g[8 * ll + j];
#pragma unroll
      for (int j = 0; j < 8; ++j) pv_[j] = __shfl_xor(nv[j], 1);
#pragma unroll
      for (int j = 0; j < 8; ++j) { const f32x2 cs = tsw[s * 8 + j]; o[j] = (ll >= 2) ? nv[j] : ((ll & 1) ? (nv[j] * cs.x + pv_[j] * cs.y) : (nv[j] * cs.x - pv_[j] * cs.y)); }
      if (pass < 4) st8(SQ + ((size_t)(b * 32 + pass * 8 + hl) * SEQ + s) * 64 + 8 * ll, o);
      else if (hl < 4) st8(SK + ((size_t)(b * 4 + hl) * SEQ + s) * 64 + 8 * ll, o);
      else st8(SV + ((size_t)(b * 4 + (hl - 4)) * SEQ + s) * 64 + 8 * ll, v);
    }
  }
}

#ifdef NO_GEMM
#define GEMM_PHASE(EPI_T, epi, Aoff, Boff, N_, K_) do { (void)(epi); } while (0)
#else
#define GEMM_PHASE(EPI_T, epi, Aoff, Boff, N_, K_) do { \
    pg8::Gemm g_{(const pg8::bf16_t*)(ws + (Aoff)), (const pg8::bf16_t*)(ws + (Boff)), T, (N_), (K_)}; pg8::StaticOrder S_; S_.init(T, (N_), c.G, (int)blockIdx.x); \
    pg8::gemm_phase<EPI_T, pg8::StaticOrder, true, true>(ldsl, g_, S_, (epi)); } while (0)
#endif

#ifndef STAG_TICKS
#define STAG_TICKS 0
#endif
#define STAGGER() do { if (STAG_TICKS > 0) { const unsigned long long t0_ = __builtin_amdgcn_s_memrealtime(); const unsigned long long d_ = (unsigned long long)((blockIdx.x >> 3) & 3) * STAG_TICKS; \
    while (__builtin_amdgcn_s_memrealtime() - t0_ < d_) __builtin_amdgcn_s_sleep(8); } } while (0)
#ifndef REP_THIN2
#define REP_THIN2 1
#endif
#ifndef REP_THIN3
#define REP_THIN3 1
#endif
#ifndef REP_SWA
#define REP_SWA 1
#endif
#ifndef REP_PRO
#define REP_PRO 1
#endif
#ifndef REP_THIN
#define REP_THIN 1
#endif
#ifndef REP_MLA
#define REP_MLA 1
#endif
#ifndef REP_GQA
#define REP_GQA 1
#endif
#ifndef REP_UP
#define REP_UP 1
#endif
__global__ void __launch_bounds__(NWAVES * 64, 2) fwd_megakernel(Args a) {
  extern __shared__ __attribute__((aligned(16))) unsigned char lds[];
#ifdef NO_SYNC
  struct { __device__ void sync() const { __syncthreads(); } } grid;
#else
  cg::grid_group grid = cg::this_grid();
#endif
  LAS unsigned char* ldsl = (LAS unsigned char*)lds;
#define MKCTX() do { int t_ = threadIdx.x; asm volatile("" : "+v"(t_)); c.lane = t_ & 63; c.wave = __builtin_amdgcn_readfirstlane(t_ >> 6); c.G = gridDim.x; \
    { const int bx = blockIdx.x; c.vcu = (c.G % 8 == 0) ? (bx % 8) * (c.G / 8) + bx / 8 : bx; } \
    c.gw = blockIdx.x * NWAVES + c.wave; c.NGW = c.G * NWAVES; c.ws = a.ws; } while (0)
  Ctx c; MKCTX();
  volatile LAS unsigned* bst = (volatile LAS unsigned*)(ldsl + 131072 + 512);
  if (threadIdx.x < 2) bst[threadIdx.x] = 0u;
  __syncthreads();
  XcdBarrier xbar = xcd_barrier_post((unsigned*)a.ws, bst);
#ifdef USE_CG_ALL
#define SEAM() do { grid.sync(); MKCTX(); } while (0)
#else
#define SEAM() do { xcd_barrier(xbar); MKCTX(); } while (0)
#endif
  unsigned char* ws = a.ws;
  float* X = a.out; float* RSS = (float*)(a.ws + WS_ROWSS);

#ifndef NO_PRO
  prologue(c, a, ldsl);

#endif
  grid.sync(); MKCTX();
  { pg8::EpiB<0> E{(pg8::bf16_t*)(ws + WS_PROJ), EVEN_IN_P, nullptr, 0.f, 0.f}; GEMM_PHASE(pg8::EpiB<0>, E, WS_XN, WS_WIN, EVEN_IN_P, DM); }
#ifndef NO_PRO
  MKCTX(); convert_dynamic<1>((unsigned*)(ws + WS_CNT), c.wave, c.lane, a, ws, ldsl);
#endif
  SEAM();
#ifndef NO_POST
  for (int rep = 0; rep < REP_THIN; ++rep) { MKCTX(); post_proj(c, a); }
#endif
  SEAM();
  { pg8::EpiB<0> E{(pg8::bf16_t*)(ws + WS_QAR), 1536, nullptr, 0.f, 0.f}; GEMM_PHASE(pg8::EpiB<0>, E, WS_CQN, WS_WUQ, 1536, 512); }
  { typedef pg8::EpiKV<WS_KA, WS_VA, WS_KR, EST_OFF, 13> EKV; EKV E{ws, a.in[8], ldsl, EPS};
    pg8::Gemm g_{(const pg8::bf16_t*)(ws + WS_CKVN), (const pg8::bf16_t*)(ws + WS_WUKV), T, 2048, 256}; pg8::StaticOrder S_; S_.init(T, 2048, c.G, (int)blockIdx.x);
    pg8::gemm_phase<EKV, pg8::StaticOrder, true, false>(ldsl, g_, S_, E); }
  SEAM();
  {
    constexpr float L2E = 1.4426950408889634f;
    const int nper = (512 + c.G - 1) / c.G;
    for (int rep = 0; rep < REP_MLA; ++rep)
    for (int i = 0; i < nper; ++i) {
      const int u = c.vcu * nper + i; if (u >= 512) break;
      int tid = threadIdx.x; asm volatile("" : "+v"(tid)); const int wid = tid >> 6, lane = tid & 63, r32 = lane & 31;
      const int bh = u >> 5, qb = u & 31, b = bh >> 3, h = bh & 7;
      const float sc = 0.07216878364870322f;
      const int qs = qb * 256 + wid * 32 + r32;
      const att::bf16* Q = (const att::bf16*)(ws + WS_QAR) + ((size_t)b * SEQ + qs) * 1536 + h * 192;
      const att::bf16* K = (const att::bf16*)(ws + WS_KA) + (size_t)bh * SEQ * 192;
      const att::bf16* V = (const att::bf16*)(ws + WS_VA) + (size_t)bh * SEQ * 128;
      att::bf16* O = (att::bf16*)(ws + WS_MRG) + ((size_t)b * SEQ + qb * 256 + wid * 32) * 2048 + h * 128;
#ifndef NO_A192
      att::attn_unit<192, 128, false, false, 1, true>(Q, K, V, O, 2048, 0, SEQ / 64, 0, SEQ, 0, -1e30f, 0.f, sc * L2E, 8.f / sc, (char*)lds, a.in[7], (const float*)(ws + WS_TMLA) + (size_t)qs * 64);
#endif
    }
    for (int rep = 0; rep < REP_GQA; ++rep)
    for (int i = 0; i < nper; ++i) {
      const int u = c.vcu * nper + i; if (u >= 512) break;
      int tid = threadIdx.x; asm volatile("" : "+v"(tid)); const int wid = tid >> 6, lane = tid & 63, r32 = lane & 31;
      const int bh = u >> 5, qb = u & 31, b = bh >> 3, h = bh & 7, kvh = h >> 2;
      const float sc = 0.08838834764831845f;
      const att::bf16* Q = (const att::bf16*)(ws + WS_QG) + ((size_t)bh * SEQ + qb * 256 + wid * 32 + r32) * 128;
      const att::bf16* K = (const att::bf16*)(ws + WS_KG) + (size_t)(b * 2 + kvh) * SEQ * 128;
      const att::bf16* V = (const att::bf16*)(ws + WS_VG) + (size_t)(b * 2 + kvh) * SEQ * 128;
      att::bf16* O = (att::bf16*)(ws + WS_MRG) + ((size_t)b * SEQ + qb * 256 + wid * 32) * 2048 + 1024 + h * 128;
#ifndef NO_A128
      att::attn_unit<128, 128, false, false, 2>(Q, K, V, O, 2048, 0, SEQ / 64, 0, SEQ, 0, -1e30f, 0.f, sc * L2E, 8.f / sc, (char*)lds);
#endif
    }
  }
  SEAM();
  { pg8::EpiResN<false> E{a.in[0], (pg8::bf16_t*)(ws + WS_XN), RSS, DM, nullptr, 0.f, 0.f}; GEMM_PHASE(pg8::EpiResN<false>, E, WS_MRG, WS_WOE, DM, DM); }
  SEAM();
  STAGGER();
  { pg8::EpiBL<2> E{(pg8::bf16_t*)(ws + WS_U), DFF, ldsl + EST_OFF}; GEMM_PHASE(pg8::EpiBL<2>, E, WS_XN, WS_WUP, DFF, DM); }
#if REP_UP > 1
#ifdef PROBE_NOEPI
  MKCTX(); { pg8::EpiNone E{}; GEMM_PHASE(pg8::EpiNone, E, WS_XN, WS_WUP, DFF, DM); }
#else
  MKCTX(); { pg8::EpiBL<2> E{(pg8::bf16_t*)(ws + WS_U), DFF, ldsl + EST_OFF}; GEMM_PHASE(pg8::EpiBL<2>, E, WS_XN, WS_WUP, DFF, DM); }
#endif
#endif
#if REP_UP > 2
#ifdef PROBE_NOEPI
  MKCTX(); { pg8::EpiNone E{}; GEMM_PHASE(pg8::EpiNone, E, WS_XN, WS_WUP, DFF, DM); }
#else
  MKCTX(); { pg8::EpiBL<2> E{(pg8::bf16_t*)(ws + WS_U), DFF, ldsl + EST_OFF}; GEMM_PHASE(pg8::EpiBL<2>, E, WS_XN, WS_WUP, DFF, DM); }
#endif
#endif
  SEAM();
#ifdef REP_DN
  { pg8::EpiB<0> E{(pg8::bf16_t*)(ws + AB + 256 * MiB), DM, nullptr, 0.f, 0.f}; GEMM_PHASE(pg8::EpiB<0>, E, WS_U, WS_WDN, DM, DFF); } MKCTX();
#endif
  { pg8::EpiResN<true> E{ws + WS_XN, (pg8::bf16_t*)(ws + WS_XN), RSS + T, DM, RSS, 1.f / DM, EPS}; GEMM_PHASE(pg8::EpiResN<true>, E, WS_U, WS_WDN, DM, DFF); }
  SEAM();
  { pg8::EpiQKV E{(pg8::bf16_t*)(ws + WS_SQ), (long)((WS_SK - WS_SQ) / 2), (long)((WS_SV - WS_SQ) / 2), RSS + T, 1.f / DM, EPS, a.in[15], a.in[16], (const float*)(ws + WS_TSWA), 13};
    GEMM_PHASE(pg8::EpiQKV, E, WS_XN, WS_WQKV, ODD_IN, DM); }
#ifndef NO_PRO
  MKCTX(); convert_dynamic<2>((unsigned*)(ws + WS_CNT) + 64, c.wave, c.lane, a, ws, ldsl);
#endif
  SEAM();
  {
    constexpr float L2E = 1.4426950408889634f; const float sc = 0.125f;
    const int nper = (1024 + c.G - 1) / c.G;
    for (int rep = 0; rep < REP_SWA; ++rep)
    for (int i = 0; i < nper; ++i) {
      const int u = c.vcu * nper + i; if (u >= 1024) break;
      int tid = threadIdx.x; asm volatile("" : "+v"(tid)); const int wid = tid >> 6, lane = tid & 63, r32 = lane & 31;
      const int b = u >> 9, kvh = (u >> 7) & 3, rb = u & 127, h = kvh * 8 + wid;
      const att::bf16* Q = (const att::bf16*)(ws + WS_SQ) + ((size_t)(b * 32 + h) * SEQ + rb * 64 + r32) * 64;
      const att::bf16* K = (const att::bf16*)(ws + WS_SK) + (size_t)(b * 4 + kvh) * SEQ * 64;
      const att::bf16* V = (const att::bf16*)(ws + WS_SV) + (size_t)(b * 4 + kvh) * SEQ * 64;
      att::bf16* O = (att::bf16*)(ws + WS_MRG) + ((size_t)b * SEQ + rb * 64) * 2048 + h * 64;
      const float sink = a.in[17][h];
#ifndef NO_A64
      att::swa_unit<5, 2>(Q, K, V, O, 2048, rb * 64 - 128, rb * 64 + r32, SEQ, 128, sink / sc, sc * L2E, 8.f / sc, (char*)lds);
#endif
    }
  }
  SEAM();
  { pg8::EpiResN<true> E{ws + WS_XN, (pg8::bf16_t*)(ws + WS_XN), RSS + 2 * T, DM, nullptr, 0.f, 0.f}; GEMM_PHASE(pg8::EpiResN<true>, E, WS_MRG, WS_WOO, DM, DM); }
  SEAM();
  STAGGER();
  { pg8::EpiBL<2> E{(pg8::bf16_t*)(ws + WS_U), DFF, ldsl + EST_OFF}; GEMM_PHASE(pg8::EpiBL<2>, E, WS_XN, WS_WUP, DFF, DM); }
#if REP_UP > 1
#ifdef PROBE_NOEPI
  MKCTX(); { pg8::EpiNone E{}; GEMM_PHASE(pg8::EpiNone, E, WS_XN, WS_WUP, DFF, DM); }
#else
  MKCTX(); { pg8::EpiBL<2> E{(pg8::bf16_t*)(ws + WS_U), DFF, ldsl + EST_OFF}; GEMM_PHASE(pg8::EpiBL<2>, E, WS_XN, WS_WUP, DFF, DM); }
#endif
#endif
#if REP_UP > 2
#ifdef PROBE_NOEPI
  MKCTX(); { pg8::EpiNone E{}; GEMM_PHASE(pg8::EpiNone, E, WS_XN, WS_WUP, DFF, DM); }
#else
  MKCTX(); { pg8::EpiBL<2> E{(pg8::bf16_t*)(ws + WS_U), DFF, ldsl + EST_OFF}; GEMM_PHASE(pg8::EpiBL<2>, E, WS_XN, WS_WUP, DFF, DM); }
#endif
#endif
  SEAM();
#ifdef REP_DN
  { pg8::EpiB<0> E{(pg8::bf16_t*)(ws + AB + 256 * MiB), DM, nullptr, 0.f, 0.f}; GEMM_PHASE(pg8::EpiB<0>, E, WS_U, WS_WDN, DM, DFF); } MKCTX();
#endif
  { pg8::EpiRes<true> E{ws + WS_XN, X, DM, RSS + 2 * T, 1.f / DM, EPS}; GEMM_PHASE(pg8::EpiRes<true>, E, WS_U, WS_WDN, DM, DFF); }
}

#ifdef PROBE_PRO_KERNEL
__global__ void __launch_bounds__(NWAVES * 64, 2) probe_prologue(Args a) {
  extern __shared__ __attribute__((aligned(16))) unsigned char lds[];
  LAS unsigned char* ldsl = (LAS unsigned char*)lds;
  Ctx c; { int t_ = threadIdx.x; c.lane = t_ & 63; c.wave = __builtin_amdgcn_readfirstlane(t_ >> 6); c.G = gridDim.x; c.vcu = blockIdx.x; c.gw = blockIdx.x * NWAVES + c.wave; c.NGW = c.G * NWAVES; c.ws = a.ws; }
  prologue(c, a, ldsl);
}
#endif
extern "C" void kernel_launch(void* const* d_in, const int* in_sizes, int n_in, void* d_out, int out_size, void* d_ws, size_t ws_size, hipStream_t stream) {
  static int grid = 0;
  if (grid == 0) {
    if (n_in != 22 || out_size != T * DM || ws_size < WS_NEED) { fprintf(stderr, "kernel_launch: unexpected shapes: n_in %d out %d ws %zu (need %zu)\n", n_in, out_size, ws_size, (size_t)WS_NEED); grid = -1; return; }
    int dev = 0, cus = 0, per_cu = 0;
    (void)hipGetDevice(&dev); (void)hipDeviceGetAttribute(&cus, hipDeviceAttributeMultiprocessorCount, dev);
    if (LDS_BYTES > 0 && hipFuncSetAttribute((const void*)fwd_megakernel, hipFuncAttributeMaxDynamicSharedMemorySize, LDS_BYTES) != hipSuccess) { fprintf(stderr, "kernel_launch: hipFuncSetAttribute failed\n"); grid = -1; return; }
    if (hipOccupancyMaxActiveBlocksPerMultiprocessor(&per_cu, (const void*)fwd_megakernel, NWAVES * 64, LDS_BYTES) != hipSuccess || per_cu < 1) { fprintf(stderr, "kernel_launch: occupancy query says %d\n", per_cu); per_cu = 1; }
    (void)hipGetLastError();
    grid = cus * 1;
    fprintf(stderr, "kernel_launch: grid %d (cus %d, per_cu %d)\n", grid, cus, per_cu);
  }
  if (grid < 0) return;
  Args a; memset(&a, 0, sizeof(a));
  for (int i = 0; i < 22; ++i) a.in[i] = (const float*)d_in[i];
  a.out = (float*)d_out; a.ws = (unsigned char*)d_ws;
  for (int f = 0; f < 32; ++f) { a.inv_mla[f] = (float)pow((double)500000.0f, -(double)(2 * f) / 64.0); a.inv_ax[f] = (float)pow((double)10000.0f, -(double)(2 * f) / 64.0); }
  for (int f = 0; f < 8; ++f) a.inv_swa[f] = (float)pow((double)500000.0f, -(double)(2 * f) / 16.0);
  if (hipMemsetAsync(d_ws, 0, 512 * 1024, stream) != hipSuccess) { fprintf(stderr, "kernel_launch: memset failed\n"); return; }
#ifdef PROBE_PRO_KERNEL
  (void)hipFuncSetAttribute((const void*)probe_prologue, hipFuncAttributeMaxDynamicSharedMemorySize, LDS_BYTES);
  hipLaunchKernelGGL(probe_prologue, dim3(grid), dim3(NWAVES * 64), LDS_BYTES, stream, a);
#endif
  void* args[] = {&a};
#ifdef PROBE_PLAIN
  hipLaunchKernelGGL(fwd_megakernel, dim3(grid), dim3(NWAVES * 64), LDS_BYTES, stream, a); hipError_t e = hipPeekAtLastError();
#else
  hipError_t e = hipLaunchCooperativeKernel((const void*)fwd_megakernel, dim3(grid), dim3(NWAVES * 64), args, LDS_BYTES, stream);
#endif
  if (e != hipSuccess) fprintf(stderr, "kernel_launch: cooperative launch failed: %s (grid %d)\n", hipGetErrorString(e), grid);
}
```

```cpp
#include <hip/hip_runtime.h>
#include <hip/hip_cooperative_groups.h>
#include <cstdio>
#include <cstdint>
#include <cmath>
#include <cstring>
namespace cg = cooperative_groups;

namespace pg8 {
#define PG8_LAS __attribute__((address_space(3)))
typedef unsigned short bf16_t;
typedef short bf16x8 __attribute__((ext_vector_type(8)));
typedef float f32x4 __attribute__((ext_vector_type(4)));
typedef unsigned u32x4 __attribute__((ext_vector_type(4)));
constexpr int BM = 256, BK = 64, HALF = 128, HTB = HALF * BK * 2  , STAGE_BYTES = 8 * HTB, NXCD = 8, WGM = 8;

__host__ __device__ __forceinline__ int lds_byte(int r, int c) { const int st = (r >> 4) * 2 + (c >> 5), rr = r & 15, cc = c & 31, ob = rr * 64 + cc * 2; return st * 1024 + (ob ^ (((ob >> 9) & 1) << 5)); }
__host__ __device__ __forceinline__ void stage_rc(int b, int& R, int& C) { const int st = b / 1024, sb = b % 1024, swz = sb ^ (((sb >> 9) & 1) << 5); R = (st >> 1) * 16 + swz / 64; C = (st & 1) * 32 + (swz % 64) / 2; }
__host__ __device__ __forceinline__ int perm32(int rho) { const int n = rho >> 4, i = rho & 15; return 8 * (i >> 2) + 4 * n + (i & 3); }

struct Unit { int pm, pn; };
struct Gemm { const bf16_t* A; const bf16_t* Bt; int M, N, K; };

struct StaticOrder {
    int nM, nN, nwg, G, c;
    __host__ __device__ void init(int M, int N, int G_, int c_) { nM = M / BM; nN = N / BM; nwg = nM * nN; G = G_; c = c_; }
    __host__ __device__ bool next(int i, Unit& u) const {
        const long L = (long)i * G + c; if (L >= nwg) return false;
        int wgid = (int)L; { const int q = nwg / NXCD, r = nwg % NXCD, xcd = wgid % NXCD, off = wgid / NXCD; wgid = (xcd < r ? xcd * (q + 1) : r * (q + 1) + (xcd - r) * q) + off; }
        const int nig = WGM * nN, gid = wgid / nig, fm = gid * WGM, gsz = (nM - fm) < WGM ? (nM - fm) : WGM;
        u.pm = fm + ((wgid % nig) % gsz); u.pn = (wgid % nig) / gsz; return true;
    }
    __device__ __forceinline__ void a_ready(const Unit&) const {}
    __device__ __forceinline__ void done(const Unit&) const {}
};
__device__ __forceinline__ unsigned cvt_pk_bf16(float lo, float hi) { unsigned r; asm volatile("v_cvt_pk_bf16_f32 %0, %1, %2" : "=v"(r) : "v"(lo), "v"(hi)); return r; }
typedef float f32x2 __attribute__((ext_vector_type(2)));
__device__ __forceinline__ f32x2 gelu_pk(f32x2 v) {
    const f32x2 av = __builtin_elementwise_abs(v), d = av * 0.2316418882f + 1.0f;
    f32x2 t; t.x = __builtin_amdgcn_rcpf(d.x); t.y = __builtin_amdgcn_rcpf(d.y);
    f32x2 q = t * 0.5307027145f + (-0.7265760135f); q = q * t + 0.7107068705f; q = q * t + (-0.142248368f); q = q * t + 0.127414796f; q = q * t;
    const f32x2 s = (v * v) * (-0.72134752044f);
    f32x2 e; e.x = __builtin_amdgcn_exp2f(s.x); e.y = __builtin_amdgcn_exp2f(s.y);
    const f32x2 m = v * (q * e), r = v - m;
    f32x2 o; o.x = v.x < 0.f ? m.x : r.x; o.y = v.y < 0.f ? m.y : r.y; return o;
}

template <int ACT  > struct EpiBf16 {
    static constexpr bool PERM = true, AFTER_DRAIN = false; static_assert(ACT == 0 || ACT == 1, "EpiBf16: ACT is 0 (none) or 1 (gelu_pk)");
    bf16_t* O; int ldc; const float* bias; int split_cols; size_t split_stride; float scale0;
    __device__ __forceinline__ void operator()(const f32x4 (&acc)[2][2][4][2], const Unit& u, int wr, int wc, int fr, int fq) const {
        const int row0 = u.pm * BM + wr * 64 + fr; int colt = u.pn * BM; bf16_t* base = O;
        float sc = 1.f; if (split_cols) { const int t = colt / split_cols; base += (size_t)t * split_stride; colt -= t * split_cols; if (t == 0) sc = scale0; }
        const int col0 = colt + wc * 32 + 8 * fq, bcol0 = u.pn * BM + wc * 32 + 8 * fq;
        f32x4 bv[2][2];
#pragma unroll
        for (int bj = 0; bj < 2; ++bj)
#pragma unroll
            for (int n = 0; n < 2; ++n) bv[bj][n] = bias ? *(const f32x4*)(bias + bcol0 + bj * HALF + 4 * n) : (f32x4){0.f, 0.f, 0.f, 0.f};
#pragma unroll
        for (int ai = 0; ai < 2; ++ai)
#pragma unroll
            for (int m = 0; m < 4; ++m) { bf16_t* rowp = base + (size_t)(row0 + ai * HALF + m * 16) * ldc + col0;
#pragma unroll
                for (int bj = 0; bj < 2; ++bj) { f32x4 v0 = acc[ai][bj][m][0] + bv[bj][0], v1 = acc[ai][bj][m][1] + bv[bj][1];
                    if (ACT == 1) { f32x2 a = gelu_pk((f32x2){v0[0], v0[1]}), b = gelu_pk((f32x2){v0[2], v0[3]}), c = gelu_pk((f32x2){v1[0], v1[1]}), d = gelu_pk((f32x2){v1[2], v1[3]});
                        v0 = (f32x4){a.x, a.y, b.x, b.y}; v1 = (f32x4){c.x, c.y, d.x, d.y}; }
                    v0 = v0 * sc; v1 = v1 * sc; u32x4 w; w.x = cvt_pk_bf16(v0[0], v0[1]); w.y = cvt_pk_bf16(v0[2], v0[3]); w.z = cvt_pk_bf16(v1[0], v1[1]); w.w = cvt_pk_bf16(v1[2], v1[3]);
                    *(u32x4*)(rowp + bj * HALF) = w; } }
    }
};

template <int ACT  > struct EpiB {
    static constexpr bool PERM = true, AFTER_DRAIN = false;
    bf16_t* O; int ldc; const float* rowss; float inv_n, eps;
    __device__ __forceinline__ void operator()(const f32x4 (&acc)[2][2][4][2], const Unit& u, int wr, int wc, int fr, int fq) const {
        const int row0 = u.pm * BM + wr * 64 + fr; const int col0 = u.pn * BM + wc * 32 + 8 * fq;
#pragma unroll
        for (int ai = 0; ai < 2; ++ai)
#pragma unroll
            for (int m = 0; m < 4; ++m) { bf16_t* rowp = O + (size_t)(row0 + ai * HALF + m * 16) * ldc + col0;
                const float rs = rowss ? 1.0f / sqrtf(rowss[row0 + ai * HALF + m * 16] * inv_n + eps) : 1.0f;
#pragma unroll
                for (int bj = 0; bj < 2; ++bj) { f32x4 v0 = acc[ai][bj][m][0] * rs, v1 = acc[ai][bj][m][1] * rs;
                    if (ACT == 2) {
#pragma unroll
                        for (int e = 0; e < 4; ++e) { float a = fmaxf(v0[e], 0.f), b = fmaxf(v1[e], 0.f); v0[e] = a * a; v1[e] = b * b; } }
                    u32x4 w; w.x = cvt_pk_bf16(v0[0], v0[1]); w.y = cvt_pk_bf16(v0[2], v0[3]); w.z = cvt_pk_bf16(v1[0], v1[1]); w.w = cvt_pk_bf16(v1[2], v1[3]);
                    *(u32x4*)(rowp + bj * HALF) = w; } }
    }
};
template <bool BASEBF> struct EpiRes {
    static constexpr bool PERM = true, AFTER_DRAIN = false;
    const void* base; float* out; int ldc; const float* sc_ss; float sc_inv_n, sc_eps;
    __device__ __forceinline__ void operator()(const f32x4 (&acc)[2][2][4][2], const Unit& u, int wr, int wc, int fr, int fq) const {
        const int row0 = u.pm * BM + wr * 64 + fr; const int col0 = u.pn * BM + wc * 32 + 8 * fq;
#pragma unroll
        for (int ai = 0; ai < 2; ++ai)
#pragma unroll
            for (int m = 0; m < 4; ++m) { const size_t off = (size_t)(row0 + ai * HALF + m * 16) * ldc + col0;
                const float sc = sc_ss ? 1.0f / (sc_ss[row0 + ai * HALF + m * 16] * sc_inv_n + sc_eps) : 1.0f;
#pragma unroll
                for (int bj = 0; bj < 2; ++bj) { f32x4 b0, b1;
                    if (BASEBF) { const u32x4 w = *(const u32x4*)((const bf16_t*)base + off + bj * HALF);
                        b0 = (f32x4){__uint_as_float(w.x << 16), __uint_as_float(w.x & 0xffff0000u), __uint_as_float(w.y << 16), __uint_as_float(w.y & 0xffff0000u)};
                        b1 = (f32x4){__uint_as_float(w.z << 16), __uint_as_float(w.z & 0xffff0000u), __uint_as_float(w.w << 16), __uint_as_float(w.w & 0xffff0000u)}; }
                    else { b0 = *(const f32x4*)((const float*)base + off + bj * HALF); b1 = *(const f32x4*)((const float*)base + off + bj * HALF + 4); }
                    *(f32x4*)(out + off + bj * HALF) = b0 + acc[ai][bj][m][0] * sc; *(f32x4*)(out + off + bj * HALF + 4) = b1 + acc[ai][bj][m][1] * sc; } }
    }
};
template <bool BASEBF> struct EpiResN {
    static constexpr bool PERM = true, AFTER_DRAIN = false;
    const void* base; bf16_t* xn; float* rowss; int ldc; const float* sc_ss; float sc_inv_n, sc_eps;
    __device__ __forceinline__ void operator()(const f32x4 (&acc)[2][2][4][2], const Unit& u, int wr, int wc, int fr, int fq) const {
        const int row0 = u.pm * BM + wr * 64 + fr; const int col0 = u.pn * BM + wc * 32 + 8 * fq;
#pragma unroll
        for (int ai = 0; ai < 2; ++ai)
#pragma unroll
            for (int m = 0; m < 4; ++m) { const int row = row0 + ai * HALF + m * 16; const size_t off = (size_t)row * ldc + col0; float ss = 0.f;
                const float sc = sc_ss ? 1.0f / (sc_ss[row] * sc_inv_n + sc_eps) : 1.0f;
#pragma unroll
                for (int bj = 0; bj < 2; ++bj) { f32x4 b0, b1;
                    if (BASEBF) { const u32x4 w = *(const u32x4*)((const bf16_t*)base + off + bj * HALF);
                        b0 = (f32x4){__uint_as_float(w.x << 16), __uint_as_float(w.x & 0xffff0000u), __uint_as_float(w.y << 16), __uint_as_float(w.y & 0xffff0000u)};
                        b1 = (f32x4){__uint_as_float(w.z << 16), __uint_as_float(w.z & 0xffff0000u), __uint_as_float(w.w << 16), __uint_as_float(w.w & 0xffff0000u)}; }
                    else { b0 = *(const f32x4*)((const float*)base + off + bj * HALF); b1 = *(const f32x4*)((const float*)base + off + bj * HALF + 4); }
                    const f32x4 o0 = b0 + acc[ai][bj][m][0] * sc, o1 = b1 + acc[ai][bj][m][1] * sc;
                    ss += ((o0[0] * o0[0] + o0[1] * o0[1]) + (o0[2] * o0[2] + o0[3] * o0[3])) + ((o1[0] * o1[0] + o1[1] * o1[1]) + (o1[2] * o1[2] + o1[3] * o1[3]));
                    u32x4 w; w.x = cvt_pk_bf16(o0[0], o0[1]); w.y = cvt_pk_bf16(o0[2], o0[3]); w.z = cvt_pk_bf16(o1[0], o1[1]); w.w = cvt_pk_bf16(o1[2], o1[3]);
                    *(u32x4*)(xn + off + bj * HALF) = w; }
                ss += __shfl_xor(ss, 16); ss += __shfl_xor(ss, 32);
                if (fq == 0) atomicAdd(rowss + row, ss); }
    }
};
struct EpiNone {
    static constexpr bool PERM = true, AFTER_DRAIN = false;
    __device__ __forceinline__ void operator()(const f32x4 (&acc)[2][2][4][2], const Unit& u, int wr, int wc, int fr, int fq) const {
#pragma unroll
        for (int ai = 0; ai < 2; ++ai)
#pragma unroll
            for (int bj = 0; bj < 2; ++bj)
#pragma unroll
                for (int m = 0; m < 4; ++m)
#pragma unroll
                    for (int n = 0; n < 2; ++n) asm volatile("" :: "v"(acc[ai][bj][m][n]));
    }
};
template <int ACT> struct EpiBL {
    static constexpr bool PERM = true, AFTER_DRAIN = false;
    static constexpr int ROWB = 528;
    bf16_t* O; int ldc; PG8_LAS unsigned char* est;
    __device__ __forceinline__ void operator()(const f32x4 (&acc)[2][2][4][2], const Unit& u, int wr, int wc, int fr, int fq) const {
        const int tid = (wr * 4 + wc) * 64 + fq * 16 + fr;
        PG8_LAS unsigned char* wp = est + (wr * 16 + fr) * ROWB + (wc * 32 + 8 * fq) * 2;
        const int rr = tid >> 5, ch = tid & 31;
        const PG8_LAS unsigned char* rp = est + rr * ROWB + ch * 16;
        bf16_t* gbase = O + (size_t)(u.pm * BM) * ldc + u.pn * BM + ch * 8;
#pragma unroll
        for (int ai = 0; ai < 2; ++ai)
#pragma unroll
            for (int m = 0; m < 4; ++m) {
#pragma unroll
                for (int bj = 0; bj < 2; ++bj) { f32x4 v0 = acc[ai][bj][m][0], v1 = acc[ai][bj][m][1];
                    if (ACT == 2) {
#pragma unroll
                        for (int q = 0; q < 4; ++q) { float a = fmaxf(v0[q], 0.f), b = fmaxf(v1[q], 0.f); v0[q] = a * a; v1[q] = b * b; } }
                    u32x4 w; w.x = cvt_pk_bf16(v0[0], v0[1]); w.y = cvt_pk_bf16(v0[2], v0[3]); w.z = cvt_pk_bf16(v1[0], v1[1]); w.w = cvt_pk_bf16(v1[2], v1[3]);
                    *(PG8_LAS u32x4*)(wp + bj * 256) = w; }
                asm volatile("s_waitcnt lgkmcnt(0)" ::: "memory"); __builtin_amdgcn_s_barrier(); asm volatile("" ::: "memory");
#pragma unroll
                for (int p = 0; p < 2; ++p) { const int r = p * 16 + rr;
                    const u32x4 v = *(const PG8_LAS u32x4*)(rp + p * 16 * ROWB);
                    *(u32x4*)(gbase + (size_t)(ai * HALF + (r >> 4) * 64 + m * 16 + (r & 15)) * ldc) = v; }
                asm volatile("s_waitcnt lgkmcnt(0)" ::: "memory"); __builtin_amdgcn_s_barrier(); asm volatile("" ::: "memory");
            }
    }
};
struct EpiQKV {
    static constexpr bool PERM = true, AFTER_DRAIN = false;
    bf16_t* SQ; long k_off, v_off; const float* rowss; float inv_n, eps; const float *gq, *gk; const float* tsw; int seq_shift;
    __device__ __forceinline__ void operator()(const f32x4 (&acc)[2][2][4][2], const Unit& u, int wr, int wc, int fr, int fq) const {
        const int pn = u.pn; const bool isv = pn == 9, isk = pn == 8;
        const float* g = gq; if (isk) g = gk;
        const int seq = 1 << seq_shift;
        long boff = 0; if (isk) boff = k_off; if (isv) boff = v_off;
        bf16_t* base = SQ + boff; const int nh = (isv || isk) ? 4 : 32, h = (isv || isk) ? wc : pn * 4 + wc;
        const float sg = fq ? 1.f : -1.f;
#pragma unroll
        for (int ai = 0; ai < 2; ++ai)
#pragma unroll
            for (int m = 0; m < 4; ++m) { const int t = u.pm * BM + ai * HALF + wr * 64 + m * 16 + fr; const int b = t >> seq_shift, s = t & (seq - 1);
                const float rs = 1.0f / sqrtf(rowss[t] * inv_n + eps);
                f32x4 x00 = acc[ai][0][m][0] * rs, x01 = acc[ai][0][m][1] * rs, x10 = acc[ai][1][m][0] * rs, x11 = acc[ai][1][m][1] * rs;
                if (!isv) {
                    float ss = ((x00[0] * x00[0] + x00[1] * x00[1]) + (x00[2] * x00[2] + x00[3] * x00[3])) + ((x01[0] * x01[0] + x01[1] * x01[1]) + (x01[2] * x01[2] + x01[3] * x01[3]))
                             + ((x10[0] * x10[0] + x10[1] * x10[1]) + (x10[2] * x10[2] + x10[3] * x10[3])) + ((x11[0] * x11[0] + x11[1] * x11[1]) + (x11[2] * x11[2] + x11[3] * x11[3]));
                    ss += __shfl_xor(ss, 16); ss += __shfl_xor(ss, 32);
                    const float hr = 1.0f / sqrtf(ss * (1.f / 64) + eps);
                    x00 = x00 * hr * *(const f32x4*)(g + 8 * fq); x01 = x01 * hr * *(const f32x4*)(g + 8 * fq + 4); x10 = x10 * hr * *(const f32x4*)(g + 32 + 8 * fq); x11 = x11 * hr * *(const f32x4*)(g + 36 + 8 * fq);
                    f32x4 p0, p1;
#pragma unroll
                    for (int q = 0; q < 4; ++q) { p0[q] = __shfl_xor(x00[q], 16); p1[q] = __shfl_xor(x01[q], 16); }
                    if (fq < 2) { const f32x4* cs = (const f32x4*)(tsw + (size_t)s * 16); const f32x4 c0 = cs[0], c1 = cs[1], c2 = cs[2], c3 = cs[3];
                        x00 = (f32x4){x00[0] * c0[0] + sg * p0[0] * c0[1], x00[1] * c0[2] + sg * p0[1] * c0[3], x00[2] * c1[0] + sg * p0[2] * c1[1], x00[3] * c1[2] + sg * p0[3] * c1[3]};
                        x01 = (f32x4){x01[0] * c2[0] + sg * p1[0] * c2[1], x01[1] * c2[2] + sg * p1[1] * c2[3], x01[2] * c3[0] + sg * p1[2] * c3[1], x01[3] * c3[2] + sg * p1[3] * c3[3]}; }
                }
                bf16_t* dst = base + ((size_t)(b * nh + h) * seq + s) * 64 + 8 * fq;
                u32x4 w; w.x = cvt_pk_bf16(x00[0], x00[1]); w.y = cvt_pk_bf16(x00[2], x00[3]); w.z = cvt_pk_bf16(x01[0], x01[1]); w.w = cvt_pk_bf16(x01[2], x01[3]);
                *(u32x4*)dst = w;
                w.x = cvt_pk_bf16(x10[0], x10[1]); w.y = cvt_pk_bf16(x10[2], x10[3]); w.z = cvt_pk_bf16(x11[0], x11[1]); w.w = cvt_pk_bf16(x11[2], x11[3]);
                *(u32x4*)(dst + 32) = w;
                asm volatile("" ::: "memory"); }
    }
};
template <size_t KA_OFF, size_t VA_OFF, size_t KR_OFF, int XCH_OFF, int SEQ_SHIFT> struct EpiKV {
    static constexpr bool PERM = true, AFTER_DRAIN = false;
    unsigned char* wsb; const float* gkn; PG8_LAS unsigned char* ldsb; float eps;
    __device__ __forceinline__ void operator()(const f32x4 (&acc)[2][2][4][2], const Unit& u, int wr, int wc, int fr, int fq) const {
        { int t_ = threadIdx.x; asm volatile("" : "+v"(t_)); fr = t_ & 15; fq = (t_ >> 4) & 3; }
        constexpr int seq_shift = SEQ_SHIFT; const int h = u.pn, seq = 1 << seq_shift;
        bf16_t* KA = (bf16_t*)(wsb + KA_OFF); bf16_t* VA = (bf16_t*)(wsb + VA_OFF); PG8_LAS float* xch = (PG8_LAS float*)(ldsb + XCH_OFF);
#pragma unroll
        for (int ai = 0; ai < 2; ++ai)
#pragma unroll
            for (int m = 0; m < 4; ++m) { const f32x4 a0 = acc[ai][0][m][0], a1 = acc[ai][0][m][1];
                float ss = ((a0[0] * a0[0] + a0[1] * a0[1]) + (a0[2] * a0[2] + a0[3] * a0[3])) + ((a1[0] * a1[0] + a1[1] * a1[1]) + (a1[2] * a1[2] + a1[3] * a1[3]));
                ss += __int_as_float(__builtin_amdgcn_ds_swizzle(__float_as_int(ss), 0x401F));
                { auto rr = __builtin_amdgcn_permlane32_swap(__float_as_uint(ss), __float_as_uint(ss), false, false); ss = __uint_as_float(rr[0]) + __uint_as_float(rr[1]); }
                if (fq == 0) xch[(ai * HALF + wr * 64 + m * 16 + fr) * 4 + wc] = ss; }
        asm volatile("s_waitcnt lgkmcnt(0)" ::: "memory"); __builtin_amdgcn_s_barrier(); asm volatile("" ::: "memory");
        const f32x4 g0 = *(const f32x4*)(gkn + wc * 32 + 8 * fq), g1 = *(const f32x4*)(gkn + wc * 32 + 8 * fq + 4);
#pragma unroll
        for (int ai = 0; ai < 2; ++ai)
#pragma unroll
            for (int m = 0; m < 4; ++m) { const int r = ai * HALF + wr * 64 + m * 16 + fr, t = u.pm * BM + r, b = t >> seq_shift, s = t & (seq - 1);
                const f32x4 p = *(const PG8_LAS f32x4*)(xch + r * 4);
                const float rstd = 1.0f / sqrtf(((p[0] + p[1]) + (p[2] + p[3])) * (1.f / 128) + eps);
                const f32x4 k0 = acc[ai][0][m][0] * rstd * g0, k1 = acc[ai][0][m][1] * rstd * g1, v0 = acc[ai][1][m][0], v1 = acc[ai][1][m][1];
                const size_t row = (size_t)(b * 8 + h) * seq + s;
                u32x4 w; w.x = cvt_pk_bf16(k0[0], k0[1]); w.y = cvt_pk_bf16(k0[2], k0[3]); w.z = cvt_pk_bf16(k1[0], k1[1]); w.w = cvt_pk_bf16(k1[2], k1[3]);
                *(u32x4*)(KA + row * 192 + wc * 32 + 8 * fq) = w;
                w.x = cvt_pk_bf16(v0[0], v0[1]); w.y = cvt_pk_bf16(v0[2], v0[3]); w.z = cvt_pk_bf16(v1[0], v1[1]); w.w = cvt_pk_bf16(v1[2], v1[3]);
                *(u32x4*)(VA + row * 128 + wc * 32 + 8 * fq) = w;
                asm volatile("" ::: "memory"); }
    }
};

template <class Epi, class Sched, bool ALIGN_EPI = false, bool SP2 = false>
__device__ __forceinline__ void gemm_phase(PG8_LAS unsigned char* lds, const Gemm g, const Sched& S, const Epi& E) {
    int tid = threadIdx.x; asm volatile("" : "+v"(tid));
    const int wid = __builtin_amdgcn_readfirstlane(tid >> 6), lane = tid & 63, wr = wid >> 2, wc = wid & 3, fr = lane & 15, fq = lane >> 4;
    const int K = g.K, nt = K / BK;
    unsigned voffA[2], voffB[2];
#pragma unroll
    for (int i = 0; i < 2; ++i) { int R, C; stage_rc(tid * 16 + i * 8192, R, C); const int Rb = Epi::PERM ? ((R & ~31) + perm32(R & 31)) : R;
        voffA[i] = (unsigned)(R * K + C) * 2u; voffB[i] = (unsigned)(Rb * K + C) * 2u; }
    const size_t kstep = (size_t)(BK * 2);
    const size_t hstep = (size_t)HALF * K * 2;
    const size_t tstep = 2 * hstep;
    const unsigned ldsw = (unsigned)wid * 1024u;
    const int aoff = lds_byte(wr * 64 + fr, fq * 8), boff = lds_byte(wc * 32 + fr, fq * 8);
#define PG8_SA(b, h) (((b) * 2 + (h)) * HTB)
#define PG8_SB(b, h) ((4 + (b) * 2 + (h)) * HTB)
#define PG8_STAGE(bufoff, gbase, voff) do { _Pragma("unroll") for (int _i = 0; _i < 2; ++_i) \
        __builtin_amdgcn_global_load_lds((const unsigned*)((const char*)(gbase) + (voff)[_i]), (PG8_LAS unsigned*)(lds + (bufoff) + ldsw + _i * 8192), 16, 0, 0); } while (0)
#define PG8_LDA(dst, b, h) do { _Pragma("unroll") for (int m = 0; m < 4; ++m) _Pragma("unroll") for (int k = 0; k < 2; ++k) dst[m][k] = *(const PG8_LAS bf16x8*)(lds + PG8_SA(b, h) + aoff + m * 2048 + k * 1024); } while (0)
#define PG8_LDB(dst, b, h) do { _Pragma("unroll") for (int n = 0; n < 2; ++n) _Pragma("unroll") for (int k = 0; k < 2; ++k) dst[n][k] = *(const PG8_LAS bf16x8*)(lds + PG8_SB(b, h) + boff + n * 2048 + k * 1024); } while (0)
#define PG8_MMA(ai, bj, At, Bt) do { __builtin_amdgcn_s_setprio(1); _Pragma("unroll") for (int m = 0; m < 4; ++m) _Pragma("unroll") for (int n = 0; n < 2; ++n) _Pragma("unroll") for (int k = 0; k < 2; ++k) \
        acc[ai][bj][m][n] = __builtin_amdgcn_mfma_f32_16x16x32_bf16(Bt[n][k], At[m][k], acc[ai][bj][m][n], 0, 0, 0); __builtin_amdgcn_s_setprio(0); } while (0)
#define PG8_WAIT_V(n) asm volatile("s_waitcnt vmcnt(" #n ")" ::: "memory")
#define PG8_WAIT_L(n) asm volatile("s_waitcnt lgkmcnt(" #n ")" ::: "memory")
#define PG8_BAR __builtin_amdgcn_s_barrier()
#define PG8_SCHED __builtin_amdgcn_sched_barrier(0)
    Unit cur, nxt; int ui = 0;
    if (!S.next(0, cur)) return;
    f32x4 acc[2][2][4][2];
#pragma unroll
    for (int a = 0; a < 2; ++a)
#pragma unroll
        for (int b = 0; b < 2; ++b)
#pragma unroll
            for (int m = 0; m < 4; ++m)
#pragma unroll
                for (int n = 0; n < 2; ++n) acc[a][b][m][n] = (f32x4){0.f, 0.f, 0.f, 0.f};
    bf16x8 At[4][2], B0[2][2], B1[2][2];
    const char* cA = (const char*)g.A + (size_t)cur.pm * tstep; const char* cB = (const char*)g.Bt + (size_t)cur.pn * tstep;
    S.a_ready(cur);
    if constexpr (SP2) {
        PG8_STAGE(PG8_SB(0, 0), cB, voffB); PG8_STAGE(PG8_SB(0, 1), cB + hstep, voffB); PG8_STAGE(PG8_SA(0, 0), cA, voffA); PG8_STAGE(PG8_SA(0, 1), cA + hstep, voffA);
        if (wr == 1) PG8_BAR;
        PG8_WAIT_V(2); PG8_BAR;
        PG8_STAGE(PG8_SB(1, 0), cB + kstep, voffB); PG8_STAGE(PG8_SA(1, 0), cA + kstep, voffA); PG8_STAGE(PG8_SB(1, 1), cB + hstep + kstep, voffB);
        PG8_WAIT_V(6); PG8_BAR;
    } else {
        PG8_STAGE(PG8_SB(0, 0), cB, voffB); PG8_STAGE(PG8_SA(0, 0), cA, voffA); PG8_STAGE(PG8_SB(0, 1), cB + hstep, voffB); PG8_STAGE(PG8_SA(0, 1), cA + hstep, voffA);
        if (wr == 1) PG8_BAR;
        PG8_WAIT_V(4); PG8_BAR;
        PG8_STAGE(PG8_SB(1, 0), cB + kstep, voffB); PG8_STAGE(PG8_SA(1, 0), cA + kstep, voffA); PG8_STAGE(PG8_SB(1, 1), cB + hstep + kstep, voffB);
        PG8_WAIT_V(6); PG8_BAR;
    }
    for (;;) {
        const bool has_next = S.next(ui + 1, nxt);
        const char* nA = has_next ? (const char*)g.A + (size_t)nxt.pm * tstep : cA; const char* nB = has_next ? (const char*)g.Bt + (size_t)nxt.pn * tstep : cB;
        for (int t = 0; t < nt; t += 2) {
            const bool last = (t == nt - 2);
            const char* a1 = cA + (size_t)(t + 1) * kstep;
            const char* a2 = last ? nA : cA + (size_t)(t + 2) * kstep; const char* b2 = last ? nB : cB + (size_t)(t + 2) * kstep;
            const char* a3 = a2 + kstep; const char* b3 = b2 + kstep;
            if (last && has_next) S.a_ready(nxt);
            if constexpr (SP2) {
            PG8_LDB(B0, 0, 0); PG8_LDB(B1, 0, 1); PG8_SCHED; PG8_LDA(At, 0, 0); PG8_STAGE(PG8_SA(1, 1), a1 + hstep, voffA);
            PG8_WAIT_V(8); PG8_WAIT_L(0); PG8_BAR; PG8_MMA(0, 0, At, B0); PG8_MMA(0, 1, At, B1); PG8_BAR; PG8_SCHED;
            PG8_LDA(At, 0, 1); PG8_STAGE(PG8_SB(0, 0), b2, voffB); PG8_STAGE(PG8_SB(0, 1), b2 + hstep, voffB); PG8_STAGE(PG8_SA(0, 0), a2, voffA);
            PG8_WAIT_V(8); PG8_WAIT_L(0); PG8_BAR; PG8_MMA(1, 0, At, B0); PG8_MMA(1, 1, At, B1); PG8_BAR; PG8_SCHED;
            PG8_LDB(B0, 1, 0); PG8_LDB(B1, 1, 1); PG8_SCHED; PG8_LDA(At, 1, 0); PG8_STAGE(PG8_SA(0, 1), a2 + hstep, voffA);
            PG8_WAIT_V(8); PG8_WAIT_L(0); PG8_BAR; PG8_MMA(0, 0, At, B0); PG8_MMA(0, 1, At, B1); PG8_BAR; PG8_SCHED;
            PG8_LDA(At, 1, 1); PG8_STAGE(PG8_SB(1, 0), b3, voffB); PG8_STAGE(PG8_SB(1, 1), b3 + hstep, voffB); PG8_STAGE(PG8_SA(1, 0), a3, voffA);
            PG8_WAIT_V(8); PG8_WAIT_L(0); PG8_BAR; PG8_MMA(1, 0, At, B0); PG8_MMA(1, 1, At, B1); PG8_BAR; PG8_SCHED;
            } else {
            PG8_LDB(B0, 0, 0); PG8_SCHED; PG8_LDA(At, 0, 0); PG8_STAGE(PG8_SA(1, 1), a1 + hstep, voffA);
            PG8_WAIT_L(8); PG8_BAR; PG8_WAIT_L(0); PG8_MMA(0, 0, At, B0); PG8_BAR; PG8_SCHED;
            PG8_LDB(B1, 0, 1); PG8_STAGE(PG8_SB(0, 0), b2, voffB);
            PG8_BAR; PG8_WAIT_L(0); PG8_MMA(0, 1, At, B1); PG8_BAR;
            PG8_LDA(At, 0, 1); PG8_STAGE(PG8_SA(0, 0), a2, voffA);
            PG8_BAR; PG8_WAIT_L(0); PG8_MMA(1, 0, At, B0); PG8_BAR; PG8_SCHED;
            PG8_STAGE(PG8_SB(0, 1), b2 + hstep, voffB);
            PG8_WAIT_V(6); PG8_BAR; PG8_MMA(1, 1, At, B1); PG8_BAR;
            PG8_LDB(B0, 1, 0); PG8_SCHED; PG8_LDA(At, 1, 0); PG8_STAGE(PG8_SA(0, 1), a2 + hstep, voffA);
            PG8_WAIT_L(8); PG8_BAR; PG8_WAIT_L(0); PG8_MMA(0, 0, At, B0); PG8_BAR; PG8_SCHED;
            PG8_LDB(B1, 1, 1); PG8_STAGE(PG8_SB(1, 0), b3, voffB);
            PG8_BAR; PG8_WAIT_L(0); PG8_MMA(0, 1, At, B1); PG8_BAR;
            PG8_LDA(At, 1, 1); PG8_STAGE(PG8_SA(1, 0), a3, voffA);
            PG8_BAR; PG8_WAIT_L(0); PG8_MMA(1, 0, At, B0); PG8_BAR; PG8_SCHED;
            PG8_STAGE(PG8_SB(1, 1), b3 + hstep, voffB);
            PG8_WAIT_V(6); PG8_BAR; PG8_MMA(1, 1, At, B1); PG8_BAR;
            }
        }
        if constexpr (ALIGN_EPI) { if (wr == 0) PG8_BAR; }
        if constexpr (!Epi::AFTER_DRAIN) { E(acc, cur, wr, wc, fr, fq); S.done(cur); }
        if (!has_next) break;
#pragma unroll
        for (int a = 0; a < 2; ++a)
#pragma unroll
            for (int b = 0; b < 2; ++b)
#pragma unroll
                for (int m = 0; m < 4; ++m)
#pragma unroll
                    for (int n = 0; n < 2; ++n) acc[a][b][m][n] = (f32x4){0.f, 0.f, 0.f, 0.f};
        cur = nxt; cA = nA; cB = nB; ++ui;
        if constexpr (ALIGN_EPI) { if (wr == 1) PG8_BAR; }
    }
    PG8_WAIT_V(0);
    if constexpr (!ALIGN_EPI) { if (wr == 0) PG8_BAR; }
    PG8_BAR;
    if constexpr (Epi::AFTER_DRAIN) { E.fused(acc, cur, wr, wc, fr, fq, lds, wid, lane); S.done(cur); }
#undef PG8_SA
#undef PG8_SB
#undef PG8_STAGE
#undef PG8_LDA
#undef PG8_LDB
#undef PG8_MMA
#undef PG8_WAIT_V
#undef PG8_WAIT_L
#undef PG8_BAR
#undef PG8_SCHED
}
}

namespace att {
typedef unsigned short bf16;
using bf16x8 = __attribute__((ext_vector_type(8))) short;
using s16x4  = __attribute__((ext_vector_type(4))) short;
using f32x16 = __attribute__((ext_vector_type(16))) float;
using u32x4  = __attribute__((ext_vector_type(4))) unsigned;
constexpr int NW = 8, QBLK = 32, KVBLK = 64;
#define SBAR() __builtin_amdgcn_sched_barrier(0)
__device__ __forceinline__ int crow(int r, int hi) { return (r & 3) + 8 * (r >> 2) + 4 * hi; }
__device__ __forceinline__ unsigned cvtpk(float lo, float hi) { unsigned r; asm volatile("v_cvt_pk_bf16_f32 %0, %1, %2" : "=v"(r) : "v"(lo), "v"(hi)); return r; }
template <int DK> __device__ __forceinline__ int kswz(int row, int colB) { const int f = (DK == 128) ? ((row & 7) | ((row & 16) >> 1)) : ((row >> 1) & 7); return row * (DK * 2) + (colB ^ (f << 4)); }

__device__ __forceinline__ void partialSM(f32x16& p0, f32x16& p1, float& m_reg, float& mn, float& alpha, const float C, const float thr_raw) {
  float pmax = p0[0];
#pragma unroll
  for (int r = 1; r < 16; ++r) pmax = fmaxf(pmax, p0[r]);
#pragma unroll
  for (int r = 0; r < 16; ++r) pmax = fmaxf(pmax, p1[r]);
  { auto rr = __builtin_amdgcn_permlane32_swap(__float_as_uint(pmax), __float_as_uint(pmax), false, false);
    pmax = fmaxf(__uint_as_float(rr[0]), __uint_as_float(rr[1])); }
  if (__builtin_expect(__all(pmax - m_reg <= thr_raw), 1)) { mn = m_reg; alpha = 1.f; }
  else { mn = fmaxf(m_reg, pmax); alpha = __builtin_amdgcn_exp2f((m_reg - mn) * C); m_reg = mn; }
  float mnC = -mn * C;
#pragma unroll
  for (int r = 0; r < 16; ++r) p0[r] = fmaf(p0[r], C, mnC);
#pragma unroll
  for (int r = 0; r < 16; ++r) p1[r] = fmaf(p1[r], C, mnC);
#pragma unroll
  for (int r = 0; r < 16; ++r) p0[r] = __builtin_amdgcn_exp2f(p0[r]);
}
__device__ __forceinline__ void finishSM(f32x16& p0, f32x16& p1, float alpha, float& l_reg, bf16x8& pa0, bf16x8& pa1, bf16x8& pa2, bf16x8& pa3) {
#pragma unroll
  for (int r = 0; r < 16; ++r) p1[r] = __builtin_amdgcn_exp2f(p1[r]);
  float ps = 0;
#pragma unroll
  for (int r = 0; r < 16; ++r) ps += p0[r];
#pragma unroll
  for (int r = 0; r < 16; ++r) ps += p1[r];
  { auto rr = __builtin_amdgcn_permlane32_swap(__float_as_uint(ps), __float_as_uint(ps), false, false);
    ps = __uint_as_float(rr[0]) + __uint_as_float(rr[1]); }
  l_reg = l_reg * alpha + ps;
#define PK4(P, BASE, OUT) do { unsigned a0 = cvtpk(P[BASE + 0], P[BASE + 1]), a1 = cvtpk(P[BASE + 2], P[BASE + 3]);   \
    unsigned b0 = cvtpk(P[BASE + 4], P[BASE + 5]), b1 = cvtpk(P[BASE + 6], P[BASE + 7]);                              \
    auto r0 = __builtin_amdgcn_permlane32_swap(a0, b0, false, false); auto r1 = __builtin_amdgcn_permlane32_swap(a1, b1, false, false); \
    u32x4 w = {r0[0], r1[0], r0[1], r1[1]}; OUT = *reinterpret_cast<bf16x8*>(&w); } while (0)
  PK4(p0, 0, pa0); PK4(p0, 8, pa1); PK4(p1, 0, pa2); PK4(p1, 8, pa3);
#undef PK4
}
template <int DK, int GS> __device__ __forceinline__ void qkt(f32x16& p0, f32x16& p1, const char* Ks, const int (&kb)[4], const int (&kbx)[4], const bf16x8* qr) {
  constexpr int ND = DK / 16, NG = ND / GS;
  static_assert(ND % GS == 0, "group size");
  p0 = f32x16{}; p1 = f32x16{};
  bf16x8 fa[2][GS], fb[2][GS];
#define QK_RD(buf, g) do { _Pragma("unroll") for (int s_ = 0; s_ < GS; ++s_) { const int d0_ = (g) * GS + s_, e_ = d0_ & 3, gg_ = d0_ >> 2; \
      const int ko_ = (DK == 128) ? (gg_ ? kbx[e_] : kb[e_]) : (kb[e_] + gg_ * 128); \
      fa[buf][s_] = *reinterpret_cast<const bf16x8*>(Ks + ko_); fb[buf][s_] = *reinterpret_cast<const bf16x8*>(Ks + ko_ + 32 * DK * 2); } } while (0)
  QK_RD(0, 0);
#pragma unroll
  for (int g = 0; g < NG; ++g) {
    if (g + 1 < NG) { QK_RD((g + 1) & 1, g + 1); }
    SBAR();
#pragma unroll
    for (int s_ = 0; s_ < GS; ++s_) {
      p0 = __builtin_amdgcn_mfma_f32_32x32x16_bf16(fa[g & 1][s_], qr[g * GS + s_], p0, 0, 0, 0);
      p1 = __builtin_amdgcn_mfma_f32_32x32x16_bf16(fb[g & 1][s_], qr[g * GS + s_], p1, 0, 0, 0); }
    SBAR();
  }
#undef QK_RD
}
template <int NCB> __device__ __forceinline__ int v_st(int k, int c) { const int kk = (k & ~0xC) | ((k & 4) << 1) | ((k & 8) >> 1); return ((kk >> 3) * NCB + (c >> 5)) * 512 + ((kk & 7) * 32 + (c & 31)) * 2; }
__device__ __forceinline__ int v_rd_base(int lane) { return ((lane & 3) << 3) | (((lane >> 2) & 3) << 6) | (((lane >> 4) & 1) << 5) | (((lane >> 5) & 1) << 8); }
template <int OFF> __device__ __forceinline__ s16x4 tr_read(int vb) {
  s16x4 r; asm volatile("ds_read_b64_tr_b16 %0, %1 offset:%2" : "=&v"(r) : "v"(vb), "i"(OFF) : "memory"); return r;
}
template <int D0, int NCB> __device__ __forceinline__ void pv_one(f32x16& od, int vb, bf16x8 pa0, bf16x8 pa1, bf16x8 pa2, bf16x8 pa3) {
#define VOFF(ks, half) (D0 * 512 + (ks) * (1024 * NCB) + (half) * (512 * NCB))
  const s16x4 l0 = tr_read<VOFF(0, 0)>(vb), h0 = tr_read<VOFF(0, 1)>(vb), l1 = tr_read<VOFF(1, 0)>(vb), h1 = tr_read<VOFF(1, 1)>(vb);
  const s16x4 l2 = tr_read<VOFF(2, 0)>(vb), h2 = tr_read<VOFF(2, 1)>(vb), l3 = tr_read<VOFF(3, 0)>(vb), h3 = tr_read<VOFF(3, 1)>(vb);
#undef VOFF
  asm volatile("s_waitcnt lgkmcnt(0)" ::: "memory"); SBAR();
#define PK(L, H) (bf16x8){L[0], L[1], L[2], L[3], H[0], H[1], H[2], H[3]}
  od = __builtin_amdgcn_mfma_f32_32x32x16_bf16(pa0, PK(l0, h0), od, 0, 0, 0);
  od = __builtin_amdgcn_mfma_f32_32x32x16_bf16(pa1, PK(l1, h1), od, 0, 0, 0);
  od = __builtin_amdgcn_mfma_f32_32x32x16_bf16(pa2, PK(l2, h2), od, 0, 0, 0);
  od = __builtin_amdgcn_mfma_f32_32x32x16_bf16(pa3, PK(l3, h3), od, 0, 0, 0);
#undef PK
}
template <int NCB> __device__ __forceinline__ void pv_all(f32x16* o, int vb, bf16x8 pa0, bf16x8 pa1, bf16x8 pa2, bf16x8 pa3) {
  pv_one<0, NCB>(o[0], vb, pa0, pa1, pa2, pa3); pv_one<1, NCB>(o[1], vb, pa0, pa1, pa2, pa3);
  if constexpr (NCB == 4) { pv_one<2, NCB>(o[2], vb, pa0, pa1, pa2, pa3); pv_one<3, NCB>(o[3], vb, pa0, pa1, pa2, pa3); }
}

template <int DK, int DV, bool SWA, bool TWO, int GS, int QMODE = 0>
__device__ __forceinline__ void attn_unit(const bf16* __restrict__ Qrow, const bf16* __restrict__ Kh, const bf16* __restrict__ Vh, bf16* __restrict__ Ow, const int ldo,
                                          const int kstart, const int NT, const int qpos, const int seq, const int win,
                                          const float m_init, const float l_init, const float C, const float thr_raw, char* lds,
                                          const float* __restrict__ mq_gain = nullptr, const float* __restrict__ mq_tm = nullptr) {
  constexpr int NCB = DV / 32, SHM_V = KVBLK * DV * 2, SHM_K = KVBLK * DK * 2, KCH = DK / 8, VCH = DV / 8, NKC = DK / 64, NVC = DV / 64;
  int tid = threadIdx.x; asm volatile("" : "+v"(tid));
  const int wid = tid >> 6, lane = tid & 63, r32 = lane & 31, hi = lane >> 5;
  char* V_lds = lds; char* K_lds = lds + 2 * SHM_V;
  float* ws = (float*)(lds + 2 * SHM_V + 2 * SHM_K) + wid * 64; float* li_l = ws; float* al_l = ws + 32;
  float m_reg = m_init, l_reg = l_init; f32x16 o[NCB]; bf16x8 qr[DK / 16];
#pragma unroll
  for (int d = 0; d < NCB; ++d) o[d] = f32x16{};
#pragma unroll
  for (int d0 = 0; d0 < DK / 16; ++d0) qr[d0] = *reinterpret_cast<const bf16x8*>(Qrow + d0 * 16 + hi * 8);
#define BFV(v_, e_) __uint_as_float(((unsigned)(unsigned short)(v_)[e_]) << 16)
#define PACK8(o_) __builtin_bit_cast(bf16x8, (u32x4){cvtpk(o_[0], o_[1]), cvtpk(o_[2], o_[3]), cvtpk(o_[4], o_[5]), cvtpk(o_[6], o_[7])})
  if constexpr (QMODE == 1) {
    static_assert(DK == 192, "MLA q prologue");
    float ss = 0.f;
#pragma unroll
    for (int d0 = 0; d0 < 12; ++d0)
#pragma unroll
      for (int e = 0; e < 8; ++e) { const float x = BFV(qr[d0], e); ss += x * x; }
    ss += __shfl_xor(ss, 32);
    const float rstd = 1.0f / sqrtf(ss * (1.f / 192) + 1e-6f);
#pragma unroll
    for (int d0 = 0; d0 < 8; ++d0) { float y[8];
#pragma unroll
      for (int e = 0; e < 8; ++e) y[e] = BFV(qr[d0], e) * rstd * mq_gain[d0 * 16 + hi * 8 + e];
      qr[d0] = PACK8(y); }
#pragma unroll
    for (int dd = 0; dd < 2; ++dd) { float o1[8], o2[8];
#pragma unroll
      for (int e = 0; e < 8; ++e) { const int i = dd * 16 + hi * 8 + e; const float x1 = BFV(qr[8 + dd], e) * rstd * mq_gain[128 + i], x2 = BFV(qr[10 + dd], e) * rstd * mq_gain[160 + i];
        const float cc = mq_tm[2 * i], sn = mq_tm[2 * i + 1]; o1[e] = x1 * cc - x2 * sn; o2[e] = x2 * cc + x1 * sn; }
      qr[8 + dd] = PACK8(o1); qr[10 + dd] = PACK8(o2); }
  }
  if constexpr (QMODE == 2) {
    static_assert(DK == 128 || QMODE != 2, "GQA q prologue");
    float ss = 0.f;
#pragma unroll
    for (int d0 = 0; d0 < 8; ++d0)
#pragma unroll
      for (int e = 0; e < 8; ++e) { const float x = BFV(qr[d0], e); ss += x * x; }
    ss += __shfl_xor(ss, 32);
    const float rstd = 1.0f / sqrtf(ss * (1.f / 128) + 1e-6f);
#pragma unroll
    for (int hf = 0; hf < 2; ++hf)
#pragma unroll
      for (int dd = 0; dd < 2; ++dd) { float o1[8], o2[8];
#pragma unroll
        for (int e = 0; e < 8; ++e) { const int i = dd * 16 + hi * 8 + e; const float x1 = BFV(qr[4 * hf + dd], e) * rstd * mq_gain[64 * hf + i], x2 = BFV(qr[4 * hf + 2 + dd], e) * rstd * mq_gain[64 * hf + 32 + i];
          const float cc = mq_tm[64 * hf + 2 * i], sn = mq_tm[64 * hf + 2 * i + 1]; o1[e] = x1 * cc - x2 * sn; o2[e] = x2 * cc + x1 * sn; }
        qr[4 * hf + dd] = PACK8(o1); qr[4 * hf + 2 + dd] = PACK8(o2); }
  }
#undef BFV
#undef PACK8
  unsigned koff[NKC], voff[NVC]; int kdst[NKC], vdst[NVC], krow0 = 0;
#pragma unroll
  for (int i = 0; i < NKC; ++i) { const int c = tid + 512 * i, row = c / KCH, col = (c % KCH) * 8; koff[i] = (unsigned)(row * DK + col) * 2u; kdst[i] = kswz<DK>(row, col * 2); if (i == 0) krow0 = row; }
#pragma unroll
  for (int i = 0; i < NVC; ++i) { const int c = tid + 512 * i, row = c / VCH, col = (c % VCH) * 8; voff[i] = (unsigned)(row * DV + col) * 2u; vdst[i] = v_st<NCB>(row, col); }
  const int vb0 = (int)(uintptr_t)V_lds + v_rd_base(lane);
  int kb[4], kbx[4];
#pragma unroll
  for (int e = 0; e < 4; ++e) { kb[e] = kswz<DK>(r32, (e * 16 + hi * 8) * 2); kbx[e] = kb[e] ^ 128; }
  bf16x8 ks[NKC], vs[NVC], ks2[NKC], vs2[NVC];
#define SLOADX(ks, vs, k0) do { if constexpr (SWA) { static_assert(!SWA || (NKC == 1 && NVC == 1 && DK == DV), "SWA path: one chunk per thread"); \
      const int kr_ = min(max((k0) + krow0, 0), seq - 1) - krow0; const char* Kt = (const char*)Kh + (long)kr_ * (DK * 2); const char* Vt = (const char*)Vh + (long)kr_ * (DV * 2); \
      vs[0] = *reinterpret_cast<const bf16x8*>(Vt + voff[0]); ks[0] = *reinterpret_cast<const bf16x8*>(Kt + koff[0]); } \
    else { const char* Kt = (const char*)Kh + (long)(k0) * (DK * 2); const char* Vt = (const char*)Vh + (long)(k0) * (DV * 2); \
      _Pragma("unroll") for (int i = 0; i < NVC; ++i) vs[i] = *reinterpret_cast<const bf16x8*>(Vt + voff[i]); \
      _Pragma("unroll") for (int i = 0; i < NKC; ++i) ks[i] = *reinterpret_cast<const bf16x8*>(Kt + koff[i]); } } while (0)
#define SWRITEX(ks, vs, b) do { _Pragma("unroll") for (int i = 0; i < NVC; ++i) *(bf16x8*)(V_lds + (b) * SHM_V + vdst[i]) = vs[i]; \
    _Pragma("unroll") for (int i = 0; i < NKC; ++i) *(bf16x8*)(K_lds + (b) * SHM_K + kdst[i]) = ks[i]; } while (0)
#define SLOAD(k0) SLOADX(ks, vs, k0)
#define SWRITE(b) SWRITEX(ks, vs, b)
#define SWAIT() asm volatile("s_waitcnt vmcnt(0)" ::: "memory")
#define RESC(a) do { if (__any((a) < 1.f)) { if (hi == 0) al_l[r32] = (a); asm volatile("s_waitcnt lgkmcnt(0)" ::: "memory"); \
    _Pragma("unroll") for (int d = 0; d < NCB; ++d) _Pragma("unroll") for (int r = 0; r < 16; ++r) o[d][r] *= al_l[crow(r, hi)]; } } while (0)
#define MASK(P0, P1, k0) do { if constexpr (SWA) { const int kb = (k0) + 4 * hi; \
    _Pragma("unroll") for (int r = 0; r < 16; ++r) { const int kv = kb + (r & 3) + 8 * (r >> 2); const int dq = qpos - kv; \
      if (!(dq <= win && dq >= -win && kv >= 0 && kv < seq)) P0[r] = -INFINITY; \
      const int kv2 = kv + 32, dq2 = qpos - kv2; if (!(dq2 <= win && dq2 >= -win && kv2 >= 0 && kv2 < seq)) P1[r] = -INFINITY; } } } while (0)
  f32x16 pA0, pA1, pB0, pB1; float mnA, mnB, alA, alB; bf16x8 pa0, pa1, pa2, pa3;
  if constexpr (TWO) {
  SLOAD(kstart); SWAIT(); SWRITE(0); __syncthreads();
  qkt<DK, GS>(pA0, pA1, K_lds, kb, kbx, qr); MASK(pA0, pA1, kstart); partialSM(pA0, pA1, m_reg, mnA, alA, C, thr_raw);
  SLOAD(kstart + KVBLK);
  SWAIT(); SWRITE(1); __syncthreads();
  for (int j = 1; j + 1 < NT; j += 2) {
    SBAR(); qkt<DK, GS>(pB0, pB1, K_lds + SHM_K, kb, kbx, qr);
    finishSM(pA0, pA1, alA, l_reg, pa0, pa1, pa2, pa3); SBAR();
    SLOAD(kstart + (j + 1) * KVBLK); SBAR();
    pv_all<NCB>(o, vb0, pa0, pa1, pa2, pa3); MASK(pB0, pB1, kstart + j * KVBLK); partialSM(pB0, pB1, m_reg, mnB, alB, C, thr_raw);
    __syncthreads(); SWAIT(); SWRITE(0);
    RESC(alB); __syncthreads();
    SBAR(); qkt<DK, GS>(pA0, pA1, K_lds, kb, kbx, qr);
    finishSM(pB0, pB1, alB, l_reg, pa0, pa1, pa2, pa3); SBAR();
    SLOAD(kstart + (j + 2) * KVBLK); SBAR();
    pv_all<NCB>(o, vb0 + SHM_V, pa0, pa1, pa2, pa3); MASK(pA0, pA1, kstart + (j + 1) * KVBLK); partialSM(pA0, pA1, m_reg, mnA, alA, C, thr_raw);
    __syncthreads(); SWAIT(); SWRITE(1);
    RESC(alA); __syncthreads();
  }
  SBAR(); qkt<DK, GS>(pB0, pB1, K_lds + SHM_K, kb, kbx, qr);
  finishSM(pA0, pA1, alA, l_reg, pa0, pa1, pa2, pa3); SBAR();
  pv_all<NCB>(o, vb0, pa0, pa1, pa2, pa3); MASK(pB0, pB1, kstart + (NT - 1) * KVBLK); partialSM(pB0, pB1, m_reg, mnB, alB, C, thr_raw);
  RESC(alB);
  finishSM(pB0, pB1, alB, l_reg, pa0, pa1, pa2, pa3); SBAR();
  pv_all<NCB>(o, vb0 + SHM_V, pa0, pa1, pa2, pa3);
  } else {
#define TILE(bsel, jj) do { SBAR(); qkt<DK, GS>(pA0, pA1, K_lds + (bsel) * SHM_K, kb, kbx, qr); MASK(pA0, pA1, kstart + (jj) * KVBLK); partialSM(pA0, pA1, m_reg, mnA, alA, C, thr_raw); \
      RESC(alA); finishSM(pA0, pA1, alA, l_reg, pa0, pa1, pa2, pa3); SBAR(); pv_all<NCB>(o, vb0 + (bsel) * SHM_V, pa0, pa1, pa2, pa3); SBAR(); } while (0)
    SLOADX(ks, vs, kstart); SBAR(); SLOADX(ks2, vs2, kstart + KVBLK); SBAR();
    SWRITEX(ks, vs, 0); SBAR();
    SLOADX(ks, vs, kstart + 2 * KVBLK); SBAR();
    __syncthreads();
    for (int j = 0; j < NT; j += 2) {
      TILE(0, j);
      SWRITEX(ks2, vs2, 1); SBAR();
      if (j + 3 < NT) { SLOADX(ks2, vs2, kstart + (j + 3) * KVBLK); } SBAR();
      __syncthreads();
      TILE(1, j + 1);
      if (j + 2 < NT) { SWRITEX(ks, vs, 0); SBAR(); if (j + 4 < NT) { SLOADX(ks, vs, kstart + (j + 4) * KVBLK); } SBAR(); }
      __syncthreads();
    }
#undef TILE
  }
  if (hi == 0) li_l[r32] = l_reg; asm volatile("s_waitcnt lgkmcnt(0)" ::: "memory");
  float rli[16];
#pragma unroll
  for (int r = 0; r < 16; ++r) rli[r] = __builtin_amdgcn_rcpf(li_l[crow(r, hi)]);
  __syncthreads();
  { bf16* stg = (bf16*)lds + wid * (QBLK * DV);
#pragma unroll
    for (int r = 0; r < 16; ++r) { const int orow = crow(r, hi);
#pragma unroll
      for (int d0 = 0; d0 < NCB; ++d0) stg[orow * DV + d0 * 32 + r32] = (bf16)(cvtpk(o[d0][r] * rli[r], 0.f) & 0xffffu); }
    asm volatile("s_waitcnt lgkmcnt(0)" ::: "memory");
#pragma unroll
    for (int i = 0; i < (QBLK * VCH) / 64; ++i) { const int idx = i * 64 + lane, row = idx / VCH, ch = idx % VCH;
      const u32x4 v = *(const u32x4*)(stg + row * DV + ch * 8); *(u32x4*)(Ow + (long)row * ldo + ch * 8) = v; } }
  __syncthreads();
#undef SLOAD
#undef SLOADX
#undef SWRITEX
#undef SWRITE
#undef SWAIT
#undef RESC
#undef MASK
}
template <int NT, int NSUB>
__device__ __forceinline__ void swa_unit(const bf16* __restrict__ Qrow, const bf16* __restrict__ Kh, const bf16* __restrict__ Vh, bf16* __restrict__ Ow, const int ldo,
                                         const int kstart, const int qpos0, const int seq, const int win,
                                         const float m_init, const float C, const float thr_raw, char* lds) {
  constexpr int DK = 64, DV = 64, NCB = 2, SHM = KVBLK * 64 * 2, VCH = 8;
  int tid = threadIdx.x; asm volatile("" : "+v"(tid));
  const int wid = tid >> 6, lane = tid & 63, r32 = lane & 31, hi = lane >> 5;
  char* V_lds = lds; char* K_lds = lds + NT * SHM;
  float* ws = (float*)(lds + 2 * NT * SHM) + wid * 64; float* li_l = ws; float* al_l = ws + 32;
  bf16* stg = (bf16*)(lds + 2 * NT * SHM + NW * 256) + wid * (QBLK * DV);
  const int row = tid >> 3, col = (tid & 7) * 8;
  const int kdst = kswz<DK>(row, col * 2), vdst = v_st<NCB>(row, col);
  const int vb0 = (int)(uintptr_t)V_lds + v_rd_base(lane);
  int kb[4], kbx[4];
#pragma unroll
  for (int e = 0; e < 4; ++e) { kb[e] = kswz<DK>(r32, (e * 16 + hi * 8) * 2); kbx[e] = kb[e]; }
  { bf16x8 ksr[NT], vsr[NT];
#pragma unroll
    for (int t = 0; t < NT; ++t) { const int kr = min(max(kstart + t * KVBLK + row, 0), seq - 1);
      ksr[t] = *reinterpret_cast<const bf16x8*>(Kh + (long)kr * DK + col); vsr[t] = *reinterpret_cast<const bf16x8*>(Vh + (long)kr * DV + col); }
#pragma unroll
    for (int t = 0; t < NT; ++t) { *(bf16x8*)(K_lds + t * SHM + kdst) = ksr[t]; *(bf16x8*)(V_lds + t * SHM + vdst) = vsr[t]; } }
  __syncthreads();
#pragma unroll 1
  for (int sub = 0; sub < NSUB; ++sub) {
    const int qpos = qpos0 + sub * QBLK;
    float m_reg = m_init, l_reg = 1.f; f32x16 o[NCB]; bf16x8 qr[4];
    o[0] = f32x16{}; o[1] = f32x16{};
#pragma unroll
    for (int d0 = 0; d0 < 4; ++d0) qr[d0] = *reinterpret_cast<const bf16x8*>(Qrow + (long)sub * QBLK * DK + d0 * 16 + hi * 8);
    f32x16 p0, p1; float mn, al; bf16x8 pa0, pa1, pa2, pa3;
#pragma unroll
    for (int t = 0; t < NT; ++t) {
      const int k0 = kstart + t * KVBLK;
      SBAR(); qkt<DK, 2>(p0, p1, K_lds + t * SHM, kb, kbx, qr);
      { const int kbase = k0 + 4 * hi;
#pragma unroll
        for (int r = 0; r < 16; ++r) { const int kv = kbase + (r & 3) + 8 * (r >> 2); const int dq = qpos - kv;
          if (!(dq <= win && dq >= -win && kv >= 0 && kv < seq)) p0[r] = -INFINITY;
          const int kv2 = kv + 32, dq2 = qpos - kv2; if (!(dq2 <= win && dq2 >= -win && kv2 >= 0 && kv2 < seq)) p1[r] = -INFINITY; } }
      partialSM(p0, p1, m_reg, mn, al, C, thr_raw);
      if (__any(al < 1.f)) { if (hi == 0) al_l[r32] = al; asm volatile("s_waitcnt lgkmcnt(0)" ::: "memory");
#pragma unroll
        for (int d = 0; d < NCB; ++d)
#pragma unroll
          for (int r = 0; r < 16; ++r) o[d][r] *= al_l[crow(r, hi)]; }
      finishSM(p0, p1, al, l_reg, pa0, pa1, pa2, pa3); SBAR();
      pv_all<NCB>(o, vb0 + t * SHM, pa0, pa1, pa2, pa3);
    }
    if (hi == 0) li_l[r32] = l_reg; asm volatile("s_waitcnt lgkmcnt(0)" ::: "memory");
    float rli[16];
#pragma unroll
    for (int r = 0; r < 16; ++r) rli[r] = __builtin_amdgcn_rcpf(li_l[crow(r, hi)]);
#pragma unroll
    for (int r = 0; r < 16; ++r) { const int orow = crow(r, hi);
#pragma unroll
      for (int d0 = 0; d0 < NCB; ++d0) stg[orow * DV + d0 * 32 + r32] = (bf16)(cvtpk(o[d0][r] * rli[r], 0.f) & 0xffffu); }
    asm volatile("s_waitcnt lgkmcnt(0)" ::: "memory");
#pragma unroll
    for (int i = 0; i < (QBLK * VCH) / 64; ++i) { const int idx = i * 64 + lane, rw = idx / VCH, ch = idx % VCH;
      const u32x4 v = *(const u32x4*)(stg + rw * DV + ch * 8); *(u32x4*)(Ow + (long)(sub * QBLK + rw) * ldo + ch * 8) = v; }
    asm volatile("s_waitcnt lgkmcnt(0)" ::: "memory");
  }
  __syncthreads();
}
#undef SBAR
}

#define LAS __attribute__((address_space(3)))
typedef unsigned short bf16;
typedef unsigned v4u __attribute__((ext_vector_type(4)));
typedef unsigned v2u __attribute__((ext_vector_type(2)));
typedef float f32x4 __attribute__((ext_vector_type(4)));
typedef float f32x2 __attribute__((ext_vector_type(2)));
constexpr int NWAVES = 8;
constexpr int BATCH = 2, SEQ = 8192, T = BATCH * SEQ, DM = 2048, DFF = 8192;
constexpr int EVEN_IN = 2368, EVEN_IN_P = 2560, ODD_IN = 2560;
constexpr float EPS = 1e-6f;
constexpr size_t MiB = 1u << 20;
constexpr size_t WS_WIN = 1 * MiB, WS_WUQ = 11 * MiB, WS_WUKV = 13 * MiB, WS_WOE = 14 * MiB, WS_WUP = 22 * MiB, WS_WDN = 54 * MiB;
constexpr size_t WS_WQKV = 487 * MiB, WS_WOO = 497 * MiB;
constexpr size_t WS_TMLA = 86 * MiB, WS_TAX = 88 * MiB, WS_TSWA = 92 * MiB;
constexpr size_t WS_XN = 93 * MiB;
constexpr size_t WS_CNT = 48 * 1024;
constexpr size_t WS_ROWSS = 64 * 1024;
constexpr size_t AB = 157 * MiB;
constexpr size_t WS_MRG0 = AB + 154 * MiB;
constexpr size_t WS_MRG = AB;
constexpr size_t WS_U = AB;
constexpr size_t WS_PROJ = AB, WS_KVR = AB, WS_QAR = AB + 80 * MiB, WS_CQN = AB + 128 * MiB, WS_CKVN = AB + 144 * MiB, WS_KR = AB + 152 * MiB, WS_QG = AB + 154 * MiB,
                 WS_KG = AB + 218 * MiB, WS_VG = AB + 226 * MiB, WS_QA = AB + 202 * MiB, WS_KA = AB + 250 * MiB, WS_VA = AB + 298 * MiB;
constexpr size_t WS_SQ = AB + 80 * MiB, WS_SK = AB + 144 * MiB, WS_SV = AB + 152 * MiB;
constexpr size_t WS_END = AB + 330 * MiB;
static_assert(WS_END <= WS_WQKV && WS_WOO + 8 * MiB <= 512 * MiB && WS_U + 256 * MiB <= WS_WQKV, "workspace map");
constexpr size_t WS_NEED = 505 * MiB;
#ifdef PROBE_NOLDS
constexpr int LDS_BYTES = 0;
#else
constexpr int EST_OFF = 131072 + 1024, LDS_BYTES = EST_OFF + 32 * 528 + 512;
#endif

__device__ __forceinline__ unsigned cvtpk2(float lo, float hi) { unsigned r; asm volatile("v_cvt_pk_bf16_f32 %0, %1, %2" : "=v"(r) : "v"(lo), "v"(hi)); return r; }
__device__ __forceinline__ float bflo(unsigned w) { return __uint_as_float(w << 16); }
__device__ __forceinline__ float bfhi(unsigned w) { return __uint_as_float(w & 0xffff0000u); }
__device__ __forceinline__ void ld8(const bf16* p, float (&v)[8]) { const v4u w = *(const v4u*)p; v[0] = bflo(w.x); v[1] = bfhi(w.x); v[2] = bflo(w.y); v[3] = bfhi(w.y); v[4] = bflo(w.z); v[5] = bfhi(w.z); v[6] = bflo(w.w); v[7] = bfhi(w.w); }
__device__ __forceinline__ void st8(bf16* p, const float (&v)[8]) { v4u w; w.x = cvtpk2(v[0], v[1]); w.y = cvtpk2(v[2], v[3]); w.z = cvtpk2(v[4], v[5]); w.w = cvtpk2(v[6], v[7]); *(v4u*)p = w; }
__device__ __forceinline__ void ld4(const bf16* p, float (&v)[4]) { const v2u w = *(const v2u*)p; v[0] = bflo(w.x); v[1] = bfhi(w.x); v[2] = bflo(w.y); v[3] = bfhi(w.y); }
__device__ __forceinline__ void st4(bf16* p, const float (&v)[4]) { v2u w; w.x = cvtpk2(v[0], v[1]); w.y = cvtpk2(v[2], v[3]); *(v2u*)p = w; }
template <int W> __device__ __forceinline__ float grp_sum(float v) {
#pragma unroll
  for (int o = 1; o < W; o <<= 1) v += __shfl_xor(v, o);
  return v;
}
__device__ __forceinline__ float sumsq8(const float (&v)[8]) { float s = 0.f;
#pragma unroll
  for (int j = 0; j < 8; ++j) s += v[j] * v[j];
  return s; }

#define XB_TMO      128
#define XB_XCNT(j)  (256  + 64 * (j))
#define XB_XSUB(j)  (1280 + 64 * (j))
#define XB_XGEN(j)  (2304 + 64 * (j))
#define XB_TOP      3328
#define XB_TOPGEN   3392
#define XCD_BAR_WORDS 3456
#define XB_SPIN_CAP (1u << 18)

__device__ __forceinline__ unsigned xb_ld(unsigned* p)              { return __hip_atomic_load(p, __ATOMIC_RELAXED, __HIP_MEMORY_SCOPE_AGENT); }
__device__ __forceinline__ unsigned xb_add(unsigned* p, unsigned v) { return __hip_atomic_fetch_add(p, v, __ATOMIC_RELAXED, __HIP_MEMORY_SCOPE_AGENT); }
__device__ __forceinline__ unsigned xb_xcc_id() { return (unsigned)__builtin_amdgcn_s_getreg((3 << 11) | 20) & 0xFu; }
#define XB_SPIN(cond, bar) do { unsigned _sp = 0; while (cond) { __builtin_amdgcn_s_sleep(1); \
    if ((++_sp & 255u) == 0u) { if (xb_ld(&(bar)[XB_TMO])) break; if (_sp > XB_SPIN_CAP) { atomicAdd(&(bar)[XB_TMO], 1u); break; } } } } while (0)

struct XcdBarrier {
    unsigned* bar; unsigned x;
    volatile LAS unsigned* st;
};

__device__ __forceinline__ XcdBarrier xcd_barrier_post(unsigned* bar, volatile LAS unsigned* st) {
    XcdBarrier b; b.bar = bar; b.x = xb_xcc_id(); b.st = st;
    if (threadIdx.x == 0) (void)xb_add(&bar[XB_XCNT(b.x)], 1u);
    return b;
}
__device__ __forceinline__ void xcd_barrier_complete(unsigned* bar, unsigned x, unsigned& nloc, unsigned& nx) {
    const unsigned G = gridDim.x * gridDim.y * gridDim.z;
    unsigned sum, cnt, mine, sp = 0u;
    for (;;) {
        sum = 0u; cnt = 0u; mine = 0u;
#pragma unroll
        for (unsigned j = 0; j < 16; ++j) { const unsigned c = xb_ld(&bar[XB_XCNT(j)]); sum += c; cnt += (c > 0u) ? 1u : 0u; mine = (j == x) ? c : mine; }
        if (sum == G) break;
        __builtin_amdgcn_s_sleep(1);
        if ((++sp & 255u) == 0u) { if (xb_ld(&bar[XB_TMO])) break; if (sp > XB_SPIN_CAP) { atomicAdd(&bar[XB_TMO], 1u); break; } }
    }
    nloc = mine > 0u ? mine : 1u; nx = cnt > 0u ? cnt : 1u;
}

__device__ __forceinline__ void xcd_barrier(const XcdBarrier& b) {
    asm volatile("s_waitcnt vmcnt(0)" ::: "memory");
    __syncthreads();
    if (threadIdx.x == 0) {
        unsigned* bar = b.bar;
        __builtin_amdgcn_s_waitcnt(0);
        unsigned nloc = b.st[0], nx = b.st[1];
        if (nloc == 0u) { xcd_barrier_complete(bar, b.x, nloc, nx); b.st[0] = nloc; b.st[1] = nx; }
        const unsigned old = xb_add(&bar[XB_XSUB(b.x)], 1u);
        const unsigned gen = old / nloc;
        if (old + 1u == (gen + 1u) * nloc) {
            __builtin_amdgcn_fence(__ATOMIC_RELEASE, "agent");
            asm volatile("s_waitcnt vmcnt(0)" ::: "memory");
            const unsigned og = xb_add(&bar[XB_TOP], 1u);
            const unsigned tg = og / nx;
            if (og + 1u == (tg + 1u) * nx) xb_add(&bar[XB_TOPGEN], 1u);
            else XB_SPIN(xb_ld(&bar[XB_TOPGEN]) == tg, bar);
            __builtin_amdgcn_fence(__ATOMIC_ACQUIRE, "agent");
            xb_add(&bar[XB_XGEN(b.x)], 1u);
            asm volatile("s_waitcnt vmcnt(0)" ::: "memory");
        } else {
            XB_SPIN(xb_ld(&bar[XB_XGEN(b.x)]) == gen, bar);
            __builtin_amdgcn_fence(__ATOMIC_ACQUIRE, "agent");
            asm volatile("s_waitcnt vmcnt(0)" ::: "memory");
        }
    }
    __syncthreads();
}

struct Args {
  const float* in[22]; float* out; unsigned char* ws;
  float inv_mla[32], inv_ax[32], inv_swa[8];
};

struct Ctx { int lane, wave, gw, NGW, G, vcu; unsigned char* ws; };

__device__ __forceinline__ void transpose_stream(const float* __restrict__ W, const int K, const int N, bf16* __restrict__ WT, LAS float* scr, const int first, const int items, const int stride, const int lane, const float* __restrict__ gain, const bool permq = false) {
  const int nblk = N / 32, half = lane >> 5, l31 = lane & 31;
  float cur[32], nxt[32];
  if (first >= items) return;
#define TS_LOAD(dst, item_) do { const int kb_ = (item_) / nblk, nb_ = (item_) % nblk; const float* p_ = W + (size_t)(64 * kb_ + half) * N + 32 * nb_ + l31; \
    _Pragma("unroll") for (int i = 0; i < 32; ++i) dst[i] = p_[(size_t)(2 * i) * N]; } while (0)
  TS_LOAD(cur, first);
  for (int it = first; it < items; it += stride) {
    const bool more = it + stride < items;
    if (more) TS_LOAD(nxt, it + stride);
    const int kb = it / nblk, nb = it % nblk, k0 = 64 * kb, n0 = 32 * nb;
    const int n0p = permq ? ((n0 & ~255) | (((n0 >> 5) & 1) << 7) | (((n0 >> 6) & 3) << 5)) : n0;
    if (gain) {
#pragma unroll
      for (int i = 0; i < 32; ++i) cur[i] *= gain[k0 + 2 * i + half]; }
#pragma unroll
    for (int i = 0; i < 32; ++i) scr[(2 * i + half) * 33 + l31] = cur[i];
    asm volatile("s_waitcnt lgkmcnt(0)" ::: "memory");
    const int c = lane & 7;
#pragma unroll
    for (int j = 0; j < 4; ++j) { const int n = (lane >> 3) + 8 * j; const LAS float* s = scr + (8 * c) * 33 + n;
      v4u o; o.x = cvtpk2(s[0 * 33], s[1 * 33]); o.y = cvtpk2(s[2 * 33], s[3 * 33]); o.z = cvtpk2(s[4 * 33], s[5 * 33]); o.w = cvtpk2(s[6 * 33], s[7 * 33]);
      *(v4u*)(WT + (size_t)(n0p + n) * K + k0 + 8 * c) = o; }
    asm volatile("s_waitcnt lgkmcnt(0)" ::: "memory");
    if (more) {
#pragma unroll
      for (int i = 0; i < 32; ++i) cur[i] = nxt[i]; }
  }
#undef TS_LOAD
}
template <int SET> __device__ __forceinline__ void convert_dynamic(unsigned* counter, const int wave, const int lane, const Args& a, unsigned char* ws, LAS unsigned char* lds) {
  LAS float* scr = (LAS float*)(lds + wave * 16384);
  constexpr int CH = 8, C_OE = (DM / 64) * (DM / 32) / CH, C_UP = (DM / 64) * (DFF / 32) / CH, C_DN = (DFF / 64) * (DM / 32) / CH, C_QKV = (DM / 64) * (ODD_IN / 32) / CH;
#define CD_TS(W_, K_, N_, off_, gain_, perm_, ch_) transpose_stream((W_), (K_), (N_), (bf16*)(ws + (off_)), scr, (ch_) * CH, (ch_) * CH + CH, 1, lane, (gain_), (perm_))
  for (;;) {
    int chv = 0; if (lane == 0) chv = (int)__hip_atomic_fetch_add(counter, 1u, __ATOMIC_RELAXED, __HIP_MEMORY_SCOPE_AGENT);
    const int ch = __builtin_amdgcn_readfirstlane(chv);
    if constexpr (SET == 1) {
      if (ch < C_UP) CD_TS(a.in[20], DM, DFF, WS_WUP, a.in[19], false, ch);
      else if (ch < C_UP + C_DN) CD_TS(a.in[21], DFF, DM, WS_WDN, nullptr, false, ch - C_UP);
      else if (ch < C_UP + C_DN + C_OE) CD_TS(a.in[12], DM, DM, WS_WOE, nullptr, false, ch - C_UP - C_DN);
      else if (ch < C_UP + C_DN + C_OE + C_QKV) CD_TS(a.in[14], DM, ODD_IN, WS_WQKV, a.in[13], true, ch - C_UP - C_DN - C_OE);
      else if (ch < C_UP + C_DN + 2 * C_OE + C_QKV) CD_TS(a.in[18], DM, DM, WS_WOO, nullptr, false, ch - C_UP - C_DN - C_OE - C_QKV);
      else break;
    } else {
      if (ch < C_UP) CD_TS(a.in[20] + (size_t)DM * DFF, DM, DFF, WS_WUP, a.in[19] + DM, false, ch);
      else if (ch < C_UP + C_DN) CD_TS(a.in[21] + (size_t)DM * DFF, DFF, DM, WS_WDN, nullptr, false, ch - C_UP);
      else break;
    }
  }
#undef CD_TS
}
__device__ __forceinline__ void rms_row(const float* xrow, const float* gain, bf16* orow, int lane) {
  f32x4 v[8]; float s = 0.f;
#pragma unroll
  for (int j = 0; j < 4; ++j) { const f32x4* p = (const f32x4*)xrow + 2 * (64 * j + lane); v[2 * j] = p[0]; v[2 * j + 1] = p[1]; }
#pragma unroll
  for (int j = 0; j < 8; ++j) s += (v[j].x * v[j].x + v[j].y * v[j].y) + (v[j].z * v[j].z + v[j].w * v[j].w);
  const float rstd = 1.0f / sqrtf(grp_sum<64>(s) * (1.f / DM) + EPS);
#pragma unroll
  for (int j = 0; j < 4; ++j) { const f32x4* gp = (const f32x4*)gain + 2 * (64 * j + lane); const f32x4 g0 = gp[0], g1 = gp[1], a0 = v[2 * j], a1 = v[2 * j + 1];
    v4u w; w.x = cvtpk2(a0.x * rstd * g0.x, a0.y * rstd * g0.y); w.y = cvtpk2(a0.z * rstd * g0.z, a0.w * rstd * g0.w); w.z = cvtpk2(a1.x * rstd * g1.x, a1.y * rstd * g1.y); w.w = cvtpk2(a1.z * rstd * g1.z, a1.w * rstd * g1.w);
    *((v4u*)orow + 64 * j + lane) = w; }
}
__device__ __forceinline__ void norm_phase(const Ctx& c, const float* x, const float* gain, bf16* xn) {
  for (int m = c.gw; m < T; m += c.NGW) rms_row(x + (size_t)m * DM, gain, xn + (size_t)m * DM, c.lane);
}
__device__ __forceinline__ f32x2 sincos_rev(float ang) {
  double fr = (double)ang * 0.15915494309189533577; fr -= rint(fr); const float f = (float)fr;
  return (f32x2){__builtin_amdgcn_cosf(f), __builtin_amdgcn_sinf(f)};
}

__device__ __forceinline__ void prologue(const Ctx& c, const Args& a, LAS unsigned char* lds) {
  LAS float* scr = (LAS float*)(lds + c.wave * 16384);
  unsigned char* ws = c.ws;
  int base = 0;
#define DO_W(inidx, K_, N_, off, srcoff, gain_) do { const int items = ((K_) / 64) * ((N_) / 32); const float* W = a.in[inidx] + (srcoff); bf16* WT = (bf16*)(ws + (off)); \
    const int first = (c.gw - (base % c.NGW) + c.NGW) % c.NGW; \
    transpose_stream(W, (K_), (N_), WT, scr, first, items, c.NGW, c.lane, (gain_)); \
    base += items; } while (0)
  DO_W(2, DM, EVEN_IN, WS_WIN, 0, nullptr); DO_W(5, 512, 1536, WS_WUQ, 0, nullptr); DO_W(6, 256, 2048, WS_WUKV, 0, nullptr);
#undef DO_W
  { v4u* z = (v4u*)((bf16*)(ws + WS_WIN) + (size_t)EVEN_IN * DM); const int n16 = (EVEN_IN_P - EVEN_IN) * DM / 8;
    for (int i = c.gw * 64 + c.lane; i < n16; i += c.NGW * 64) z[i] = (v4u){0u, 0u, 0u, 0u}; }
  { f32x2* tm = (f32x2*)(ws + WS_TMLA); f32x2* ta = (f32x2*)(ws + WS_TAX); f32x2* tsw = (f32x2*)(ws + WS_TSWA);
    const int gt = c.gw * 64 + c.lane, NT_ = c.NGW * 64;
    for (int i = gt; i < SEQ * 32; i += NT_) { const int s = i >> 5, f = i & 31; tm[i] = sincos_rev((float)s * a.inv_mla[f]); }
    for (int i = gt; i < SEQ * 64; i += NT_) { const int s = i >> 6, f = i & 63; const int pos = (f < 32) ? (s >> 6) : (s & 63); ta[i] = sincos_rev((float)pos * a.inv_ax[f & 31]); }
    for (int i = gt; i < SEQ * 8; i += NT_) { const int s = i >> 3, f = i & 7; tsw[i] = sincos_rev((float)s * a.inv_swa[f]); } }
  norm_phase(c, a.in[0], a.in[1], (bf16*)(ws + WS_XN));
}

__device__ __forceinline__ void convert_layer1(const Ctx& c, const Args& a, LAS unsigned char* lds) {
  LAS float* scr = (LAS float*)(lds + c.wave * 16384);
  unsigned char* ws = c.ws;
  int base = 0;
#define DO_W(inidx, K_, N_, off, srcoff, gain_) do { const int items = ((K_) / 64) * ((N_) / 32); const float* W = a.in[inidx] + (srcoff); bf16* WT = (bf16*)(ws + (off)); \
    const int first = (c.gw - (base % c.NGW) + c.NGW) % c.NGW; \
    transpose_stream(W, (K_), (N_), WT, scr, first, items, c.NGW, c.lane, (gain_)); \
    base += items; } while (0)
  DO_W(20, DM, DFF, WS_WUP, (size_t)DM * DFF, a.in[19] + DM); DO_W(21, DFF, DM, WS_WDN, (size_t)DM * DFF, nullptr);
#undef DO_W
}
__device__ __forceinline__ void post_proj(const Ctx& c, const Args& a) {
  unsigned char* ws = c.ws; const int l = c.lane;
  const bf16* PROJ = (const bf16*)(ws + WS_PROJ);
  bf16* CQN = (bf16*)(ws + WS_CQN); bf16* CKVN = (bf16*)(ws + WS_CKVN); bf16* KR = (bf16*)(ws + WS_KR);
  bf16* QG = (bf16*)(ws + WS_QG); bf16* KG = (bf16*)(ws + WS_KG); bf16* VG = (bf16*)(ws + WS_VG);
  const f32x2* tm = (const f32x2*)(ws + WS_TMLA); const f32x2* ta = (const f32x2*)(ws + WS_TAX);
  const float* g_qlat = a.in[3]; const float* g_kvlat = a.in[4]; const float* g_krope = a.in[9]; const float* g_gq = a.in[10]; const float* g_gk = a.in[11];
  for (int t = c.gw; t < T; t += c.NGW) {
    const int b = t / SEQ, s = t % SEQ; const bf16* pr = PROJ + (size_t)t * EVEN_IN_P;
    float v[8], o[8];
    { ld8(pr + 8 * l, v); const float rstd = 1.0f / sqrtf(grp_sum<64>(sumsq8(v)) * (1.f / 512) + EPS);
#pragma unroll
      for (int j = 0; j < 8; ++j) o[j] = v[j] * rstd * g_qlat[8 * l + j];
      st8(CQN + (size_t)t * 512 + 8 * l, o); }
    { const bool act = l < 40; if (act) ld8(pr + 512 + 8 * l, v); else {
#pragma unroll
        for (int j = 0; j < 8; ++j) v[j] = 0.f; }
      float ss = grp_sum<8>(sumsq8(v)); const float ss8 = ss; ss += __shfl_xor(ss, 8); ss += __shfl_xor(ss, 16);
      if (l < 32) { const float rstd = 1.0f / sqrtf(ss * (1.f / 256) + EPS);
#pragma unroll
        for (int j = 0; j < 8; ++j) o[j] = v[j] * rstd * g_kvlat[8 * l + j];
        st8(CKVN + (size_t)t * 256 + 8 * l, o); }
      const int lr = l & 7; const float rstd8 = 1.0f / sqrtf(ss8 * (1.f / 64) + EPS); float nv[8], pv_[8];
#pragma unroll
      for (int j = 0; j < 8; ++j) nv[j] = v[j] * rstd8 * g_krope[(8 * lr + j) & 63];
#pragma unroll
      for (int j = 0; j < 8; ++j) pv_[j] = __shfl_xor(nv[j], 4);
      if (l >= 32 && l < 40) {
#pragma unroll
        for (int j = 0; j < 8; ++j) { const f32x2 cs = tm[s * 32 + 8 * (lr & 3) + j]; o[j] = (lr & 4) ? (nv[j] * cs.x + pv_[j] * cs.y) : (nv[j] * cs.x - pv_[j] * cs.y); }
        bf16* KAr = (bf16*)(ws + WS_KA) + ((size_t)(b * 8) * SEQ + s) * 192 + 128 + 8 * lr;
#pragma unroll
        for (int hh = 0; hh < 8; ++hh) st8(KAr + (size_t)hh * SEQ * 192, o); } }
#pragma unroll
    for (int pass = 2; pass < 3; ++pass) {
      const int hl = l >> 4, ll = l & 15;
      ld8(pr + 832 + pass * 512 + 8 * l, v);
      const float rstd = 1.0f / sqrtf(grp_sum<16>(sumsq8(v)) * (1.f / 128) + EPS);
      const float* g = (pass < 2) ? g_gq : g_gk; float nv[8], pv_[8];
#pragma unroll
      for (int j = 0; j < 8; ++j) nv[j] = v[j] * rstd * g[8 * ll + j];
#pragma unroll
      for (int j = 0; j < 8; ++j) pv_[j] = __shfl_xor(nv[j], 4);
#pragma unroll
      for (int j = 0; j < 8; ++j) { const f32x2 cs = ta[s * 64 + ((ll & 8) ? 32 : 0) + 8 * (ll & 3) + j]; o[j] = (ll & 4) ? (nv[j] * cs.x + pv_[j] * cs.y) : (nv[j] * cs.x - pv_[j] * cs.y); }
      if (pass < 2) st8(QG + ((size_t)(b * 8 + pass * 4 + hl) * SEQ + s) * 128 + 8 * ll, o);
      else if (hl < 2) st8(KG + ((size_t)(b * 2 + hl) * SEQ + s) * 128 + 8 * ll, o);
      else st8(VG + ((size_t)(b * 2 + (hl - 2)) * SEQ + s) * 128 + 8 * ll, v);
    }
  }
}
__device__ __forceinline__ void post_mla(const Ctx& c, const Args& a) {
  unsigned char* ws = c.ws; const int l = c.lane, hl = l >> 4, ll = l & 15;
  const bf16* QAR = (const bf16*)(ws + WS_QAR); const bf16* KVR = (const bf16*)(ws + WS_KVR); const bf16* KR = (const bf16*)(ws + WS_KR);
  bf16* QA = (bf16*)(ws + WS_QA); bf16* KA = (bf16*)(ws + WS_KA); bf16* VA = (bf16*)(ws + WS_VA);
  const f32x2* tm = (const f32x2*)(ws + WS_TMLA);
  const float* g_q = a.in[7]; const float* g_kn = a.in[8];
  for (int t = c.gw; t < T; t += c.NGW) {
    const int b = t / SEQ, s = t % SEQ;
#pragma unroll
    for (int pass = 0; pass < 2; ++pass) {
      const int h = pass * 4 + hl;
      {
        const bf16* q = QAR + (size_t)t * 1536 + h * 192; float v[8], r[4], o[8], ro[4];
        ld8(q + 8 * ll, v); ld4(q + 128 + 4 * ll, r);
        float ss = sumsq8(v) + (r[0] * r[0] + r[1] * r[1]) + (r[2] * r[2] + r[3] * r[3]);
        const float rstd = 1.0f / sqrtf(grp_sum<16>(ss) * (1.f / 192) + EPS);
#pragma unroll
        for (int j = 0; j < 8; ++j) o[j] = v[j] * rstd * g_q[8 * ll + j];
        float nr[4], pr_[4];
#pragma unroll
        for (int j = 0; j < 4; ++j) nr[j] = r[j] * rstd * g_q[128 + 4 * ll + j];
#pragma unroll
        for (int j = 0; j < 4; ++j) pr_[j] = __shfl_xor(nr[j], 8);
#pragma unroll
        for (int j = 0; j < 4; ++j) { const f32x2 cs = tm[s * 32 + 4 * (ll & 7) + j]; ro[j] = (ll & 8) ? (nr[j] * cs.x + pr_[j] * cs.y) : (nr[j] * cs.x - pr_[j] * cs.y); }
        bf16* qo = QA + ((size_t)(b * 8 + h) * SEQ + s) * 192; st8(qo + 8 * ll, o); st4(qo + 128 + 4 * ll, ro); }
      {
        const bf16* kv = KVR + (size_t)t * 2048 + h * 256; float v[8], o[8];
        ld8(kv + 8 * ll, v);
        const float rstd = 1.0f / sqrtf(grp_sum<16>(sumsq8(v)) * (1.f / 128) + EPS);
#pragma unroll
        for (int j = 0; j < 8; ++j) o[j] = v[j] * rstd * g_kn[8 * ll + j];
        bf16* ko = KA + ((size_t)(b * 8 + h) * SEQ + s) * 192; st8(ko + 8 * ll, o);
        *(v2u*)(ko + 128 + 4 * ll) = *(const v2u*)(KR + (size_t)t * 64 + 4 * ll);
        *(v4u*)(VA + ((size_t)(b * 8 + h) * SEQ + s) * 128 + 8 * ll) = *(const v4u*)(kv + 128 + 8 * ll); }
    }
  }
}
__device__ __forceinline__ void post_qkv(const Ctx& c, const Args& a) {
  unsigned char* ws = c.ws; const int l = c.lane, hl = l >> 3, ll = l & 7;
  const bf16* QKV = (const bf16*)(ws + WS_PROJ);
  bf16* SQ = (bf16*)(ws + WS_SQ); bf16* SK = (bf16*)(ws + WS_SK); bf16* SV = (bf16*)(ws + WS_SV);
  const f32x2* tsw = (const f32x2*)(ws + WS_TSWA);
  const float* g_q = a.in[15]; const float* g_k = a.in[16];
  for (int t = c.gw; t < T; t += c.NGW) {
    const int b = t / SEQ, s = t % SEQ; const bf16* pr = QKV + (size_t)t * ODD_IN;
#pragma unroll
    for (int pass = 0; pass < 5; ++pass) {
      float v[8], o[8], nv[8], pv_[8];
      ld8(pr + pass * 512 + 8 * l, v);
      const float rstd = 1.0f / sqrtf(grp_sum<8>(sumsq8(v)) * (1.f / 64) + EPS);
      const float* g = (pass < 4) ? g_q : g_k;
#pragma unroll
      for (int j = 0; j < 8; ++j) nv[j] = v[j] * rstd * g[8 * ll + j];
#pragma unroll
      for (int j = 0; j < 8; ++j) pv_[j] = __shfl_xor(nv[j], 1);
#pragma unroll
      for (int j = 0; j < 8; ++j) { const f32x2 cs = tsw[s * 8 + j]; o[j] = (ll >= 2) ? nv[j] : ((ll & 1) ? (nv[j] * cs.x + pv_[j] * cs.y) : (nv[j] * cs.x - pv_[j] * cs.y)); }
      if (pass < 4) st8(SQ + ((size_t)(b * 32 + pass * 8 + hl) * SEQ + s) * 64 + 8 * ll, o);
      else if (hl < 4) st8(SK + ((size_t)(b * 4 + hl) * SEQ + s) * 64 + 8 * ll, o);
      else st8(SV + ((size_t)(b * 4 + (hl - 4)) * SEQ + s) * 64 + 8 * ll, v);
    }
  }
}

#ifdef NO_GEMM
#define GEMM_PHASE(EPI_T, epi, Aoff, Boff, N_, K_) do { (void)(epi); } while (0)
#else
#define GEMM_PHASE(EPI_T, epi, Aoff, Boff, N_, K_) do { \
    pg8::Gemm g_{(const pg8::bf16_t*)(ws + (Aoff)), (const pg8::bf16_t*)(ws + (Boff)), T, (N_), (K_)}; pg8::StaticOrder S_; S_.init(T, (N_), c.G, (int)blockIdx.x); \
    pg8::gemm_phase<EPI_T, pg8::StaticOrder, true, true>(ldsl, g_, S_, (epi)); } while (0)
#endif

#ifndef STAG_TICKS
#define STAG_TICKS 0
#endif
#define STAGGER() do { if (STAG_TICKS > 0) { const unsigned long long t0_ = __builtin_amdgcn_s_memrealtime(); const unsigned long long d_ = (unsigned long long)((blockIdx.x >> 3) & 3) * STAG_TICKS; \
    while (__builtin_amdgcn_s_memrealtime() - t0_ < d_) __builtin_amdgcn_s_sleep(8); } } while (0)
#ifndef REP_THIN2
#define REP_THIN2 1
#endif
#ifndef REP_THIN3
#define REP_THIN3 1
#endif
#ifndef REP_SWA
#define REP_SWA 1
#endif
#ifndef REP_PRO
#define REP_PRO 1
#endif
#ifndef REP_THIN
#define REP_THIN 1
#endif
#ifndef REP_MLA
#define REP_MLA 1
#endif
#ifndef REP_GQA
#define REP_GQA 1
#endif
#ifndef REP_UP
#define REP_UP 1
#endif
__global__ void __launch_bounds__(NWAVES * 64, 2) fwd_megakernel(Args a) {
  extern __shared__ __attribute__((aligned(16))) unsigned char lds[];
#ifdef NO_SYNC
  struct { __device__ void sync() const { __syncthreads(); } } grid;
#else
  cg::grid_group grid = cg::this_grid();
#endif
  LAS unsigned char* ldsl = (LAS unsigned char*)lds;
#define MKCTX() do { int t_ = threadIdx.x; asm volatile("" : "+v"(t_)); c.lane = t_ & 63; c.wave = __builtin_amdgcn_readfirstlane(t_ >> 6); c.G = gridDim.x; \
    { const int bx = blockIdx.x; c.vcu = (c.G % 8 == 0) ? (bx % 8) * (c.G / 8) + bx / 8 : bx; } \
    c.gw = blockIdx.x * NWAVES + c.wave; c.NGW = c.G * NWAVES; c.ws = a.ws; } while (0)
  Ctx c; MKCTX();
  volatile LAS unsigned* bst = (volatile LAS unsigned*)(ldsl + 131072 + 512);
  if (threadIdx.x < 2) bst[threadIdx.x] = 0u;
  __syncthreads();
  XcdBarrier xbar = xcd_barrier_post((unsigned*)a.ws, bst);
#ifdef USE_CG_ALL
#define SEAM() do { grid.sync(); MKCTX(); } while (0)
#else
#define SEAM() do { xcd_barrier(xbar); MKCTX(); } while (0)
#endif
  unsigned char* ws = a.ws;
  float* X = a.out; float* RSS = (float*)(a.ws + WS_ROWSS);

#ifndef NO_PRO
  prologue(c, a, ldsl);

#endif
  grid.sync(); MKCTX();
  { pg8::EpiB<0> E{(pg8::bf16_t*)(ws + WS_PROJ), EVEN_IN_P, nullptr, 0.f, 0.f}; GEMM_PHASE(pg8::EpiB<0>, E, WS_XN, WS_WIN, EVEN_IN_P, DM); }
#ifndef NO_PRO
  MKCTX(); convert_dynamic<1>((unsigned*)(ws + WS_CNT), c.wave, c.lane, a, ws, ldsl);
#endif
  SEAM();
#ifndef NO_POST
  for (int rep = 0; rep < REP_THIN; ++rep) { MKCTX(); post_proj(c, a); }
#endif
  SEAM();
  { pg8::EpiB<0> E{(pg8::bf16_t*)(ws + WS_QAR), 1536, nullptr, 0.f, 0.f}; GEMM_PHASE(pg8::EpiB<0>, E, WS_CQN, WS_WUQ, 1536, 512); }
  { typedef pg8::EpiKV<WS_KA, WS_VA, WS_KR, EST_OFF, 13> EKV; EKV E{ws, a.in[8], ldsl, EPS};
    pg8::Gemm g_{(const pg8::bf16_t*)(ws + WS_CKVN), (const pg8::bf16_t*)(ws + WS_WUKV), T, 2048, 256}; pg8::StaticOrder S_; S_.init(T, 2048, c.G, (int)blockIdx.x);
    pg8::gemm_phase<EKV, pg8::StaticOrder, true, false>(ldsl, g_, S_, E); }
  SEAM();
  {
    constexpr float L2E = 1.4426950408889634f;
    const int nper = (512 + c.G - 1) / c.G;
    for (int rep = 0; rep < REP_MLA; ++rep)
    for (int i = 0; i < nper; ++i) {
      const int u = c.vcu * nper + i; if (u >= 512) break;
      int tid = threadIdx.x; asm volatile("" : "+v"(tid)); const int wid = tid >> 6, lane = tid & 63, r32 = lane & 31;
      const int bh = u >> 5, qb = u & 31, b = bh >> 3, h = bh & 7;
      const float sc = 0.07216878364870322f;
      const int qs = qb * 256 + wid * 32 + r32;
      const att::bf16* Q = (const att::bf16*)(ws + WS_QAR) + ((size_t)b * SEQ + qs) * 1536 + h * 192;
      const att::bf16* K = (const att::bf16*)(ws + WS_KA) + (size_t)bh * SEQ * 192;
      const att::bf16* V = (const att::bf16*)(ws + WS_VA) + (size_t)bh * SEQ * 128;
      att::bf16* O = (att::bf16*)(ws + WS_MRG0) + ((size_t)b * SEQ + qb * 256 + wid * 32) * 2048 + h * 128;
#ifndef NO_A192
      att::attn_unit<192, 128, false, false, 1, 1>(Q, K, V, O, 2048, 0, SEQ / 64, 0, SEQ, 0, -1e30f, 0.f, sc * L2E, 8.f / sc, (char*)lds, a.in[7], (const float*)(ws + WS_TMLA) + (size_t)qs * 64);
#endif
    }
    for (int rep = 0; rep < REP_GQA; ++rep)
    for (int i = 0; i < nper; ++i) {
      const int u = c.vcu * nper + i; if (u >= 512) break;
      int tid = threadIdx.x; asm volatile("" : "+v"(tid)); const int wid = tid >> 6, lane = tid & 63, r32 = lane & 31;
      const int bh = u >> 5, qb = u & 31, b = bh >> 3, h = bh & 7, kvh = h >> 2;
      const float sc = 0.08838834764831845f;
      const int qs = qb * 256 + wid * 32 + r32;
      const att::bf16* Q = (const att::bf16*)(ws + WS_PROJ) + ((size_t)b * SEQ + qs) * EVEN_IN_P + 832 + h * 128;
      const att::bf16* K = (const att::bf16*)(ws + WS_KG) + (size_t)(b * 2 + kvh) * SEQ * 128;
      const att::bf16* V = (const att::bf16*)(ws + WS_VG) + (size_t)(b * 2 + kvh) * SEQ * 128;
      att::bf16* O = (att::bf16*)(ws + WS_MRG0) + ((size_t)b * SEQ + qb * 256 + wid * 32) * 2048 + 1024 + h * 128;
#ifndef NO_A128
      att::attn_unit<128, 128, false, false, 2, 2>(Q, K, V, O, 2048, 0, SEQ / 64, 0, SEQ, 0, -1e30f, 0.f, sc * L2E, 8.f / sc, (char*)lds, a.in[10], (const float*)(ws + WS_TAX) + (size_t)qs * 128);
#endif
    }
  }
  SEAM();
  { pg8::EpiResN<false> E{a.in[0], (pg8::bf16_t*)(ws + WS_XN), RSS, DM, nullptr, 0.f, 0.f}; GEMM_PHASE(pg8::EpiResN<false>, E, WS_MRG0, WS_WOE, DM, DM); }
  SEAM();
  STAGGER();
  { pg8::EpiBL<2> E{(pg8::bf16_t*)(ws + WS_U), DFF, ldsl + EST_OFF}; GEMM_PHASE(pg8::EpiBL<2>, E, WS_XN, WS_WUP, DFF, DM); }
#if REP_UP > 1
#ifdef PROBE_NOEPI
  MKCTX(); { pg8::EpiNone E{}; GEMM_PHASE(pg8::EpiNone, E, WS_XN, WS_WUP, DFF, DM); }
#else
  MKCTX(); { pg8::EpiBL<2> E{(pg8::bf16_t*)(ws + WS_U), DFF, ldsl + EST_OFF}; GEMM_PHASE(pg8::EpiBL<2>, E, WS_XN, WS_WUP, DFF, DM); }
#endif
#endif
#if REP_UP > 2
#ifdef PROBE_NOEPI
  MKCTX(); { pg8::EpiNone E{}; GEMM_PHASE(pg8::EpiNone, E, WS_XN, WS_WUP, DFF, DM); }
#else
  MKCTX(); { pg8::EpiBL<2> E{(pg8::bf16_t*)(ws + WS_U), DFF, ldsl + EST_OFF}; GEMM_PHASE(pg8::EpiBL<2>, E, WS_XN, WS_WUP, DFF, DM); }
#endif
#endif
  SEAM();
#ifdef REP_DN
  { pg8::EpiB<0> E{(pg8::bf16_t*)(ws + AB + 256 * MiB), DM, nullptr, 0.f, 0.f}; GEMM_PHASE(pg8::EpiB<0>, E, WS_U, WS_WDN, DM, DFF); } MKCTX();
#endif
  { pg8::EpiResN<true> E{ws + WS_XN, (pg8::bf16_t*)(ws + WS_XN), RSS + T, DM, RSS, 1.f / DM, EPS}; GEMM_PHASE(pg8::EpiResN<true>, E, WS_U, WS_WDN, DM, DFF); }
  SEAM();
  { pg8::EpiQKV E{(pg8::bf16_t*)(ws + WS_SQ), (long)((WS_SK - WS_SQ) / 2), (long)((WS_SV - WS_SQ) / 2), RSS + T, 1.f / DM, EPS, a.in[15], a.in[16], (const float*)(ws + WS_TSWA), 13};
    GEMM_PHASE(pg8::EpiQKV, E, WS_XN, WS_WQKV, ODD_IN, DM); }
#ifndef NO_PRO
  MKCTX(); convert_dynamic<2>((unsigned*)(ws + WS_CNT) + 64, c.wave, c.lane, a, ws, ldsl);
#endif
  SEAM();
  {
    constexpr float L2E = 1.4426950408889634f; const float sc = 0.125f;
    const int nper = (1024 + c.G - 1) / c.G;
    for (int rep = 0; rep < REP_SWA; ++rep)
    for (int i = 0; i < nper; ++i) {
      const int u = c.vcu * nper + i; if (u >= 1024) break;
      int tid = threadIdx.x; asm volatile("" : "+v"(tid)); const int wid = tid >> 6, lane = tid & 63, r32 = lane & 31;
      const int b = u >> 9, kvh = (u >> 7) & 3, rb = u & 127, h = kvh * 8 + wid;
      const att::bf16* Q = (const att::bf16*)(ws + WS_SQ) + ((size_t)(b * 32 + h) * SEQ + rb * 64 + r32) * 64;
      const att::bf16* K = (const att::bf16*)(ws + WS_SK) + (size_t)(b * 4 + kvh) * SEQ * 64;
      const att::bf16* V = (const att::bf16*)(ws + WS_SV) + (size_t)(b * 4 + kvh) * SEQ * 64;
      att::bf16* O = (att::bf16*)(ws + WS_MRG) + ((size_t)b * SEQ + rb * 64) * 2048 + h * 64;
      const float sink = a.in[17][h];
#ifndef NO_A64
      att::swa_unit<5, 2>(Q, K, V, O, 2048, rb * 64 - 128, rb * 64 + r32, SEQ, 128, sink / sc, sc * L2E, 8.f / sc, (char*)lds);
#endif
    }
  }
  SEAM();
  { pg8::EpiResN<true> E{ws + WS_XN, (pg8::bf16_t*)(ws + WS_XN), RSS + 2 * T, DM, nullptr, 0.f, 0.f}; GEMM_PHASE(pg8::EpiResN<true>, E, WS_MRG, WS_WOO, DM, DM); }
  SEAM();
  STAGGER();
  { pg8::EpiBL<2> E{(pg8::bf16_t*)(ws + WS_U), DFF, ldsl + EST_OFF}; GEMM_PHASE(pg8::EpiBL<2>, E, WS_XN, WS_WUP, DFF, DM); }
#if REP_UP > 1
#ifdef PROBE_NOEPI
  MKCTX(); { pg8::EpiNone E{}; GEMM_PHASE(pg8::EpiNone, E, WS_XN, WS_WUP, DFF, DM); }
#else
  MKCTX(); { pg8::EpiBL<2> E{(pg8::bf16_t*)(ws + WS_U), DFF, ldsl + EST_OFF}; GEMM_PHASE(pg8::EpiBL<2>, E, WS_XN, WS_WUP, DFF, DM); }
#endif
#endif
#if REP_UP > 2
#ifdef PROBE_NOEPI
  MKCTX(); { pg8::EpiNone E{}; GEMM_PHASE(pg8::EpiNone, E, WS_XN, WS_WUP, DFF, DM); }
#else
  MKCTX(); { pg8::EpiBL<2> E{(pg8::bf16_t*)(ws + WS_U), DFF, ldsl + EST_OFF}; GEMM_PHASE(pg8::EpiBL<2>, E, WS_XN, WS_WUP, DFF, DM); }
#endif
#endif
  SEAM();
#ifdef REP_DN
  { pg8::EpiB<0> E{(pg8::bf16_t*)(ws + AB + 256 * MiB), DM, nullptr, 0.f, 0.f}; GEMM_PHASE(pg8::EpiB<0>, E, WS_U, WS_WDN, DM, DFF); } MKCTX();
#endif
  { pg8::EpiRes<true> E{ws + WS_XN, X, DM, RSS + 2 * T, 1.f / DM, EPS}; GEMM_PHASE(pg8::EpiRes<true>, E, WS_U, WS_WDN, DM, DFF); }
}

#ifdef PROBE_PRO_KERNEL
__global__ void __launch_bounds__(NWAVES * 64, 2) probe_prologue(Args a) {
  extern __shared__ __attribute__((aligned(16))) unsigned char lds[];
  LAS unsigned char* ldsl = (LAS unsigned char*)lds;
  Ctx c; { int t_ = threadIdx.x; c.lane = t_ & 63; c.wave = __builtin_amdgcn_readfirstlane(t_ >> 6); c.G = gridDim.x; c.vcu = blockIdx.x; c.gw = blockIdx.x * NWAVES + c.wave; c.NGW = c.G * NWAVES; c.ws = a.ws; }
  prologue(c, a, ldsl);
}
#endif
extern "C" void kernel_launch(void* const* d_in, const int* in_sizes, int n_in, void* d_out, int out_size, void* d_ws, size_t ws_size, hipStream_t stream) {
  static int grid = 0;
  if (grid == 0) {
    if (n_in != 22 || out_size != T * DM || ws_size < WS_NEED) { fprintf(stderr, "kernel_launch: unexpected shapes: n_in %d out %d ws %zu (need %zu)\n", n_in, out_size, ws_size, (size_t)WS_NEED); grid = -1; return; }
    int dev = 0, cus = 0, per_cu = 0;
    (void)hipGetDevice(&dev); (void)hipDeviceGetAttribute(&cus, hipDeviceAttributeMultiprocessorCount, dev);
    if (LDS_BYTES > 0 && hipFuncSetAttribute((const void*)fwd_megakernel, hipFuncAttributeMaxDynamicSharedMemorySize, LDS_BYTES) != hipSuccess) { fprintf(stderr, "kernel_launch: hipFuncSetAttribute failed\n"); grid = -1; return; }
    if (hipOccupancyMaxActiveBlocksPerMultiprocessor(&per_cu, (const void*)fwd_megakernel, NWAVES * 64, LDS_BYTES) != hipSuccess || per_cu < 1) { fprintf(stderr, "kernel_launch: occupancy query says %d\n", per_cu); per_cu = 1; }
    (void)hipGetLastError();
    grid = cus * 1;
    fprintf(stderr, "kernel_launch: grid %d (cus %d, per_cu %d)\n", grid, cus, per_cu);
  }
  if (grid < 0) return;
  Args a; memset(&a, 0, sizeof(a));
  for (int i = 0; i < 22; ++i) a.in[i] = (const float*)d_in[i];
  a.out = (float*)d_out; a.ws = (unsigned char*)d_ws;
  for (int f = 0; f < 32; ++f) { a.inv_mla[f] = (float)pow((double)500000.0f, -(double)(2 * f) / 64.0); a.inv_ax[f] = (float)pow((double)10000.0f, -(double)(2 * f) / 64.0); }
  for (int f = 0; f < 8; ++f) a.inv_swa[f] = (float)pow((double)500000.0f, -(double)(2 * f) / 16.0);
  if (hipMemsetAsync(d_ws, 0, 512 * 1024, stream) != hipSuccess) { fprintf(stderr, "kernel_launch: memset failed\n"); return; }
#ifdef PROBE_PRO_KERNEL
  (void)hipFuncSetAttribute((const void*)probe_prologue, hipFuncAttributeMaxDynamicSharedMemorySize, LDS_BYTES);
  hipLaunchKernelGGL(probe_prologue, dim3(grid), dim3(NWAVES * 64), LDS_BYTES, stream, a);
#endif
  void* args[] = {&a};
#ifdef PROBE_PLAIN
  hipLaunchKernelGGL(fwd_megakernel, dim3(grid), dim3(NWAVES * 64), LDS_BYTES, stream, a); hipError_t e = hipPeekAtLastError();
#else
  hipError_t e = hipLaunchCooperativeKernel((const void*)fwd_megakernel, dim3(grid), dim3(NWAVES * 64), args, LDS_BYTES, stream);
#endif
  if (e != hipSuccess) fprintf(stderr, "kernel_launch: cooperative launch failed: %s (grid %d)\n", hipGetErrorString(e), grid);
}
```

```cpp
#include <hip/hip_runtime.h>
#include <hip/hip_cooperative_groups.h>
#include <cstdio>
#include <cstdint>
#include <cmath>
#include <cstring>
namespace cg = cooperative_groups;

namespace pg8 {
#define PG8_LAS __attribute__((address_space(3)))
typedef unsigned short bf16_t;
typedef short bf16x8 __attribute__((ext_vector_type(8)));
typedef float f32x4 __attribute__((ext_vector_type(4)));
typedef unsigned u32x4 __attribute__((ext_vector_type(4)));
constexpr int BM = 256, BK = 64, HALF = 128, HTB = HALF * BK * 2  , STAGE_BYTES = 8 * HTB, NXCD = 8, WGM = 8;

__host__ __device__ __forceinline__ int lds_byte(int r, int c) { const int st = (r >> 4) * 2 + (c >> 5), rr = r & 15, cc = c & 31, ob = rr * 64 + cc * 2; return st * 1024 + (ob ^ (((ob >> 9) & 1) << 5)); }
__host__ __device__ __forceinline__ void stage_rc(int b, int& R, int& C) { const int st = b / 1024, sb = b % 1024, swz = sb ^ (((sb >> 9) & 1) << 5); R = (st >> 1) * 16 + swz / 64; C = (st & 1) * 32 + (swz % 64) / 2; }
__host__ __device__ __forceinline__ int perm32(int rho) { const int n = rho >> 4, i = rho & 15; return 8 * (i >> 2) + 4 * n + (i & 3); }

struct Unit { int pm, pn; };
struct Gemm { const bf16_t* A; const bf16_t* Bt; int M, N, K; };

struct StaticOrder {
    int nM, nN, nwg, G, c;
    __host__ __device__ void init(int M, int N, int G_, int c_) { nM = M / BM; nN = N / BM; nwg = nM * nN; G = G_; c = c_; }
    __host__ __device__ bool next(int i, Unit& u) const {
        const long L = (long)i * G + c; if (L >= nwg) return false;
        int wgid = (int)L; { const int q = nwg / NXCD, r = nwg % NXCD, xcd = wgid % NXCD, off = wgid / NXCD; wgid = (xcd < r ? xcd * (q + 1) : r * (q + 1) + (xcd - r) * q) + off; }
        const int nig = WGM * nN, gid = wgid / nig, fm = gid * WGM, gsz = (nM - fm) < WGM ? (nM - fm) : WGM;
        u.pm = fm + ((wgid % nig) % gsz); u.pn = (wgid % nig) / gsz; return true;
    }
    __device__ __forceinline__ void a_ready(const Unit&) const {}
    __device__ __forceinline__ void done(const Unit&) const {}
};
__device__ __forceinline__ unsigned cvt_pk_bf16(float lo, float hi) { unsigned r; asm volatile("v_cvt_pk_bf16_f32 %0, %1, %2" : "=v"(r) : "v"(lo), "v"(hi)); return r; }
typedef float f32x2 __attribute__((ext_vector_type(2)));
__device__ __forceinline__ f32x2 gelu_pk(f32x2 v) {
    const f32x2 av = __builtin_elementwise_abs(v), d = av * 0.2316418882f + 1.0f;
    f32x2 t; t.x = __builtin_amdgcn_rcpf(d.x); t.y = __builtin_amdgcn_rcpf(d.y);
    f32x2 q = t * 0.5307027145f + (-0.7265760135f); q = q * t + 0.7107068705f; q = q * t + (-0.142248368f); q = q * t + 0.127414796f; q = q * t;
    const f32x2 s = (v * v) * (-0.72134752044f);
    f32x2 e; e.x = __builtin_amdgcn_exp2f(s.x); e.y = __builtin_amdgcn_exp2f(s.y);
    const f32x2 m = v * (q * e), r = v - m;
    f32x2 o; o.x = v.x < 0.f ? m.x : r.x; o.y = v.y < 0.f ? m.y : r.y; return o;
}

template <int ACT  > struct EpiBf16 {
    static constexpr bool PERM = true, AFTER_DRAIN = false; static_assert(ACT == 0 || ACT == 1, "EpiBf16: ACT is 0 (none) or 1 (gelu_pk)");
    bf16_t* O; int ldc; const float* bias; int split_cols; size_t split_stride; float scale0;
    __device__ __forceinline__ void operator()(const f32x4 (&acc)[2][2][4][2], const Unit& u, int wr, int wc, int fr, int fq) const {
        const int row0 = u.pm * BM + wr * 64 + fr; int colt = u.pn * BM; bf16_t* base = O;
        float sc = 1.f; if (split_cols) { const int t = colt / split_cols; base += (size_t)t * split_stride; colt -= t * split_cols; if (t == 0) sc = scale0; }
        const int col0 = colt + wc * 32 + 8 * fq, bcol0 = u.pn * BM + wc * 32 + 8 * fq;
        f32x4 bv[2][2];
#pragma unroll
        for (int bj = 0; bj < 2; ++bj)
#pragma unroll
            for (int n = 0; n < 2; ++n) bv[bj][n] = bias ? *(const f32x4*)(bias + bcol0 + bj * HALF + 4 * n) : (f32x4){0.f, 0.f, 0.f, 0.f};
#pragma unroll
        for (int ai = 0; ai < 2; ++ai)
#pragma unroll
            for (int m = 0; m < 4; ++m) { bf16_t* rowp = base + (size_t)(row0 + ai * HALF + m * 16) * ldc + col0;
#pragma unroll
                for (int bj = 0; bj < 2; ++bj) { f32x4 v0 = acc[ai][bj][m][0] + bv[bj][0], v1 = acc[ai][bj][m][1] + bv[bj][1];
                    if (ACT == 1) { f32x2 a = gelu_pk((f32x2){v0[0], v0[1]}), b = gelu_pk((f32x2){v0[2], v0[3]}), c = gelu_pk((f32x2){v1[0], v1[1]}), d = gelu_pk((f32x2){v1[2], v1[3]});
                        v0 = (f32x4){a.x, a.y, b.x, b.y}; v1 = (f32x4){c.x, c.y, d.x, d.y}; }
                    v0 = v0 * sc; v1 = v1 * sc; u32x4 w; w.x = cvt_pk_bf16(v0[0], v0[1]); w.y = cvt_pk_bf16(v0[2], v0[3]); w.z = cvt_pk_bf16(v1[0], v1[1]); w.w = cvt_pk_bf16(v1[2], v1[3]);
                    *(u32x4*)(rowp + bj * HALF) = w; } }
    }
};

template <int ACT  > struct EpiB {
    static constexpr bool PERM = true, AFTER_DRAIN = false;
    bf16_t* O; int ldc; const float* rowss; float inv_n, eps;
    __device__ __forceinline__ void operator()(const f32x4 (&acc)[2][2][4][2], const Unit& u, int wr, int wc, int fr, int fq) const {
        const int row0 = u.pm * BM + wr * 64 + fr; const int col0 = u.pn * BM + wc * 32 + 8 * fq;
#pragma unroll
        for (int ai = 0; ai < 2; ++ai)
#pragma unroll
            for (int m = 0; m < 4; ++m) { bf16_t* rowp = O + (size_t)(row0 + ai * HALF + m * 16) * ldc + col0;
                const float rs = rowss ? 1.0f / sqrtf(rowss[row0 + ai * HALF + m * 16] * inv_n + eps) : 1.0f;
#pragma unroll
                for (int bj = 0; bj < 2; ++bj) { f32x4 v0 = acc[ai][bj][m][0] * rs, v1 = acc[ai][bj][m][1] * rs;
                    if (ACT == 2) {
#pragma unroll
                        for (int e = 0; e < 4; ++e) { float a = fmaxf(v0[e], 0.f), b = fmaxf(v1[e], 0.f); v0[e] = a * a; v1[e] = b * b; } }
                    u32x4 w; w.x = cvt_pk_bf16(v0[0], v0[1]); w.y = cvt_pk_bf16(v0[2], v0[3]); w.z = cvt_pk_bf16(v1[0], v1[1]); w.w = cvt_pk_bf16(v1[2], v1[3]);
                    *(u32x4*)(rowp + bj * HALF) = w; } }
    }
};
template <bool BASEBF> struct EpiRes {
    static constexpr bool PERM = true, AFTER_DRAIN = false;
    const void* base; float* out; int ldc; const float* sc_ss; float sc_inv_n, sc_eps;
    __device__ __forceinline__ void operator()(const f32x4 (&acc)[2][2][4][2], const Unit& u, int wr, int wc, int fr, int fq) const {
        const int row0 = u.pm * BM + wr * 64 + fr; const int col0 = u.pn * BM + wc * 32 + 8 * fq;
#pragma unroll
        for (int ai = 0; ai < 2; ++ai)
#pragma unroll
            for (int m = 0; m < 4; ++m) { const size_t off = (size_t)(row0 + ai * HALF + m * 16) * ldc + col0;
                const float sc = sc_ss ? 1.0f / (sc_ss[row0 + ai * HALF + m * 16] * sc_inv_n + sc_eps) : 1.0f;
#pragma unroll
                for (int bj = 0; bj < 2; ++bj) { f32x4 b0, b1;
                    if (BASEBF) { const u32x4 w = *(const u32x4*)((const bf16_t*)base + off + bj * HALF);
                        b0 = (f32x4){__uint_as_float(w.x << 16), __uint_as_float(w.x & 0xffff0000u), __uint_as_float(w.y << 16), __uint_as_float(w.y & 0xffff0000u)};
                        b1 = (f32x4){__uint_as_float(w.z << 16), __uint_as_float(w.z & 0xffff0000u), __uint_as_float(w.w << 16), __uint_as_float(w.w & 0xffff0000u)}; }
                    else { b0 = *(const f32x4*)((const float*)base + off + bj * HALF); b1 = *(const f32x4*)((const float*)base + off + bj * HALF + 4); }
                    *(f32x4*)(out + off + bj * HALF) = b0 + acc[ai][bj][m][0] * sc; *(f32x4*)(out + off + bj * HALF + 4) = b1 + acc[ai][bj][m][1] * sc; } }
    }
};
template <bool BASEBF> struct EpiResN {
    static constexpr bool PERM = true, AFTER_DRAIN = false;
    const void* base; bf16_t* xn; float* rowss; int ldc; const float* sc_ss; float sc_inv_n, sc_eps;
    __device__ __forceinline__ void operator()(const f32x4 (&acc)[2][2][4][2], const Unit& u, int wr, int wc, int fr, int fq) const {
        const int row0 = u.pm * BM + wr * 64 + fr; const int col0 = u.pn * BM + wc * 32 + 8 * fq;
#pragma unroll
        for (int ai = 0; ai < 2; ++ai)
#pragma unroll
            for (int m = 0; m < 4; ++m) { const int row = row0 + ai * HALF + m * 16; const size_t off = (size_t)row * ldc + col0; float ss = 0.f;
                const float sc = sc_ss ? 1.0f / (sc_ss[row] * sc_inv_n + sc_eps) : 1.0f;
#pragma unroll
                for (int bj = 0; bj < 2; ++bj) { f32x4 b0, b1;
                    if (BASEBF) { const u32x4 w = *(const u32x4*)((const bf16_t*)base + off + bj * HALF);
                        b0 = (f32x4){__uint_as_float(w.x << 16), __uint_as_float(w.x & 0xffff0000u), __uint_as_float(w.y << 16), __uint_as_float(w.y & 0xffff0000u)};
                        b1 = (f32x4){__uint_as_float(w.z << 16), __uint_as_float(w.z & 0xffff0000u), __uint_as_float(w.w << 16), __uint_as_float(w.w & 0xffff0000u)}; }
                    else { b0 = *(const f32x4*)((const float*)base + off + bj * HALF); b1 = *(const f32x4*)((const float*)base + off + bj * HALF + 4); }
                    const f32x4 o0 = b0 + acc[ai][bj][m][0] * sc, o1 = b1 + acc[ai][bj][m][1] * sc;
                    ss += ((o0[0] * o0[0] + o0[1] * o0[1]) + (o0[2] * o0[2] + o0[3] * o0[3])) + ((o1[0] * o1[0] + o1[1] * o1[1]) + (o1[2] * o1[2] + o1[3] * o1[3]));
                    u32x4 w; w.x = cvt_pk_bf16(o0[0], o0[1]); w.y = cvt_pk_bf16(o0[2], o0[3]); w.z = cvt_pk_bf16(o1[0], o1[1]); w.w = cvt_pk_bf16(o1[2], o1[3]);
                    *(u32x4*)(xn + off + bj * HALF) = w; }
                ss += __shfl_xor(ss, 16); ss += __shfl_xor(ss, 32);
                if (fq == 0) atomicAdd(rowss + row, ss); }
    }
};
struct EpiNone {
    static constexpr bool PERM = true, AFTER_DRAIN = false;
    __device__ __forceinline__ void operator()(const f32x4 (&acc)[2][2][4][2], const Unit& u, int wr, int wc, int fr, int fq) const {
#pragma unroll
        for (int ai = 0; ai < 2; ++ai)
#pragma unroll
            for (int bj = 0; bj < 2; ++bj)
#pragma unroll
                for (int m = 0; m < 4; ++m)
#pragma unroll
                    for (int n = 0; n < 2; ++n) asm volatile("" :: "v"(acc[ai][bj][m][n]));
    }
};
template <int ACT> struct EpiBL {
    static constexpr bool PERM = true, AFTER_DRAIN = false;
    static constexpr int ROWB = 528;
    bf16_t* O; int ldc; PG8_LAS unsigned char* est;
    __device__ __forceinline__ void operator()(const f32x4 (&acc)[2][2][4][2], const Unit& u, int wr, int wc, int fr, int fq) const {
        const int tid = (wr * 4 + wc) * 64 + fq * 16 + fr;
        PG8_LAS unsigned char* wp = est + (wr * 16 + fr) * ROWB + (wc * 32 + 8 * fq) * 2;
        const int rr = tid >> 5, ch = tid & 31;
        const PG8_LAS unsigned char* rp = est + rr * ROWB + ch * 16;
        bf16_t* gbase = O + (size_t)(u.pm * BM) * ldc + u.pn * BM + ch * 8;
#pragma unroll
        for (int ai = 0; ai < 2; ++ai)
#pragma unroll
            for (int m = 0; m < 4; ++m) {
#pragma unroll
                for (int bj = 0; bj < 2; ++bj) { f32x4 v0 = acc[ai][bj][m][0], v1 = acc[ai][bj][m][1];
                    if (ACT == 2) {
#pragma unroll
                        for (int q = 0; q < 4; ++q) { float a = fmaxf(v0[q], 0.f), b = fmaxf(v1[q], 0.f); v0[q] = a * a; v1[q] = b * b; } }
                    u32x4 w; w.x = cvt_pk_bf16(v0[0], v0[1]); w.y = cvt_pk_bf16(v0[2], v0[3]); w.z = cvt_pk_bf16(v1[0], v1[1]); w.w = cvt_pk_bf16(v1[2], v1[3]);
                    *(PG8_LAS u32x4*)(wp + bj * 256) = w; }
                asm volatile("s_waitcnt lgkmcnt(0)" ::: "memory"); __builtin_amdgcn_s_barrier(); asm volatile("" ::: "memory");
#pragma unroll
                for (int p = 0; p < 2; ++p) { const int r = p * 16 + rr;
                    const u32x4 v = *(const PG8_LAS u32x4*)(rp + p * 16 * ROWB);
                    *(u32x4*)(gbase + (size_t)(ai * HALF + (r >> 4) * 64 + m * 16 + (r & 15)) * ldc) = v; }
                asm volatile("s_waitcnt lgkmcnt(0)" ::: "memory"); __builtin_amdgcn_s_barrier(); asm volatile("" ::: "memory");
            }
    }
};
struct EpiQKV {
    static constexpr bool PERM = true, AFTER_DRAIN = false;
    bf16_t* SQ; long k_off, v_off; const float* rowss; float inv_n, eps; const float *gq, *gk; const float* tsw; int seq_shift;
    __device__ __forceinline__ void operator()(const f32x4 (&acc)[2][2][4][2], const Unit& u, int wr, int wc, int fr, int fq) const {
        const int pn = u.pn; const bool isv = pn == 9, isk = pn == 8;
        const float* g = gq; if (isk) g = gk;
        const int seq = 1 << seq_shift;
        long boff = 0; if (isk) boff = k_off; if (isv) boff = v_off;
        bf16_t* base = SQ + boff; const int nh = (isv || isk) ? 4 : 32, h = (isv || isk) ? wc : pn * 4 + wc;
        const float sg = fq ? 1.f : -1.f;
#pragma unroll
        for (int ai = 0; ai < 2; ++ai)
#pragma unroll
            for (int m = 0; m < 4; ++m) { const int t = u.pm * BM + ai * HALF + wr * 64 + m * 16 + fr; const int b = t >> seq_shift, s = t & (seq - 1);
                const float rs = 1.0f / sqrtf(rowss[t] * inv_n + eps);
                f32x4 x00 = acc[ai][0][m][0] * rs, x01 = acc[ai][0][m][1] * rs, x10 = acc[ai][1][m][0] * rs, x11 = acc[ai][1][m][1] * rs;
                if (!isv) {
                    float ss = ((x00[0] * x00[0] + x00[1] * x00[1]) + (x00[2] * x00[2] + x00[3] * x00[3])) + ((x01[0] * x01[0] + x01[1] * x01[1]) + (x01[2] * x01[2] + x01[3] * x01[3]))
                             + ((x10[0] * x10[0] + x10[1] * x10[1]) + (x10[2] * x10[2] + x10[3] * x10[3])) + ((x11[0] * x11[0] + x11[1] * x11[1]) + (x11[2] * x11[2] + x11[3] * x11[3]));
                    ss += __shfl_xor(ss, 16); ss += __shfl_xor(ss, 32);
                    const float hr = 1.0f / sqrtf(ss * (1.f / 64) + eps);
                    x00 = x00 * hr * *(const f32x4*)(g + 8 * fq); x01 = x01 * hr * *(const f32x4*)(g + 8 * fq + 4); x10 = x10 * hr * *(const f32x4*)(g + 32 + 8 * fq); x11 = x11 * hr * *(const f32x4*)(g + 36 + 8 * fq);
                    f32x4 p0, p1;
#pragma unroll
                    for (int q = 0; q < 4; ++q) { p0[q] = __shfl_xor(x00[q], 16); p1[q] = __shfl_xor(x01[q], 16); }
                    if (fq < 2) { const f32x4* cs = (const f32x4*)(tsw + (size_t)s * 16); const f32x4 c0 = cs[0], c1 = cs[1], c2 = cs[2], c3 = cs[3];
                        x00 = (f32x4){x00[0] * c0[0] + sg * p0[0] * c0[1], x00[1] * c0[2] + sg * p0[1] * c0[3], x00[2] * c1[0] + sg * p0[2] * c1[1], x00[3] * c1[2] + sg * p0[3] * c1[3]};
                        x01 = (f32x4){x01[0] * c2[0] + sg * p1[0] * c2[1], x01[1] * c2[2] + sg * p1[1] * c2[3], x01[2] * c3[0] + sg * p1[2] * c3[1], x01[3] * c3[2] + sg * p1[3] * c3[3]}; }
                }
                bf16_t* dst = base + ((size_t)(b * nh + h) * seq + s) * 64 + 8 * fq;
                u32x4 w; w.x = cvt_pk_bf16(x00[0], x00[1]); w.y = cvt_pk_bf16(x00[2], x00[3]); w.z = cvt_pk_bf16(x01[0], x01[1]); w.w = cvt_pk_bf16(x01[2], x01[3]);
                *(u32x4*)dst = w;
                w.x = cvt_pk_bf16(x10[0], x10[1]); w.y = cvt_pk_bf16(x10[2], x10[3]); w.z = cvt_pk_bf16(x11[0], x11[1]); w.w = cvt_pk_bf16(x11[2], x11[3]);
                *(u32x4*)(dst + 32) = w;
                asm volatile("" ::: "memory"); }
    }
};
template <size_t KA_OFF, size_t VA_OFF, size_t RSS_OFF, int XCH_OFF, int SEQ_SHIFT> struct EpiKV {
    static constexpr bool PERM = true, AFTER_DRAIN = false;
    unsigned char* wsb; const float* gkn; PG8_LAS unsigned char* ldsb; float eps;
    __device__ __forceinline__ void operator()(const f32x4 (&acc)[2][2][4][2], const Unit& u, int wr, int wc, int fr, int fq) const {
        { int t_ = threadIdx.x; asm volatile("" : "+v"(t_)); fr = t_ & 15; fq = (t_ >> 4) & 3; }
        constexpr int seq_shift = SEQ_SHIFT; const int h = u.pn, seq = 1 << seq_shift;
        bf16_t* KA = (bf16_t*)(wsb + KA_OFF); bf16_t* VA = (bf16_t*)(wsb + VA_OFF); PG8_LAS float* xch = (PG8_LAS float*)(ldsb + XCH_OFF);
#pragma unroll
        for (int ai = 0; ai < 2; ++ai)
#pragma unroll
            for (int m = 0; m < 4; ++m) { const f32x4 a0 = acc[ai][0][m][0], a1 = acc[ai][0][m][1];
                const float rq = 1.0f / (((const float*)(wsb + RSS_OFF))[u.pm * BM + ai * HALF + wr * 64 + m * 16 + fr] * (1.f / 256) + eps);
                float ss = rq * (((a0[0] * a0[0] + a0[1] * a0[1]) + (a0[2] * a0[2] + a0[3] * a0[3])) + ((a1[0] * a1[0] + a1[1] * a1[1]) + (a1[2] * a1[2] + a1[3] * a1[3])));
                ss += __int_as_float(__builtin_amdgcn_ds_swizzle(__float_as_int(ss), 0x401F));
                { auto rr = __builtin_amdgcn_permlane32_swap(__float_as_uint(ss), __float_as_uint(ss), false, false); ss = __uint_as_float(rr[0]) + __uint_as_float(rr[1]); }
                if (fq == 0) xch[(ai * HALF + wr * 64 + m * 16 + fr) * 4 + wc] = ss; }
        asm volatile("s_waitcnt lgkmcnt(0)" ::: "memory"); __builtin_amdgcn_s_barrier(); asm volatile("" ::: "memory");
        const f32x4 g0 = *(const f32x4*)(gkn + wc * 32 + 8 * fq), g1 = *(const f32x4*)(gkn + wc * 32 + 8 * fq + 4);
#pragma unroll
        for (int ai = 0; ai < 2; ++ai)
#pragma unroll
            for (int m = 0; m < 4; ++m) { const int r = ai * HALF + wr * 64 + m * 16 + fr, t = u.pm * BM + r, b = t >> seq_shift, s = t & (seq - 1);
                const f32x4 p = *(const PG8_LAS f32x4*)(xch + r * 4);
                const float rs = 1.0f / sqrtf(((const float*)(wsb + RSS_OFF))[t] * (1.f / 256) + eps);
                const float rstd = rs / sqrtf(((p[0] + p[1]) + (p[2] + p[3])) * (1.f / 128) + eps);
                const f32x4 k0 = acc[ai][0][m][0] * rstd * g0, k1 = acc[ai][0][m][1] * rstd * g1, v0 = acc[ai][1][m][0] * rs, v1 = acc[ai][1][m][1] * rs;
                const size_t row = (size_t)(b * 8 + h) * seq + s;
                u32x4 w; w.x = cvt_pk_bf16(k0[0], k0[1]); w.y = cvt_pk_bf16(k0[2], k0[3]); w.z = cvt_pk_bf16(k1[0], k1[1]); w.w = cvt_pk_bf16(k1[2], k1[3]);
                *(u32x4*)(KA + row * 192 + wc * 32 + 8 * fq) = w;
                w.x = cvt_pk_bf16(v0[0], v0[1]); w.y = cvt_pk_bf16(v0[2], v0[3]); w.z = cvt_pk_bf16(v1[0], v1[1]); w.w = cvt_pk_bf16(v1[2], v1[3]);
                *(u32x4*)(VA + row * 128 + wc * 32 + 8 * fq) = w;
                asm volatile("" ::: "memory"); }
    }
};
template <size_t CQ_OFF, size_t CKV_OFF, size_t PROJ_OFF, size_t RSQ_OFF, size_t RSKV_OFF, int LDP> struct EpiP1 {
    static constexpr bool PERM = true, AFTER_DRAIN = false;
    unsigned char* wsb;
    __device__ __forceinline__ void operator()(const f32x4 (&acc)[2][2][4][2], const Unit& u, int wr, int wc, int fr, int fq) const {
        { int t_ = threadIdx.x; asm volatile("" : "+v"(t_)); fr = t_ & 15; fq = (t_ >> 4) & 3; }
        const int pn = u.pn;
        size_t boff = PROJ_OFF, roff = 0; int ldc = LDP, colt = pn * BM;
        if (pn < 2) { boff = CQ_OFF; roff = RSQ_OFF; ldc = 512; } else if (pn == 2) { boff = CKV_OFF; roff = RSKV_OFF; ldc = 256; colt = 0; }
        bf16_t* O = (bf16_t*)(wsb + boff); float* rss = (float*)(wsb + roff);
        const int row0 = u.pm * BM + wr * 64 + fr; const int col0 = colt + wc * 32 + 8 * fq;
#pragma unroll
        for (int ai = 0; ai < 2; ++ai)
#pragma unroll
            for (int m = 0; m < 4; ++m) { const int row = row0 + ai * HALF + m * 16; bf16_t* rowp = O + (size_t)row * ldc + col0; float ss = 0.f;
#pragma unroll
                for (int bj = 0; bj < 2; ++bj) { const f32x4 v0 = acc[ai][bj][m][0], v1 = acc[ai][bj][m][1];
                    ss += ((v0[0] * v0[0] + v0[1] * v0[1]) + (v0[2] * v0[2] + v0[3] * v0[3])) + ((v1[0] * v1[0] + v1[1] * v1[1]) + (v1[2] * v1[2] + v1[3] * v1[3]));
                    u32x4 w; w.x = cvt_pk_bf16(v0[0], v0[1]); w.y = cvt_pk_bf16(v0[2], v0[3]); w.z = cvt_pk_bf16(v1[0], v1[1]); w.w = cvt_pk_bf16(v1[2], v1[3]);
                    *(u32x4*)(rowp + bj * HALF) = w; }
                if (pn <= 2) { ss += __int_as_float(__builtin_amdgcn_ds_swizzle(__float_as_int(ss), 0x401F));
                    { auto rr = __builtin_amdgcn_permlane32_swap(__float_as_uint(ss), __float_as_uint(ss), false, false); ss = __uint_as_float(rr[0]) + __uint_as_float(rr[1]); }
                    if (fq == 0) atomicAdd(rss + row, ss); } }
    }
};

template <class Epi, class Sched, bool ALIGN_EPI = false, bool SP2 = false>
__device__ __forceinline__ void gemm_phase(PG8_LAS unsigned char* lds, const Gemm g, const Sched& S, const Epi& E) {
    int tid = threadIdx.x; asm volatile("" : "+v"(tid));
    const int wid = __builtin_amdgcn_readfirstlane(tid >> 6), lane = tid & 63, wr = wid >> 2, wc = wid & 3, fr = lane & 15, fq = lane >> 4;
    const int K = g.K, nt = K / BK;
    unsigned voffA[2], voffB[2];
#pragma unroll
    for (int i = 0; i < 2; ++i) { int R, C; stage_rc(tid * 16 + i * 8192, R, C); const int Rb = Epi::PERM ? ((R & ~31) + perm32(R & 31)) : R;
        voffA[i] = (unsigned)(R * K + C) * 2u; voffB[i] = (unsigned)(Rb * K + C) * 2u; }
    const size_t kstep = (size_t)(BK * 2);
    const size_t hstep = (size_t)HALF * K * 2;
    const size_t tstep = 2 * hstep;
    const unsigned ldsw = (unsigned)wid * 1024u;
    const int aoff = lds_byte(wr * 64 + fr, fq * 8), boff = lds_byte(wc * 32 + fr, fq * 8);
#define PG8_SA(b, h) (((b) * 2 + (h)) * HTB)
#define PG8_SB(b, h) ((4 + (b) * 2 + (h)) * HTB)
#define PG8_STAGE(bufoff, gbase, voff) do { _Pragma("unroll") for (int _i = 0; _i < 2; ++_i) \
        __builtin_amdgcn_global_load_lds((const unsigned*)((const char*)(gbase) + (voff)[_i]), (PG8_LAS unsigned*)(lds + (bufoff) + ldsw + _i * 8192), 16, 0, 0); } while (0)
#define PG8_LDA(dst, b, h) do { _Pragma("unroll") for (int m = 0; m < 4; ++m) _Pragma("unroll") for (int k = 0; k < 2; ++k) dst[m][k] = *(const PG8_LAS bf16x8*)(lds + PG8_SA(b, h) + aoff + m * 2048 + k * 1024); } while (0)
#define PG8_LDB(dst, b, h) do { _Pragma("unroll") for (int n = 0; n < 2; ++n) _Pragma("unroll") for (int k = 0; k < 2; ++k) dst[n][k] = *(const PG8_LAS bf16x8*)(lds + PG8_SB(b, h) + boff + n * 2048 + k * 1024); } while (0)
#define PG8_MMA(ai, bj, At, Bt) do { __builtin_amdgcn_s_setprio(1); _Pragma("unroll") for (int m = 0; m < 4; ++m) _Pragma("unroll") for (int n = 0; n < 2; ++n) _Pragma("unroll") for (int k = 0; k < 2; ++k) \
        acc[ai][bj][m][n] = __builtin_amdgcn_mfma_f32_16x16x32_bf16(Bt[n][k], At[m][k], acc[ai][bj][m][n], 0, 0, 0); __builtin_amdgcn_s_setprio(0); } while (0)
#define PG8_WAIT_V(n) asm volatile("s_waitcnt vmcnt(" #n ")" ::: "memory")
#define PG8_WAIT_L(n) asm volatile("s_waitcnt lgkmcnt(" #n ")" ::: "memory")
#define PG8_BAR __builtin_amdgcn_s_barrier()
#define PG8_SCHED __builtin_amdgcn_sched_barrier(0)
    Unit cur, nxt; int ui = 0;
    if (!S.next(0, cur)) return;
    f32x4 acc[2][2][4][2];
#pragma unroll
    for (int a = 0; a < 2; ++a)
#pragma unroll
        for (int b = 0; b < 2; ++b)
#pragma unroll
            for (int m = 0; m < 4; ++m)
#pragma unroll
                for (int n = 0; n < 2; ++n) acc[a][b][m][n] = (f32x4){0.f, 0.f, 0.f, 0.f};
    bf16x8 At[4][2], B0[2][2], B1[2][2];
    const char* cA = (const char*)g.A + (size_t)cur.pm * tstep; const char* cB = (const char*)g.Bt + (size_t)cur.pn * tstep;
    S.a_ready(cur);
    if constexpr (SP2) {
        PG8_STAGE(PG8_SB(0, 0), cB, voffB); PG8_STAGE(PG8_SB(0, 1), cB + hstep, voffB); PG8_STAGE(PG8_SA(0, 0), cA, voffA); PG8_STAGE(PG8_SA(0, 1), cA + hstep, voffA);
        if (wr == 1) PG8_BAR;
        PG8_WAIT_V(2); PG8_BAR;
        PG8_STAGE(PG8_SB(1, 0), cB + kstep, voffB); PG8_STAGE(PG8_SA(1, 0), cA + kstep, voffA); PG8_STAGE(PG8_SB(1, 1), cB + hstep + kstep, voffB);
        PG8_WAIT_V(6); PG8_BAR;
    } else {
        PG8_STAGE(PG8_SB(0, 0), cB, voffB); PG8_STAGE(PG8_SA(0, 0), cA, voffA); PG8_STAGE(PG8_SB(0, 1), cB + hstep, voffB); PG8_STAGE(PG8_SA(0, 1), cA + hstep, voffA);
        if (wr == 1) PG8_BAR;
        PG8_WAIT_V(4); PG8_BAR;
        PG8_STAGE(PG8_SB(1, 0), cB + kstep, voffB); PG8_STAGE(PG8_SA(1, 0), cA + kstep, voffA); PG8_STAGE(PG8_SB(1, 1), cB + hstep + kstep, voffB);
        PG8_WAIT_V(6); PG8_BAR;
    }
    for (;;) {
        const bool has_next = S.next(ui + 1, nxt);
        const char* nA = has_next ? (const char*)g.A + (size_t)nxt.pm * tstep : cA; const char* nB = has_next ? (const char*)g.Bt + (size_t)nxt.pn * tstep : cB;
        for (int t = 0; t < nt; t += 2) {
            const bool last = (t == nt - 2);
            const char* a1 = cA + (size_t)(t + 1) * kstep;
            const char* a2 = last ? nA : cA + (size_t)(t + 2) * kstep; const char* b2 = last ? nB : cB + (size_t)(t + 2) * kstep;
            const char* a3 = a2 + kstep; const char* b3 = b2 + kstep;
            if (last && has_next) S.a_ready(nxt);
            if constexpr (SP2) {
            PG8_LDB(B0, 0, 0); PG8_LDB(B1, 0, 1); PG8_SCHED; PG8_LDA(At, 0, 0); PG8_STAGE(PG8_SA(1, 1), a1 + hstep, voffA);
            PG8_WAIT_V(8); PG8_WAIT_L(0); PG8_BAR; PG8_MMA(0, 0, At, B0); PG8_MMA(0, 1, At, B1); PG8_BAR; PG8_SCHED;
            PG8_LDA(At, 0, 1); PG8_STAGE(PG8_SB(0, 0), b2, voffB); PG8_STAGE(PG8_SB(0, 1), b2 + hstep, voffB); PG8_STAGE(PG8_SA(0, 0), a2, voffA);
            PG8_WAIT_V(8); PG8_WAIT_L(0); PG8_BAR; PG8_MMA(1, 0, At, B0); PG8_MMA(1, 1, At, B1); PG8_BAR; PG8_SCHED;
            PG8_LDB(B0, 1, 0); PG8_LDB(B1, 1, 1); PG8_SCHED; PG8_LDA(At, 1, 0); PG8_STAGE(PG8_SA(0, 1), a2 + hstep, voffA);
            PG8_WAIT_V(8); PG8_WAIT_L(0); PG8_BAR; PG8_MMA(0, 0, At, B0); PG8_MMA(0, 1, At, B1); PG8_BAR; PG8_SCHED;
            PG8_LDA(At, 1, 1); PG8_STAGE(PG8_SB(1, 0), b3, voffB); PG8_STAGE(PG8_SB(1, 1), b3 + hstep, voffB); PG8_STAGE(PG8_SA(1, 0), a3, voffA);
            PG8_WAIT_V(8); PG8_WAIT_L(0); PG8_BAR; PG8_MMA(1, 0, At, B0); PG8_MMA(1, 1, At, B1); PG8_BAR; PG8_SCHED;
            } else {
            PG8_LDB(B0, 0, 0); PG8_SCHED; PG8_LDA(At, 0, 0); PG8_STAGE(PG8_SA(1, 1), a1 + hstep, voffA);
            PG8_WAIT_L(8); PG8_BAR; PG8_WAIT_L(0); PG8_MMA(0, 0, At, B0); PG8_BAR; PG8_SCHED;
            PG8_LDB(B1, 0, 1); PG8_STAGE(PG8_SB(0, 0), b2, voffB);
            PG8_BAR; PG8_WAIT_L(0); PG8_MMA(0, 1, At, B1); PG8_BAR;
            PG8_LDA(At, 0, 1); PG8_STAGE(PG8_SA(0, 0), a2, voffA);
            PG8_BAR; PG8_WAIT_L(0); PG8_MMA(1, 0, At, B0); PG8_BAR; PG8_SCHED;
            PG8_STAGE(PG8_SB(0, 1), b2 + hstep, voffB);
            PG8_WAIT_V(6); PG8_BAR; PG8_MMA(1, 1, At, B1); PG8_BAR;
            PG8_LDB(B0, 1, 0); PG8_SCHED; PG8_LDA(At, 1, 0); PG8_STAGE(PG8_SA(0, 1), a2 + hstep, voffA);
            PG8_WAIT_L(8); PG8_BAR; PG8_WAIT_L(0); PG8_MMA(0, 0, At, B0); PG8_BAR; PG8_SCHED;
            PG8_LDB(B1, 1, 1); PG8_STAGE(PG8_SB(1, 0), b3, voffB);
            PG8_BAR; PG8_WAIT_L(0); PG8_MMA(0, 1, At, B1); PG8_BAR;
            PG8_LDA(At, 1, 1); PG8_STAGE(PG8_SA(1, 0), a3, voffA);
            PG8_BAR; PG8_WAIT_L(0); PG8_MMA(1, 0, At, B0); PG8_BAR; PG8_SCHED;
            PG8_STAGE(PG8_SB(1, 1), b3 + hstep, voffB);
            PG8_WAIT_V(6); PG8_BAR; PG8_MMA(1, 1, At, B1); PG8_BAR;
            }
        }
        if constexpr (ALIGN_EPI) { if (wr == 0) PG8_BAR; }
        if constexpr (!Epi::AFTER_DRAIN) { E(acc, cur, wr, wc, fr, fq); S.done(cur); }
        if (!has_next) break;
#pragma unroll
        for (int a = 0; a < 2; ++a)
#pragma unroll
            for (int b = 0; b < 2; ++b)
#pragma unroll
                for (int m = 0; m < 4; ++m)
#pragma unroll
                    for (int n = 0; n < 2; ++n) acc[a][b][m][n] = (f32x4){0.f, 0.f, 0.f, 0.f};
        cur = nxt; cA = nA; cB = nB; ++ui;
        if constexpr (ALIGN_EPI) { if (wr == 1) PG8_BAR; }
    }
    PG8_WAIT_V(0);
    if constexpr (!ALIGN_EPI) { if (wr == 0) PG8_BAR; }
    PG8_BAR;
    if constexpr (Epi::AFTER_DRAIN) { E.fused(acc, cur, wr, wc, fr, fq, lds, wid, lane); S.done(cur); }
#undef PG8_SA
#undef PG8_SB
#undef PG8_STAGE
#undef PG8_LDA
#undef PG8_LDB
#undef PG8_MMA
#undef PG8_WAIT_V
#undef PG8_WAIT_L
#undef PG8_BAR
#undef PG8_SCHED
}
}

namespace att {
typedef unsigned short bf16;
using bf16x8 = __attribute__((ext_vector_type(8))) short;
using s16x4  = __attribute__((ext_vector_type(4))) short;
using f32x16 = __attribute__((ext_vector_type(16))) float;
using u32x4  = __attribute__((ext_vector_type(4))) unsigned;
constexpr int NW = 8, QBLK = 32, KVBLK = 64;
#define SBAR() __builtin_amdgcn_sched_barrier(0)
__device__ __forceinline__ int crow(int r, int hi) { return (r & 3) + 8 * (r >> 2) + 4 * hi; }
__device__ __forceinline__ unsigned cvtpk(float lo, float hi) { unsigned r; asm volatile("v_cvt_pk_bf16_f32 %0, %1, %2" : "=v"(r) : "v"(lo), "v"(hi)); return r; }
template <int DK> __device__ __forceinline__ int kswz(int row, int colB) { const int f = (DK == 128) ? ((row & 7) | ((row & 16) >> 1)) : ((row >> 1) & 7); return row * (DK * 2) + (colB ^ (f << 4)); }

__device__ __forceinline__ void partialSM(f32x16& p0, f32x16& p1, float& m_reg, float& mn, float& alpha, const float C, const float thr_raw) {
  float pmax = p0[0];
#pragma unroll
  for (int r = 1; r < 16; ++r) pmax = fmaxf(pmax, p0[r]);
#pragma unroll
  for (int r = 0; r < 16; ++r) pmax = fmaxf(pmax, p1[r]);
  { auto rr = __builtin_amdgcn_permlane32_swap(__float_as_uint(pmax), __float_as_uint(pmax), false, false);
    pmax = fmaxf(__uint_as_float(rr[0]), __uint_as_float(rr[1])); }
  if (__builtin_expect(__all(pmax - m_reg <= thr_raw), 1)) { mn = m_reg; alpha = 1.f; }
  else { mn = fmaxf(m_reg, pmax); alpha = __builtin_amdgcn_exp2f((m_reg - mn) * C); m_reg = mn; }
  float mnC = -mn * C;
#pragma unroll
  for (int r = 0; r < 16; ++r) p0[r] = fmaf(p0[r], C, mnC);
#pragma unroll
  for (int r = 0; r < 16; ++r) p1[r] = fmaf(p1[r], C, mnC);
#pragma unroll
  for (int r = 0; r < 16; ++r) p0[r] = __builtin_amdgcn_exp2f(p0[r]);
}
__device__ __forceinline__ void finishSM(f32x16& p0, f32x16& p1, float alpha, float& l_reg, bf16x8& pa0, bf16x8& pa1, bf16x8& pa2, bf16x8& pa3) {
#pragma unroll
  for (int r = 0; r < 16; ++r) p1[r] = __builtin_amdgcn_exp2f(p1[r]);
  float ps = 0;
#pragma unroll
  for (int r = 0; r < 16; ++r) ps += p0[r];
#pragma unroll
  for (int r = 0; r < 16; ++r) ps += p1[r];
  { auto rr = __builtin_amdgcn_permlane32_swap(__float_as_uint(ps), __float_as_uint(ps), false, false);
    ps = __uint_as_float(rr[0]) + __uint_as_float(rr[1]); }
  l_reg = l_reg * alpha + ps;
#define PK4(P, BASE, OUT) do { unsigned a0 = cvtpk(P[BASE + 0], P[BASE + 1]), a1 = cvtpk(P[BASE + 2], P[BASE + 3]);   \
    unsigned b0 = cvtpk(P[BASE + 4], P[BASE + 5]), b1 = cvtpk(P[BASE + 6], P[BASE + 7]);                              \
    auto r0 = __builtin_amdgcn_permlane32_swap(a0, b0, false, false); auto r1 = __builtin_amdgcn_permlane32_swap(a1, b1, false, false); \
    u32x4 w = {r0[0], r1[0], r0[1], r1[1]}; OUT = *reinterpret_cast<bf16x8*>(&w); } while (0)
  PK4(p0, 0, pa0); PK4(p0, 8, pa1); PK4(p1, 0, pa2); PK4(p1, 8, pa3);
#undef PK4
}
template <int DK, int GS> __device__ __forceinline__ void qkt(f32x16& p0, f32x16& p1, const char* Ks, const int (&kb)[4], const int (&kbx)[4], const bf16x8* qr) {
  constexpr int ND = DK / 16, NG = ND / GS;
  static_assert(ND % GS == 0, "group size");
  p0 = f32x16{}; p1 = f32x16{};
  bf16x8 fa[2][GS], fb[2][GS];
#define QK_RD(buf, g) do { _Pragma("unroll") for (int s_ = 0; s_ < GS; ++s_) { const int d0_ = (g) * GS + s_, e_ = d0_ & 3, gg_ = d0_ >> 2; \
      const int ko_ = (DK == 128) ? (gg_ ? kbx[e_] : kb[e_]) : (kb[e_] + gg_ * 128); \
      fa[buf][s_] = *reinterpret_cast<const bf16x8*>(Ks + ko_); fb[buf][s_] = *reinterpret_cast<const bf16x8*>(Ks + ko_ + 32 * DK * 2); } } while (0)
  QK_RD(0, 0);
#pragma unroll
  for (int g = 0; g < NG; ++g) {
    if (g + 1 < NG) { QK_RD((g + 1) & 1, g + 1); }
    SBAR();
#pragma unroll
    for (int s_ = 0; s_ < GS; ++s_) {
      p0 = __builtin_amdgcn_mfma_f32_32x32x16_bf16(fa[g & 1][s_], qr[g * GS + s_], p0, 0, 0, 0);
      p1 = __builtin_amdgcn_mfma_f32_32x32x16_bf16(fb[g & 1][s_], qr[g * GS + s_], p1, 0, 0, 0); }
    SBAR();
  }
#undef QK_RD
}
template <int NCB> __device__ __forceinline__ int v_st(int k, int c) { const int kk = (k & ~0xC) | ((k & 4) << 1) | ((k & 8) >> 1); return ((kk >> 3) * NCB + (c >> 5)) * 512 + ((kk & 7) * 32 + (c & 31)) * 2; }
__device__ __forceinline__ int v_rd_base(int lane) { return ((lane & 3) << 3) | (((lane >> 2) & 3) << 6) | (((lane >> 4) & 1) << 5) | (((lane >> 5) & 1) << 8); }
template <int OFF> __device__ __forceinline__ s16x4 tr_read(int vb) {
  s16x4 r; asm volatile("ds_read_b64_tr_b16 %0, %1 offset:%2" : "=&v"(r) : "v"(vb), "i"(OFF) : "memory"); return r;
}
template <int D0, int NCB> __device__ __forceinline__ void pv_one(f32x16& od, int vb, bf16x8 pa0, bf16x8 pa1, bf16x8 pa2, bf16x8 pa3) {
#define VOFF(ks, half) (D0 * 512 + (ks) * (1024 * NCB) + (half) * (512 * NCB))
  const s16x4 l0 = tr_read<VOFF(0, 0)>(vb), h0 = tr_read<VOFF(0, 1)>(vb), l1 = tr_read<VOFF(1, 0)>(vb), h1 = tr_read<VOFF(1, 1)>(vb);
  const s16x4 l2 = tr_read<VOFF(2, 0)>(vb), h2 = tr_read<VOFF(2, 1)>(vb), l3 = tr_read<VOFF(3, 0)>(vb), h3 = tr_read<VOFF(3, 1)>(vb);
#undef VOFF
  asm volatile("s_waitcnt lgkmcnt(0)" ::: "memory"); SBAR();
#define PK(L, H) (bf16x8){L[0], L[1], L[2], L[3], H[0], H[1], H[2], H[3]}
  od = __builtin_amdgcn_mfma_f32_32x32x16_bf16(pa0, PK(l0, h0), od, 0, 0, 0);
  od = __builtin_amdgcn_mfma_f32_32x32x16_bf16(pa1, PK(l1, h1), od, 0, 0, 0);
  od = __builtin_amdgcn_mfma_f32_32x32x16_bf16(pa2, PK(l2, h2), od, 0, 0, 0);
  od = __builtin_amdgcn_mfma_f32_32x32x16_bf16(pa3, PK(l3, h3), od, 0, 0, 0);
#undef PK
}
template <int NCB> __device__ __forceinline__ void pv_all(f32x16* o, int vb, bf16x8 pa0, bf16x8 pa1, bf16x8 pa2, bf16x8 pa3) {
  pv_one<0, NCB>(o[0], vb, pa0, pa1, pa2, pa3); pv_one<1, NCB>(o[1], vb, pa0, pa1, pa2, pa3);
  if constexpr (NCB == 4) { pv_one<2, NCB>(o[2], vb, pa0, pa1, pa2, pa3); pv_one<3, NCB>(o[3], vb, pa0, pa1, pa2, pa3); }
}

template <int DK, int DV, bool SWA, bool TWO, int GS, int QMODE = 0>
__device__ __forceinline__ void attn_unit(const bf16* __restrict__ Qrow, const bf16* __restrict__ Kh, const bf16* __restrict__ Vh, bf16* __restrict__ Ow, const int ldo,
                                          const int kstart, const int NT, const int qpos, const int seq, const int win,
                                          const float m_init, const float l_init, const float C, const float thr_raw, char* lds,
                                          const float* __restrict__ mq_gain = nullptr, const float* __restrict__ mq_tm = nullptr) {
  constexpr int NCB = DV / 32, SHM_V = KVBLK * DV * 2, SHM_K = KVBLK * DK * 2, KCH = DK / 8, VCH = DV / 8, NKC = DK / 64, NVC = DV / 64;
  int tid = threadIdx.x; asm volatile("" : "+v"(tid));
  const int wid = tid >> 6, lane = tid & 63, r32 = lane & 31, hi = lane >> 5;
  char* V_lds = lds; char* K_lds = lds + 2 * SHM_V;
  float* ws = (float*)(lds + 2 * SHM_V + 2 * SHM_K) + wid * 64; float* li_l = ws; float* al_l = ws + 32;
  float m_reg = m_init, l_reg = l_init; f32x16 o[NCB]; bf16x8 qr[DK / 16];
#pragma unroll
  for (int d = 0; d < NCB; ++d) o[d] = f32x16{};
#pragma unroll
  for (int d0 = 0; d0 < DK / 16; ++d0) qr[d0] = *reinterpret_cast<const bf16x8*>(Qrow + d0 * 16 + hi * 8);
#define BFV(v_, e_) __uint_as_float(((unsigned)(unsigned short)(v_)[e_]) << 16)
#define PACK8(o_) __builtin_bit_cast(bf16x8, (u32x4){cvtpk(o_[0], o_[1]), cvtpk(o_[2], o_[3]), cvtpk(o_[4], o_[5]), cvtpk(o_[6], o_[7])})
  if constexpr (QMODE == 1) {
    static_assert(DK == 192, "MLA q prologue");
    float ss = 0.f;
#pragma unroll
    for (int d0 = 0; d0 < 12; ++d0)
#pragma unroll
      for (int e = 0; e < 8; ++e) { const float x = BFV(qr[d0], e); ss += x * x; }
    ss += __shfl_xor(ss, 32);
    const float rstd = 1.0f / sqrtf(ss * (1.f / 192) + 1e-6f);
#pragma unroll
    for (int d0 = 0; d0 < 8; ++d0) { float y[8];
#pragma unroll
      for (int e = 0; e < 8; ++e) y[e] = BFV(qr[d0], e) * rstd * mq_gain[d0 * 16 + hi * 8 + e];
      qr[d0] = PACK8(y); }
#pragma unroll
    for (int dd = 0; dd < 2; ++dd) { float o1[8], o2[8];
#pragma unroll
      for (int e = 0; e < 8; ++e) { const int i = dd * 16 + hi * 8 + e; const float x1 = BFV(qr[8 + dd], e) * rstd * mq_gain[128 + i], x2 = BFV(qr[10 + dd], e) * rstd * mq_gain[160 + i];
        const float cc = mq_tm[2 * i], sn = mq_tm[2 * i + 1]; o1[e] = x1 * cc - x2 * sn; o2[e] = x2 * cc + x1 * sn; }
      qr[8 + dd] = PACK8(o1); qr[10 + dd] = PACK8(o2); }
  }
  if constexpr (QMODE == 2) {
    static_assert(DK == 128 || QMODE != 2, "GQA q prologue");
    float ss = 0.f;
#pragma unroll
    for (int d0 = 0; d0 < 8; ++d0)
#pragma unroll
      for (int e = 0; e < 8; ++e) { const float x = BFV(qr[d0], e); ss += x * x; }
    ss += __shfl_xor(ss, 32);
    const float rstd = 1.0f / sqrtf(ss * (1.f / 128) + 1e-6f);
#pragma unroll
    for (int hf = 0; hf < 2; ++hf)
#pragma unroll
      for (int dd = 0; dd < 2; ++dd) { float o1[8], o2[8];
#pragma unroll
        for (int e = 0; e < 8; ++e) { const int i = dd * 16 + hi * 8 + e; const float x1 = BFV(qr[4 * hf + dd], e) * rstd * mq_gain[64 * hf + i], x2 = BFV(qr[4 * hf + 2 + dd], e) * rstd * mq_gain[64 * hf + 32 + i];
          const float cc = mq_tm[64 * hf + 2 * i], sn = mq_tm[64 * hf + 2 * i + 1]; o1[e] = x1 * cc - x2 * sn; o2[e] = x2 * cc + x1 * sn; }
        qr[4 * hf + dd] = PACK8(o1); qr[4 * hf + 2 + dd] = PACK8(o2); }
  }
#undef BFV
#undef PACK8
  unsigned koff[NKC], voff[NVC]; int kdst[NKC], vdst[NVC], krow0 = 0;
#pragma unroll
  for (int i = 0; i < NKC; ++i) { const int c = tid + 512 * i, row = c / KCH, col = (c % KCH) * 8; koff[i] = (unsigned)(row * DK + col) * 2u; kdst[i] = kswz<DK>(row, col * 2); if (i == 0) krow0 = row; }
#pragma unroll
  for (int i = 0; i < NVC; ++i) { const int c = tid + 512 * i, row = c / VCH, col = (c % VCH) * 8; voff[i] = (unsigned)(row * DV + col) * 2u; vdst[i] = v_st<NCB>(row, col); }
  const int vb0 = (int)(uintptr_t)V_lds + v_rd_base(lane);
  int kb[4], kbx[4];
#pragma unroll
  for (int e = 0; e < 4; ++e) { kb[e] = kswz<DK>(r32, (e * 16 + hi * 8) * 2); kbx[e] = kb[e] ^ 128; }
  bf16x8 ks[NKC], vs[NVC], ks2[NKC], vs2[NVC];
#define SLOADX(ks, vs, k0) do { if constexpr (SWA) { static_assert(!SWA || (NKC == 1 && NVC == 1 && DK == DV), "SWA path: one chunk per thread"); \
      const int kr_ = min(max((k0) + krow0, 0), seq - 1) - krow0; const char* Kt = (const char*)Kh + (long)kr_ * (DK * 2); const char* Vt = (const char*)Vh + (long)kr_ * (DV * 2); \
      vs[0] = *reinterpret_cast<const bf16x8*>(Vt + voff[0]); ks[0] = *reinterpret_cast<const bf16x8*>(Kt + koff[0]); } \
    else { const char* Kt = (const char*)Kh + (long)(k0) * (DK * 2); const char* Vt = (const char*)Vh + (long)(k0) * (DV * 2); \
      _Pragma("unroll") for (int i = 0; i < NVC; ++i) vs[i] = *reinterpret_cast<const bf16x8*>(Vt + voff[i]); \
      _Pragma("unroll") for (int i = 0; i < NKC; ++i) ks[i] = *reinterpret_cast<const bf16x8*>(Kt + koff[i]); } } while (0)
#define SWRITEX(ks, vs, b) do { _Pragma("unroll") for (int i = 0; i < NVC; ++i) *(bf16x8*)(V_lds + (b) * SHM_V + vdst[i]) = vs[i]; \
    _Pragma("unroll") for (int i = 0; i < NKC; ++i) *(bf16x8*)(K_lds + (b) * SHM_K + kdst[i]) = ks[i]; } while (0)
#define SLOAD(k0) SLOADX(ks, vs, k0)
#define SWRITE(b) SWRITEX(ks, vs, b)
#define SWAIT() asm volatile("s_waitcnt vmcnt(0)" ::: "memory")
#define RESC(a) do { if (__any((a) < 1.f)) { if (hi == 0) al_l[r32] = (a); asm volatile("s_waitcnt lgkmcnt(0)" ::: "memory"); \
    _Pragma("unroll") for (int d = 0; d < NCB; ++d) _Pragma("unroll") for (int r = 0; r < 16; ++r) o[d][r] *= al_l[crow(r, hi)]; } } while (0)
#define MASK(P0, P1, k0) do { if constexpr (SWA) { const int kb = (k0) + 4 * hi; \
    _Pragma("unroll") for (int r = 0; r < 16; ++r) { const int kv = kb + (r & 3) + 8 * (r >> 2); const int dq = qpos - kv; \
      if (!(dq <= win && dq >= -win && kv >= 0 && kv < seq)) P0[r] = -INFINITY; \
      const int kv2 = kv + 32, dq2 = qpos - kv2; if (!(dq2 <= win && dq2 >= -win && kv2 >= 0 && kv2 < seq)) P1[r] = -INFINITY; } } } while (0)
  f32x16 pA0, pA1, pB0, pB1; float mnA, mnB, alA, alB; bf16x8 pa0, pa1, pa2, pa3;
  if constexpr (TWO) {
  SLOAD(kstart); SWAIT(); SWRITE(0); __syncthreads();
  qkt<DK, GS>(pA0, pA1, K_lds, kb, kbx, qr); MASK(pA0, pA1, kstart); partialSM(pA0, pA1, m_reg, mnA, alA, C, thr_raw);
  SLOAD(kstart + KVBLK);
  SWAIT(); SWRITE(1); __syncthreads();
  for (int j = 1; j + 1 < NT; j += 2) {
    SBAR(); qkt<DK, GS>(pB0, pB1, K_lds + SHM_K, kb, kbx, qr);
    finishSM(pA0, pA1, alA, l_reg, pa0, pa1, pa2, pa3); SBAR();
    SLOAD(kstart + (j + 1) * KVBLK); SBAR();
    pv_all<NCB>(o, vb0, pa0, pa1, pa2, pa3); MASK(pB0, pB1, kstart + j * KVBLK); partialSM(pB0, pB1, m_reg, mnB, alB, C, thr_raw);
    __syncthreads(); SWAIT(); SWRITE(0);
    RESC(alB); __syncthreads();
    SBAR(); qkt<DK, GS>(pA0, pA1, K_lds, kb, kbx, qr);
    finishSM(pB0, pB1, alB, l_reg, pa0, pa1, pa2, pa3); SBAR();
    SLOAD(kstart + (j + 2) * KVBLK); SBAR();
    pv_all<NCB>(o, vb0 + SHM_V, pa0, pa1, pa2, pa3); MASK(pA0, pA1, kstart + (j + 1) * KVBLK); partialSM(pA0, pA1, m_reg, mnA, alA, C, thr_raw);
    __syncthreads(); SWAIT(); SWRITE(1);
    RESC(alA); __syncthreads();
  }
  SBAR(); qkt<DK, GS>(pB0, pB1, K_lds + SHM_K, kb, kbx, qr);
  finishSM(pA0, pA1, alA, l_reg, pa0, pa1, pa2, pa3); SBAR();
  pv_all<NCB>(o, vb0, pa0, pa1, pa2, pa3); MASK(pB0, pB1, kstart + (NT - 1) * KVBLK); partialSM(pB0, pB1, m_reg, mnB, alB, C, thr_raw);
  RESC(alB);
  finishSM(pB0, pB1, alB, l_reg, pa0, pa1, pa2, pa3); SBAR();
  pv_all<NCB>(o, vb0 + SHM_V, pa0, pa1, pa2, pa3);
  } else {
#define TILE(bsel, jj) do { SBAR(); qkt<DK, GS>(pA0, pA1, K_lds + (bsel) * SHM_K, kb, kbx, qr); MASK(pA0, pA1, kstart + (jj) * KVBLK); partialSM(pA0, pA1, m_reg, mnA, alA, C, thr_raw); \
      RESC(alA); finishSM(pA0, pA1, alA, l_reg, pa0, pa1, pa2, pa3); SBAR(); pv_all<NCB>(o, vb0 + (bsel) * SHM_V, pa0, pa1, pa2, pa3); SBAR(); } while (0)
    SLOADX(ks, vs, kstart); SBAR(); SLOADX(ks2, vs2, kstart + KVBLK); SBAR();
    SWRITEX(ks, vs, 0); SBAR();
    SLOADX(ks, vs, kstart + 2 * KVBLK); SBAR();
    __syncthreads();
    for (int j = 0; j < NT; j += 2) {
      TILE(0, j);
      SWRITEX(ks2, vs2, 1); SBAR();
      if (j + 3 < NT) { SLOADX(ks2, vs2, kstart + (j + 3) * KVBLK); } SBAR();
      __syncthreads();
      TILE(1, j + 1);
      if (j + 2 < NT) { SWRITEX(ks, vs, 0); SBAR(); if (j + 4 < NT) { SLOADX(ks, vs, kstart + (j + 4) * KVBLK); } SBAR(); }
      __syncthreads();
    }
#undef TILE
  }
  if (hi == 0) li_l[r32] = l_reg; asm volatile("s_waitcnt lgkmcnt(0)" ::: "memory");
  float rli[16];
#pragma unroll
  for (int r = 0; r < 16; ++r) rli[r] = __builtin_amdgcn_rcpf(li_l[crow(r, hi)]);
  __syncthreads();
  { bf16* stg = (bf16*)lds + wid * (QBLK * DV);
#pragma unroll
    for (int r = 0; r < 16; ++r) { const int orow = crow(r, hi);
#pragma unroll
      for (int d0 = 0; d0 < NCB; ++d0) stg[orow * DV + d0 * 32 + r32] = (bf16)(cvtpk(o[d0][r] * rli[r], 0.f) & 0xffffu); }
    asm volatile("s_waitcnt lgkmcnt(0)" ::: "memory");
#pragma unroll
    for (int i = 0; i < (QBLK * VCH) / 64; ++i) { const int idx = i * 64 + lane, row = idx / VCH, ch = idx % VCH;
      const u32x4 v = *(const u32x4*)(stg + row * DV + ch * 8); *(u32x4*)(Ow + (long)row * ldo + ch * 8) = v; } }
  __syncthreads();
#undef SLOAD
#undef SLOADX
#undef SWRITEX
#undef SWRITE
#undef SWAIT
#undef RESC
#undef MASK
}
template <int NT, int NSUB>
__device__ __forceinline__ void swa_unit(const bf16* __restrict__ Qrow, const bf16* __restrict__ Kh, const bf16* __restrict__ Vh, bf16* __restrict__ Ow, const int ldo,
                                         const int kstart, const int qpos0, const int seq, const int win,
                                         const float m_init, const float C, const float thr_raw, char* lds) {
  constexpr int DK = 64, DV = 64, NCB = 2, SHM = KVBLK * 64 * 2, VCH = 8;
  int tid = threadIdx.x; asm volatile("" : "+v"(tid));
  const int wid = tid >> 6, lane = tid & 63, r32 = lane & 31, hi = lane >> 5;
  char* V_lds = lds; char* K_lds = lds + NT * SHM;
  float* ws = (float*)(lds + 2 * NT * SHM) + wid * 64; float* li_l = ws; float* al_l = ws + 32;
  bf16* stg = (bf16*)(lds + 2 * NT * SHM + NW * 256) + wid * (QBLK * DV);
  const int row = tid >> 3, col = (tid & 7) * 8;
  const int kdst = kswz<DK>(row, col * 2), vdst = v_st<NCB>(row, col);
  const int vb0 = (int)(uintptr_t)V_lds + v_rd_base(lane);
  int kb[4], kbx[4];
#pragma unroll
  for (int e = 0; e < 4; ++e) { kb[e] = kswz<DK>(r32, (e * 16 + hi * 8) * 2); kbx[e] = kb[e]; }
  { bf16x8 ksr[NT], vsr[NT];
#pragma unroll
    for (int t = 0; t < NT; ++t) { const int kr = min(max(kstart + t * KVBLK + row, 0), seq - 1);
      ksr[t] = *reinterpret_cast<const bf16x8*>(Kh + (long)kr * DK + col); vsr[t] = *reinterpret_cast<const bf16x8*>(Vh + (long)kr * DV + col); }
#pragma unroll
    for (int t = 0; t < NT; ++t) { *(bf16x8*)(K_lds + t * SHM + kdst) = ksr[t]; *(bf16x8*)(V_lds + t * SHM + vdst) = vsr[t]; } }
  __syncthreads();
#pragma unroll 1
  for (int sub = 0; sub < NSUB; ++sub) {
    const int qpos = qpos0 + sub * QBLK;
    float m_reg = m_init, l_reg = 1.f; f32x16 o[NCB]; bf16x8 qr[4];
    o[0] = f32x16{}; o[1] = f32x16{};
#pragma unroll
    for (int d0 = 0; d0 < 4; ++d0) qr[d0] = *reinterpret_cast<const bf16x8*>(Qrow + (long)sub * QBLK * DK + d0 * 16 + hi * 8);
    f32x16 p0, p1; float mn, al; bf16x8 pa0, pa1, pa2, pa3;
#pragma unroll
    for (int t = 0; t < NT; ++t) {
      const int k0 = kstart + t * KVBLK;
      SBAR(); qkt<DK, 2>(p0, p1, K_lds + t * SHM, kb, kbx, qr);
      { const int kbase = k0 + 4 * hi;
#pragma unroll
        for (int r = 0; r < 16; ++r) { const int kv = kbase + (r & 3) + 8 * (r >> 2); const int dq = qpos - kv;
          if (!(dq <= win && dq >= -win && kv >= 0 && kv < seq)) p0[r] = -INFINITY;
          const int kv2 = kv + 32, dq2 = qpos - kv2; if (!(dq2 <= win && dq2 >= -win && kv2 >= 0 && kv2 < seq)) p1[r] = -INFINITY; } }
      partialSM(p0, p1, m_reg, mn, al, C, thr_raw);
      if (__any(al < 1.f)) { if (hi == 0) al_l[r32] = al; asm volatile("s_waitcnt lgkmcnt(0)" ::: "memory");
#pragma unroll
        for (int d = 0; d < NCB; ++d)
#pragma unroll
          for (int r = 0; r < 16; ++r) o[d][r] *= al_l[crow(r, hi)]; }
      finishSM(p0, p1, al, l_reg, pa0, pa1, pa2, pa3); SBAR();
      pv_all<NCB>(o, vb0 + t * SHM, pa0, pa1, pa2, pa3);
    }
    if (hi == 0) li_l[r32] = l_reg; asm volatile("s_waitcnt lgkmcnt(0)" ::: "memory");
    float rli[16];
#pragma unroll
    for (int r = 0; r < 16; ++r) rli[r] = __builtin_amdgcn_rcpf(li_l[crow(r, hi)]);
#pragma unroll
    for (int r = 0; r < 16; ++r) { const int orow = crow(r, hi);
#pragma unroll
      for (int d0 = 0; d0 < NCB; ++d0) stg[orow * DV + d0 * 32 + r32] = (bf16)(cvtpk(o[d0][r] * rli[r], 0.f) & 0xffffu); }
    asm volatile("s_waitcnt lgkmcnt(0)" ::: "memory");
#pragma unroll
    for (int i = 0; i < (QBLK * VCH) / 64; ++i) { const int idx = i * 64 + lane, rw = idx / VCH, ch = idx % VCH;
      const u32x4 v = *(const u32x4*)(stg + rw * DV + ch * 8); *(u32x4*)(Ow + (long)(sub * QBLK + rw) * ldo + ch * 8) = v; }
    asm volatile("s_waitcnt lgkmcnt(0)" ::: "memory");
  }
  __syncthreads();
}
#undef SBAR
}

#define LAS __attribute__((address_space(3)))
typedef unsigned short bf16;
typedef unsigned v4u __attribute__((ext_vector_type(4)));
typedef unsigned v2u __attribute__((ext_vector_type(2)));
typedef float f32x4 __attribute__((ext_vector_type(4)));
typedef float f32x2 __attribute__((ext_vector_type(2)));
constexpr int NWAVES = 8;
constexpr int BATCH = 2, SEQ = 8192, T = BATCH * SEQ, DM = 2048, DFF = 8192;
constexpr int EVEN_IN = 2368, EVEN_IN_P = 2560, ODD_IN = 2560;
constexpr float EPS = 1e-6f;
constexpr size_t MiB = 1u << 20;
constexpr size_t WS_WIN = 1 * MiB, WS_WUQ = 11 * MiB, WS_WUKV = 13 * MiB, WS_WOE = 14 * MiB, WS_WUP = 22 * MiB, WS_WDN = 54 * MiB;
constexpr size_t WS_WQKV = 487 * MiB, WS_WOO = 497 * MiB;
constexpr size_t WS_TMLA = 86 * MiB, WS_TAX = 88 * MiB, WS_TSWA = 92 * MiB;
constexpr size_t WS_XN = 93 * MiB;
constexpr size_t WS_CNT = 48 * 1024;
constexpr size_t WS_ROWSS = 64 * 1024;
constexpr size_t AB = 157 * MiB;
constexpr size_t WS_MRG0 = AB + 154 * MiB;
constexpr size_t WS_MRG = AB;
constexpr size_t WS_U = AB;
constexpr size_t WS_PROJ = AB, WS_KVR = AB, WS_QAR = AB + 80 * MiB, WS_CQN = AB + 128 * MiB, WS_CKVN = AB + 144 * MiB, WS_KR = AB + 152 * MiB, WS_QG = AB + 154 * MiB,
                 WS_KG = AB + 218 * MiB, WS_VG = AB + 226 * MiB, WS_QA = AB + 202 * MiB, WS_KA = AB + 250 * MiB, WS_VA = AB + 298 * MiB;
constexpr size_t WS_SQ = AB + 80 * MiB, WS_SK = AB + 144 * MiB, WS_SV = AB + 152 * MiB;
constexpr size_t WS_END = AB + 330 * MiB;
static_assert(WS_END <= WS_WQKV && WS_WOO + 8 * MiB <= 512 * MiB && WS_U + 256 * MiB <= WS_WQKV, "workspace map");
constexpr size_t WS_NEED = 505 * MiB;
#ifdef PROBE_NOLDS
constexpr int LDS_BYTES = 0;
#else
constexpr int EST_OFF = 131072 + 1024, LDS_BYTES = EST_OFF + 32 * 528 + 512;
#endif

__device__ __forceinline__ unsigned cvtpk2(float lo, float hi) { unsigned r; asm volatile("v_cvt_pk_bf16_f32 %0, %1, %2" : "=v"(r) : "v"(lo), "v"(hi)); return r; }
__device__ __forceinline__ float bflo(unsigned w) { return __uint_as_float(w << 16); }
__device__ __forceinline__ float bfhi(unsigned w) { return __uint_as_float(w & 0xffff0000u); }
__device__ __forceinline__ void ld8(const bf16* p, float (&v)[8]) { const v4u w = *(const v4u*)p; v[0] = bflo(w.x); v[1] = bfhi(w.x); v[2] = bflo(w.y); v[3] = bfhi(w.y); v[4] = bflo(w.z); v[5] = bfhi(w.z); v[6] = bflo(w.w); v[7] = bfhi(w.w); }
__device__ __forceinline__ void st8(bf16* p, const float (&v)[8]) { v4u w; w.x = cvtpk2(v[0], v[1]); w.y = cvtpk2(v[2], v[3]); w.z = cvtpk2(v[4], v[5]); w.w = cvtpk2(v[6], v[7]); *(v4u*)p = w; }
__device__ __forceinline__ void ld4(const bf16* p, float (&v)[4]) { const v2u w = *(const v2u*)p; v[0] = bflo(w.x); v[1] = bfhi(w.x); v[2] = bflo(w.y); v[3] = bfhi(w.y); }
__device__ __forceinline__ void st4(bf16* p, const float (&v)[4]) { v2u w; w.x = cvtpk2(v[0], v[1]); w.y = cvtpk2(v[2], v[3]); *(v2u*)p = w; }
template <int W> __device__ __forceinline__ float grp_sum(float v) {
#pragma unroll
  for (int o = 1; o < W; o <<= 1) v += __shfl_xor(v, o);
  return v;
}
__device__ __forceinline__ float sumsq8(const float (&v)[8]) { float s = 0.f;
#pragma unroll
  for (int j = 0; j < 8; ++j) s += v[j] * v[j];
  return s; }

#define XB_TMO      128
#define XB_XCNT(j)  (256  + 64 * (j))
#define XB_XSUB(j)  (1280 + 64 * (j))
#define XB_XGEN(j)  (2304 + 64 * (j))
#define XB_TOP      3328
#define XB_TOPGEN   3392
#define XCD_BAR_WORDS 3456
#define XB_SPIN_CAP (1u << 18)

__device__ __forceinline__ unsigned xb_ld(unsigned* p)              { return __hip_atomic_load(p, __ATOMIC_RELAXED, __HIP_MEMORY_SCOPE_AGENT); }
__device__ __forceinline__ unsigned xb_add(unsigned* p, unsigned v) { return __hip_atomic_fetch_add(p, v, __ATOMIC_RELAXED, __HIP_MEMORY_SCOPE_AGENT); }
__device__ __forceinline__ unsigned xb_xcc_id() { return (unsigned)__builtin_amdgcn_s_getreg((3 << 11) | 20) & 0xFu; }
#define XB_SPIN(cond, bar) do { unsigned _sp = 0; while (cond) { __builtin_amdgcn_s_sleep(1); \
    if ((++_sp & 255u) == 0u) { if (xb_ld(&(bar)[XB_TMO])) break; if (_sp > XB_SPIN_CAP) { atomicAdd(&(bar)[XB_TMO], 1u); break; } } } } while (0)

struct XcdBarrier {
    unsigned* bar; unsigned x;
    volatile LAS unsigned* st;
};

__device__ __forceinline__ XcdBarrier xcd_barrier_post(unsigned* bar, volatile LAS unsigned* st) {
    XcdBarrier b; b.bar = bar; b.x = xb_xcc_id(); b.st = st;
    if (threadIdx.x == 0) (void)xb_add(&bar[XB_XCNT(b.x)], 1u);
    return b;
}
__device__ __forceinline__ void xcd_barrier_complete(unsigned* bar, unsigned x, unsigned& nloc, unsigned& nx) {
    const unsigned G = gridDim.x * gridDim.y * gridDim.z;
    unsigned sum, cnt, mine, sp = 0u;
    for (;;) {
        sum = 0u; cnt = 0u; mine = 0u;
#pragma unroll
        for (unsigned j = 0; j < 16; ++j) { const unsigned c = xb_ld(&bar[XB_XCNT(j)]); sum += c; cnt += (c > 0u) ? 1u : 0u; mine = (j == x) ? c : mine; }
        if (sum == G) break;
        __builtin_amdgcn_s_sleep(1);
        if ((++sp & 255u) == 0u) { if (xb_ld(&bar[XB_TMO])) break; if (sp > XB_SPIN_CAP) { atomicAdd(&bar[XB_TMO], 1u); break; } }
    }
    nloc = mine > 0u ? mine : 1u; nx = cnt > 0u ? cnt : 1u;
}

__device__ __forceinline__ void xcd_barrier(const XcdBarrier& b) {
    asm volatile("s_waitcnt vmcnt(0)" ::: "memory");
    __syncthreads();
    if (threadIdx.x == 0) {
        unsigned* bar = b.bar;
        __builtin_amdgcn_s_waitcnt(0);
        unsigned nloc = b.st[0], nx = b.st[1];
        if (nloc == 0u) { xcd_barrier_complete(bar, b.x, nloc, nx); b.st[0] = nloc; b.st[1] = nx; }
        const unsigned old = xb_add(&bar[XB_XSUB(b.x)], 1u);
        const unsigned gen = old / nloc;
        if (old + 1u == (gen + 1u) * nloc) {
            __builtin_amdgcn_fence(__ATOMIC_RELEASE, "agent");
            asm volatile("s_waitcnt vmcnt(0)" ::: "memory");
            const unsigned og = xb_add(&bar[XB_TOP], 1u);
            const unsigned tg = og / nx;
            if (og + 1u == (tg + 1u) * nx) xb_add(&bar[XB_TOPGEN], 1u);
            else XB_SPIN(xb_ld(&bar[XB_TOPGEN]) == tg, bar);
            __builtin_amdgcn_fence(__ATOMIC_ACQUIRE, "agent");
            xb_add(&bar[XB_XGEN(b.x)], 1u);
            asm volatile("s_waitcnt vmcnt(0)" ::: "memory");
        } else {
            XB_SPIN(xb_ld(&bar[XB_XGEN(b.x)]) == gen, bar);
            __builtin_amdgcn_fence(__ATOMIC_ACQUIRE, "agent");
            asm volatile("s_waitcnt vmcnt(0)" ::: "memory");
        }
    }
    __syncthreads();
}

struct Args {
  const float* in[22]; float* out; unsigned char* ws;
  float inv_mla[32], inv_ax[32], inv_swa[8];
};

struct Ctx { int lane, wave, gw, NGW, G, vcu; unsigned char* ws; };

__device__ __forceinline__ void transpose_stream(const float* __restrict__ W, const int K, const int N, bf16* __restrict__ WT, LAS float* scr, const int first, const int items, const int stride, const int lane, const float* __restrict__ gain, const bool permq = false) {
  const int nblk = N / 32, half = lane >> 5, l31 = lane & 31;
  float cur[32], nxt[32];
  if (first >= items) return;
#define TS_LOAD(dst, item_) do { const int kb_ = (item_) / nblk, nb_ = (item_) % nblk; const float* p_ = W + (size_t)(64 * kb_ + half) * N + 32 * nb_ + l31; \
    _Pragma("unroll") for (int i = 0; i < 32; ++i) dst[i] = p_[(size_t)(2 * i) * N]; } while (0)
  TS_LOAD(cur, first);
  for (int it = first; it < items; it += stride) {
    const bool more = it + stride < items;
    if (more) TS_LOAD(nxt, it + stride);
    const int kb = it / nblk, nb = it % nblk, k0 = 64 * kb, n0 = 32 * nb;
    const int n0p = permq ? ((n0 & ~255) | (((n0 >> 5) & 1) << 7) | (((n0 >> 6) & 3) << 5)) : n0;
    if (gain) {
#pragma unroll
      for (int i = 0; i < 32; ++i) cur[i] *= gain[k0 + 2 * i + half]; }
#pragma unroll
    for (int i = 0; i < 32; ++i) scr[(2 * i + half) * 33 + l31] = cur[i];
    asm volatile("s_waitcnt lgkmcnt(0)" ::: "memory");
    const int c = lane & 7;
#pragma unroll
    for (int j = 0; j < 4; ++j) { const int n = (lane >> 3) + 8 * j; const LAS float* s = scr + (8 * c) * 33 + n;
      v4u o; o.x = cvtpk2(s[0 * 33], s[1 * 33]); o.y = cvtpk2(s[2 * 33], s[3 * 33]); o.z = cvtpk2(s[4 * 33], s[5 * 33]); o.w = cvtpk2(s[6 * 33], s[7 * 33]);
      *(v4u*)(WT + (size_t)(n0p + n) * K + k0 + 8 * c) = o; }
    asm volatile("s_waitcnt lgkmcnt(0)" ::: "memory");
    if (more) {
#pragma unroll
      for (int i = 0; i < 32; ++i) cur[i] = nxt[i]; }
  }
#undef TS_LOAD
}
template <int SET> __device__ __forceinline__ void convert_dynamic(unsigned* counter, const int wave, const int lane, const Args& a, unsigned char* ws, LAS unsigned char* lds) {
  LAS float* scr = (LAS float*)(lds + wave * 16384);
  constexpr int CH = 8, C_OE = (DM / 64) * (DM / 32) / CH, C_UP = (DM / 64) * (DFF / 32) / CH, C_DN = (DFF / 64) * (DM / 32) / CH, C_QKV = (DM / 64) * (ODD_IN / 32) / CH;
#define CD_TS(W_, K_, N_, off_, gain_, perm_, ch_) transpose_stream((W_), (K_), (N_), (bf16*)(ws + (off_)), scr, (ch_) * CH, (ch_) * CH + CH, 1, lane, (gain_), (perm_))
  for (;;) {
    int chv = 0; if (lane == 0) chv = (int)__hip_atomic_fetch_add(counter, 1u, __ATOMIC_RELAXED, __HIP_MEMORY_SCOPE_AGENT);
    const int ch = __builtin_amdgcn_readfirstlane(chv);
    if constexpr (SET == 1) {
      if (ch < C_UP) CD_TS(a.in[20], DM, DFF, WS_WUP, a.in[19], false, ch);
      else if (ch < C_UP + C_DN) CD_TS(a.in[21], DFF, DM, WS_WDN, nullptr, false, ch - C_UP);
      else if (ch < C_UP + C_DN + C_OE) CD_TS(a.in[12], DM, DM, WS_WOE, nullptr, false, ch - C_UP - C_DN);
      else if (ch < C_UP + C_DN + C_OE + C_QKV) CD_TS(a.in[14], DM, ODD_IN, WS_WQKV, a.in[13], true, ch - C_UP - C_DN - C_OE);
      else if (ch < C_UP + C_DN + 2 * C_OE + C_QKV) CD_TS(a.in[18], DM, DM, WS_WOO, nullptr, false, ch - C_UP - C_DN - C_OE - C_QKV);
      else break;
    } else {
      if (ch < C_UP) CD_TS(a.in[20] + (size_t)DM * DFF, DM, DFF, WS_WUP, a.in[19] + DM, false, ch);
      else if (ch < C_UP + C_DN) CD_TS(a.in[21] + (size_t)DM * DFF, DFF, DM, WS_WDN, nullptr, false, ch - C_UP);
      else break;
    }
  }
#undef CD_TS
}
__device__ __forceinline__ void rms_row(const float* xrow, const float* gain, bf16* orow, int lane) {
  f32x4 v[8]; float s = 0.f;
#pragma unroll
  for (int j = 0; j < 4; ++j) { const f32x4* p = (const f32x4*)xrow + 2 * (64 * j + lane); v[2 * j] = p[0]; v[2 * j + 1] = p[1]; }
#pragma unroll
  for (int j = 0; j < 8; ++j) s += (v[j].x * v[j].x + v[j].y * v[j].y) + (v[j].z * v[j].z + v[j].w * v[j].w);
  const float rstd = 1.0f / sqrtf(grp_sum<64>(s) * (1.f / DM) + EPS);
#pragma unroll
  for (int j = 0; j < 4; ++j) { const f32x4* gp = (const f32x4*)gain + 2 * (64 * j + lane); const f32x4 g0 = gp[0], g1 = gp[1], a0 = v[2 * j], a1 = v[2 * j + 1];
    v4u w; w.x = cvtpk2(a0.x * rstd * g0.x, a0.y * rstd * g0.y); w.y = cvtpk2(a0.z * rstd * g0.z, a0.w * rstd * g0.w); w.z = cvtpk2(a1.x * rstd * g1.x, a1.y * rstd * g1.y); w.w = cvtpk2(a1.z * rstd * g1.z, a1.w * rstd * g1.w);
    *((v4u*)orow + 64 * j + lane) = w; }
}
__device__ __forceinline__ void norm_phase(const Ctx& c, const float* x, const float* gain, bf16* xn) {
  for (int m = c.gw; m < T; m += c.NGW) rms_row(x + (size_t)m * DM, gain, xn + (size_t)m * DM, c.lane);
}
__device__ __forceinline__ f32x2 sincos_rev(float ang) {
  double fr = (double)ang * 0.15915494309189533577; fr -= rint(fr); const float f = (float)fr;
  return (f32x2){__builtin_amdgcn_cosf(f), __builtin_amdgcn_sinf(f)};
}

__device__ __forceinline__ void prologue(const Ctx& c, const Args& a, LAS unsigned char* lds) {
  LAS float* scr = (LAS float*)(lds + c.wave * 16384);
  unsigned char* ws = c.ws;
  int base = 0;
#define DO_W(inidx, K_, N_, off, srcoff, gain_) do { const int items = ((K_) / 64) * ((N_) / 32); const float* W = a.in[inidx] + (srcoff); bf16* WT = (bf16*)(ws + (off)); \
    const int first = (c.gw - (base % c.NGW) + c.NGW) % c.NGW; \
    transpose_stream(W, (K_), (N_), WT, scr, first, items, c.NGW, c.lane, (gain_)); \
    base += items; } while (0)
  DO_W(2, DM, EVEN_IN, WS_WIN, 0, nullptr); DO_W(5, 512, 1536, WS_WUQ, 0, a.in[3]); DO_W(6, 256, 2048, WS_WUKV, 0, a.in[4]);
#undef DO_W
  { v4u* z = (v4u*)((bf16*)(ws + WS_WIN) + (size_t)EVEN_IN * DM); const int n16 = (EVEN_IN_P - EVEN_IN) * DM / 8;
    for (int i = c.gw * 64 + c.lane; i < n16; i += c.NGW * 64) z[i] = (v4u){0u, 0u, 0u, 0u}; }
  { f32x2* tm = (f32x2*)(ws + WS_TMLA); f32x2* ta = (f32x2*)(ws + WS_TAX); f32x2* tsw = (f32x2*)(ws + WS_TSWA);
    const int gt = c.gw * 64 + c.lane, NT_ = c.NGW * 64;
    for (int i = gt; i < SEQ * 32; i += NT_) { const int s = i >> 5, f = i & 31; tm[i] = sincos_rev((float)s * a.inv_mla[f]); }
    for (int i = gt; i < SEQ * 64; i += NT_) { const int s = i >> 6, f = i & 63; const int pos = (f < 32) ? (s >> 6) : (s & 63); ta[i] = sincos_rev((float)pos * a.inv_ax[f & 31]); }
    for (int i = gt; i < SEQ * 8; i += NT_) { const int s = i >> 3, f = i & 7; tsw[i] = sincos_rev((float)s * a.inv_swa[f]); } }
  norm_phase(c, a.in[0], a.in[1], (bf16*)(ws + WS_XN));
}

__device__ __forceinline__ void convert_layer1(const Ctx& c, const Args& a, LAS unsigned char* lds) {
  LAS float* scr = (LAS float*)(lds + c.wave * 16384);
  unsigned char* ws = c.ws;
  int base = 0;
#define DO_W(inidx, K_, N_, off, srcoff, gain_) do { const int items = ((K_) / 64) * ((N_) / 32); const float* W = a.in[inidx] + (srcoff); bf16* WT = (bf16*)(ws + (off)); \
    const int first = (c.gw - (base % c.NGW) + c.NGW) % c.NGW; \
    transpose_stream(W, (K_), (N_), WT, scr, first, items, c.NGW, c.lane, (gain_)); \
    base += items; } while (0)
  DO_W(20, DM, DFF, WS_WUP, (size_t)DM * DFF, a.in[19] + DM); DO_W(21, DFF, DM, WS_WDN, (size_t)DM * DFF, nullptr);
#undef DO_W
}
__device__ __forceinline__ void post_proj(const Ctx& c, const Args& a) {
  unsigned char* ws = c.ws; const int l = c.lane;
  const bf16* PROJ = (const bf16*)(ws + WS_PROJ);
  bf16* CQN = (bf16*)(ws + WS_CQN); bf16* CKVN = (bf16*)(ws + WS_CKVN); bf16* KR = (bf16*)(ws + WS_KR);
  bf16* QG = (bf16*)(ws + WS_QG); bf16* KG = (bf16*)(ws + WS_KG); bf16* VG = (bf16*)(ws + WS_VG);
  const f32x2* tm = (const f32x2*)(ws + WS_TMLA); const f32x2* ta = (const f32x2*)(ws + WS_TAX);
  const float* g_qlat = a.in[3]; const float* g_kvlat = a.in[4]; const float* g_krope = a.in[9]; const float* g_gq = a.in[10]; const float* g_gk = a.in[11];
  for (int t = c.gw; t < T; t += c.NGW) {
    const int b = t / SEQ, s = t % SEQ; const bf16* pr = PROJ + (size_t)t * EVEN_IN_P;
    float v[8], o[8];
    { const bool act = l >= 32 && l < 40; if (act) ld8(pr + 512 + 8 * l, v); else {
#pragma unroll
        for (int j = 0; j < 8; ++j) v[j] = 0.f; }
      float ss = grp_sum<8>(sumsq8(v)); const float ss8 = ss; ss += __shfl_xor(ss, 8); ss += __shfl_xor(ss, 16);
      const int lr = l & 7; const float rstd8 = 1.0f / sqrtf(ss8 * (1.f / 64) + EPS); float nv[8], pv_[8];
#pragma unroll
      for (int j = 0; j < 8; ++j) nv[j] = v[j] * rstd8 * g_krope[(8 * lr + j) & 63];
#pragma unroll
      for (int j = 0; j < 8; ++j) pv_[j] = __shfl_xor(nv[j], 4);
      if (l >= 32 && l < 40) {
#pragma unroll
        for (int j = 0; j < 8; ++j) { const f32x2 cs = tm[s * 32 + 8 * (lr & 3) + j]; o[j] = (lr & 4) ? (nv[j] * cs.x + pv_[j] * cs.y) : (nv[j] * cs.x - pv_[j] * cs.y); }
        bf16* KAr = (bf16*)(ws + WS_KA) + ((size_t)(b * 8) * SEQ + s) * 192 + 128 + 8 * lr;
#pragma unroll
        for (int hh = 0; hh < 8; ++hh) st8(KAr + (size_t)hh * SEQ * 192, o); } }
#pragma unroll
    for (int pass = 2; pass < 3; ++pass) {
      const int hl = l >> 4, ll = l & 15;
      ld8(pr + 832 + pass * 512 + 8 * l, v);
      const float rstd = 1.0f / sqrtf(grp_sum<16>(sumsq8(v)) * (1.f / 128) + EPS);
      const float* g = (pass < 2) ? g_gq : g_gk; float nv[8], pv_[8];
#pragma unroll
      for (int j = 0; j < 8; ++j) nv[j] = v[j] * rstd * g[8 * ll + j];
#pragma unroll
      for (int j = 0; j < 8; ++j) pv_[j] = __shfl_xor(nv[j], 4);
#pragma unroll
      for (int j = 0; j < 8; ++j) { const f32x2 cs = ta[s * 64 + ((ll & 8) ? 32 : 0) + 8 * (ll & 3) + j]; o[j] = (ll & 4) ? (nv[j] * cs.x + pv_[j] * cs.y) : (nv[j] * cs.x - pv_[j] * cs.y); }
      if (pass < 2) st8(QG + ((size_t)(b * 8 + pass * 4 + hl) * SEQ + s) * 128 + 8 * ll, o);
      else if (hl < 2) st8(KG + ((size_t)(b * 2 + hl) * SEQ + s) * 128 + 8 * ll, o);
      else st8(VG + ((size_t)(b * 2 + (hl - 2)) * SEQ + s) * 128 + 8 * ll, v);
    }
  }
}
__device__ __forceinline__ void post_mla(const Ctx& c, const Args& a) {
  unsigned char* ws = c.ws; const int l = c.lane, hl = l >> 4, ll = l & 15;
  const bf16* QAR = (const bf16*)(ws + WS_QAR); const bf16* KVR = (const bf16*)(ws + WS_KVR); const bf16* KR = (const bf16*)(ws + WS_KR);
  bf16* QA = (bf16*)(ws + WS_QA); bf16* KA = (bf16*)(ws + WS_KA); bf16* VA = (bf16*)(ws + WS_VA);
  const f32x2* tm = (const f32x2*)(ws + WS_TMLA);
  const float* g_q = a.in[7]; const float* g_kn = a.in[8];
  for (int t = c.gw; t < T; t += c.NGW) {
    const int b = t / SEQ, s = t % SEQ;
#pragma unroll
    for (int pass = 0; pass < 2; ++pass) {
      const int h = pass * 4 + hl;
      {
        const bf16* q = QAR + (size_t)t * 1536 + h * 192; float v[8], r[4], o[8], ro[4];
        ld8(q + 8 * ll, v); ld4(q + 128 + 4 * ll, r);
        float ss = sumsq8(v) + (r[0] * r[0] + r[1] * r[1]) + (r[2] * r[2] + r[3] * r[3]);
        const float rstd = 1.0f / sqrtf(grp_sum<16>(ss) * (1.f / 192) + EPS);
#pragma unroll
        for (int j = 0; j < 8; ++j) o[j] = v[j] * rstd * g_q[8 * ll + j];
        float nr[4], pr_[4];
#pragma unroll
        for (int j = 0; j < 4; ++j) nr[j] = r[j] * rstd * g_q[128 + 4 * ll + j];
#pragma unroll
        for (int j = 0; j < 4; ++j) pr_[j] = __shfl_xor(nr[j], 8);
#pragma unroll
        for (int j = 0; j < 4; ++j) { const f32x2 cs = tm[s * 32 + 4 * (ll & 7) + j]; ro[j] = (ll & 8) ? (nr[j] * cs.x + pr_[j] * cs.y) : (nr[j] * cs.x - pr_[j] * cs.y); }
        bf16* qo = QA + ((size_t)(b * 8 + h) * SEQ + s) * 192; st8(qo + 8 * ll, o); st4(qo + 128 + 4 * ll, ro); }
      {
        const bf16* kv = KVR + (size_t)t * 2048 + h * 256; float v[8], o[8];
        ld8(kv + 8 * ll, v);
        const float rstd = 1.0f / sqrtf(grp_sum<16>(sumsq8(v)) * (1.f / 128) + EPS);
#pragma unroll
        for (int j = 0; j < 8; ++j) o[j] = v[j] * rstd * g_kn[8 * ll + j];
        bf16* ko = KA + ((size_t)(b * 8 + h) * SEQ + s) * 192; st8(ko + 8 * ll, o);
        *(v2u*)(ko + 128 + 4 * ll) = *(const v2u*)(KR + (size_t)t * 64 + 4 * ll);
        *(v4u*)(VA + ((size_t)(b * 8 + h) * SEQ + s) * 128 + 8 * ll) = *(const v4u*)(kv + 128 + 8 * ll); }
    }
  }
}
__device__ __forceinline__ void post_qkv(const Ctx& c, const Args& a) {
  unsigned char* ws = c.ws; const int l = c.lane, hl = l >> 3, ll = l & 7;
  const bf16* QKV = (const bf16*)(ws + WS_PROJ);
  bf16* SQ = (bf16*)(ws + WS_SQ); bf16* SK = (bf16*)(ws + WS_SK); bf16* SV = (bf16*)(ws + WS_SV);
  const f32x2* tsw = (const f32x2*)(ws + WS_TSWA);
  const float* g_q = a.in[15]; const float* g_k = a.in[16];
  for (int t = c.gw; t < T; t += c.NGW) {
    const int b = t / SEQ, s = t % SEQ; const bf16* pr = QKV + (size_t)t * ODD_IN;
#pragma unroll
    for (int pass = 0; pass < 5; ++pass) {
      float v[8], o[8], nv[8], pv_[8];
      ld8(pr + pass * 512 + 8 * l, v);
      const float rstd = 1.0f / sqrtf(grp_sum<8>(sumsq8(v)) * (1.f / 64) + EPS);
      const float* g = (pass < 4) ? g_q : g_k;
#pragma unroll
      for (int j = 0; j < 8; ++j) nv[j] = v[j] * rstd * g[8 * ll + j];
#pragma unroll
      for (int j = 0; j < 8; ++j) pv_[j] = __shfl_xor(nv[j], 1);
#pragma unroll
      for (int j = 0; j < 8; ++j) { const f32x2 cs = tsw[s * 8 + j]; o[j] = (ll >= 2) ? nv[j] : ((ll & 1) ? (nv[j] * cs.x + pv_[j] * cs.y) : (nv[j] * cs.x - pv_[j] * cs.y)); }
      if (pass < 4) st8(SQ + ((size_t)(b * 32 + pass * 8 + hl) * SEQ + s) * 64 + 8 * ll, o);
      else if (hl < 4) st8(SK + ((size_t)(b * 4 + hl) * SEQ + s) * 64 + 8 * ll, o);
      else st8(SV + ((size_t)(b * 4 + (hl - 4)) * SEQ + s) * 64 + 8 * ll, v);
    }
  }
}

#ifdef NO_GEMM
#define GEMM_PHASE(EPI_T, epi, Aoff, Boff, N_, K_) do { (void)(epi); } while (0)
#else
#define GEMM_PHASE(EPI_T, epi, Aoff, Boff, N_, K_) do { \
    pg8::Gemm g_{(const pg8::bf16_t*)(ws + (Aoff)), (const pg8::bf16_t*)(ws + (Boff)), T, (N_), (K_)}; pg8::StaticOrder S_; S_.init(T, (N_), c.G, (int)blockIdx.x); \
    pg8::gemm_phase<EPI_T, pg8::StaticOrder, true, true>(ldsl, g_, S_, (epi)); } while (0)
#endif

#ifndef STAG_TICKS
#define STAG_TICKS 0
#endif
#define STAGGER() do { if (STAG_TICKS > 0) { const unsigned long long t0_ = __builtin_amdgcn_s_memrealtime(); const unsigned long long d_ = (unsigned long long)((blockIdx.x >> 3) & 3) * STAG_TICKS; \
    while (__builtin_amdgcn_s_memrealtime() - t0_ < d_) __builtin_amdgcn_s_sleep(8); } } while (0)
#ifndef REP_THIN2
#define REP_THIN2 1
#endif
#ifndef REP_THIN3
#define REP_THIN3 1
#endif
#ifndef REP_SWA
#define REP_SWA 1
#endif
#ifndef REP_PRO
#define REP_PRO 1
#endif
#ifndef REP_THIN
#define REP_THIN 1
#endif
#ifndef REP_MLA
#define REP_MLA 1
#endif
#ifndef REP_GQA
#define REP_GQA 1
#endif
#ifndef REP_UP
#define REP_UP 1
#endif
__global__ void __launch_bounds__(NWAVES * 64, 2) fwd_megakernel(Args a) {
  extern __shared__ __attribute__((aligned(16))) unsigned char lds[];
#ifdef NO_SYNC
  struct { __device__ void sync() const { __syncthreads(); } } grid;
#else
  cg::grid_group grid = cg::this_grid();
#endif
  LAS unsigned char* ldsl = (LAS unsigned char*)lds;
#define MKCTX() do { int t_ = threadIdx.x; asm volatile("" : "+v"(t_)); c.lane = t_ & 63; c.wave = __builtin_amdgcn_readfirstlane(t_ >> 6); c.G = gridDim.x; \
    { const int bx = blockIdx.x; c.vcu = (c.G % 8 == 0) ? (bx % 8) * (c.G / 8) + bx / 8 : bx; } \
    c.gw = blockIdx.x * NWAVES + c.wave; c.NGW = c.G * NWAVES; c.ws = a.ws; } while (0)
  Ctx c; MKCTX();
  volatile LAS unsigned* bst = (volatile LAS unsigned*)(ldsl + 131072 + 512);
  if (threadIdx.x < 2) bst[threadIdx.x] = 0u;
  __syncthreads();
  XcdBarrier xbar = xcd_barrier_post((unsigned*)a.ws, bst);
#ifdef USE_CG_ALL
#define SEAM() do { grid.sync(); MKCTX(); } while (0)
#else
#define SEAM() do { xcd_barrier(xbar); MKCTX(); } while (0)
#endif
  unsigned char* ws = a.ws;
  float* X = a.out; float* RSS = (float*)(a.ws + WS_ROWSS);

#ifndef NO_PRO
  prologue(c, a, ldsl);

#endif
  grid.sync(); MKCTX();
  { typedef pg8::EpiP1<WS_CQN, WS_CKVN, WS_PROJ, WS_ROWSS + 3 * T * 4, WS_ROWSS + 4 * T * 4, EVEN_IN_P> EP1; EP1 E{ws}; GEMM_PHASE(EP1, E, WS_XN, WS_WIN, EVEN_IN_P, DM); }
#ifndef NO_PRO
  MKCTX(); convert_dynamic<1>((unsigned*)(ws + WS_CNT), c.wave, c.lane, a, ws, ldsl);
#endif
  SEAM();
  { pg8::EpiB<0> E{(pg8::bf16_t*)(ws + WS_QAR), 1536, RSS + 3 * T, 1.f / 512, EPS}; GEMM_PHASE(pg8::EpiB<0>, E, WS_CQN, WS_WUQ, 1536, 512); }
  { typedef pg8::EpiKV<WS_KA, WS_VA, WS_ROWSS + 4 * T * 4, EST_OFF, 13> EKV; EKV E{ws, a.in[8], ldsl, EPS};
    pg8::Gemm g_{(const pg8::bf16_t*)(ws + WS_CKVN), (const pg8::bf16_t*)(ws + WS_WUKV), T, 2048, 256}; pg8::StaticOrder S_; S_.init(T, 2048, c.G, (int)blockIdx.x);
    pg8::gemm_phase<EKV, pg8::StaticOrder, true, false>(ldsl, g_, S_, E); }
#ifndef NO_POST
  MKCTX(); post_proj(c, a);
#endif
  SEAM();
  {
    constexpr float L2E = 1.4426950408889634f;
    const int nper = (512 + c.G - 1) / c.G;
    for (int rep = 0; rep < REP_MLA; ++rep)
    for (int i = 0; i < nper; ++i) {
      const int u = c.vcu * nper + i; if (u >= 512) break;
      int tid = threadIdx.x; asm volatile("" : "+v"(tid)); const int wid = tid >> 6, lane = tid & 63, r32 = lane & 31;
      const int bh = u >> 5, qb = u & 31, b = bh >> 3, h = bh & 7;
      const float sc = 0.07216878364870322f;
      const int qs = qb * 256 + wid * 32 + r32;
      const att::bf16* Q = (const att::bf16*)(ws + WS_QAR) + ((size_t)b * SEQ + qs) * 1536 + h * 192;
      const att::bf16* K = (const att::bf16*)(ws + WS_KA) + (size_t)bh * SEQ * 192;
      const att::bf16* V = (const att::bf16*)(ws + WS_VA) + (size_t)bh * SEQ * 128;
      att::bf16* O = (att::bf16*)(ws + WS_MRG0) + ((size_t)b * SEQ + qb * 256 + wid * 32) * 2048 + h * 128;
#ifndef NO_A192
      att::attn_unit<192, 128, false, false, 1, 1>(Q, K, V, O, 2048, 0, SEQ / 64, 0, SEQ, 0, -1e30f, 0.f, sc * L2E, 8.f / sc, (char*)lds, a.in[7], (const float*)(ws + WS_TMLA) + (size_t)qs * 64);
#endif
    }
    for (int rep = 0; rep < REP_GQA; ++rep)
    for (int i = 0; i < nper; ++i) {
      const int u = c.vcu * nper + i; if (u >= 512) break;
      int tid = threadIdx.x; asm volatile("" : "+v"(tid)); const int wid = tid >> 6, lane = tid & 63, r32 = lane & 31;
      const int bh = u >> 5, qb = u & 31, b = bh >> 3, h = bh & 7, kvh = h >> 2;
      const float sc = 0.08838834764831845f;
      const int qs = qb * 256 + wid * 32 + r32;
      const att::bf16* Q = (const att::bf16*)(ws + WS_PROJ) + ((size_t)b * SEQ + qs) * EVEN_IN_P + 832 + h * 128;
      const att::bf16* K = (const att::bf16*)(ws + WS_KG) + (size_t)(b * 2 + kvh) * SEQ * 128;
      const att::bf16* V = (const att::bf16*)(ws + WS_VG) + (size_t)(b * 2 + kvh) * SEQ * 128;
      att::bf16* O = (att::bf16*)(ws + WS_MRG0) + ((size_t)b * SEQ + qb * 256 + wid * 32) * 2048 + 1024 + h * 128;
#ifndef NO_A128
      att::attn_unit<128, 128, false, false, 2, 2>(Q, K, V, O, 2048, 0, SEQ / 64, 0, SEQ, 0, -1e30f, 0.f, sc * L2E, 8.f / sc, (char*)lds, a.in[10], (const float*)(ws + WS_TAX) + (size_t)qs * 128);
#endif
    }
  }
  SEAM();
  { pg8::EpiResN<false> E{a.in[0], (pg8::bf16_t*)(ws + WS_XN), RSS, DM, nullptr, 0.f, 0.f}; GEMM_PHASE(pg8::EpiResN<false>, E, WS_MRG0, WS_WOE, DM, DM); }
  SEAM();
  STAGGER();
  { pg8::EpiBL<2> E{(pg8::bf16_t*)(ws + WS_U), DFF, ldsl + EST_OFF}; GEMM_PHASE(pg8::EpiBL<2>, E, WS_XN, WS_WUP, DFF, DM); }
#if REP_UP > 1
#ifdef PROBE_NOEPI
  MKCTX(); { pg8::EpiNone E{}; GEMM_PHASE(pg8::EpiNone, E, WS_XN, WS_WUP, DFF, DM); }
#else
  MKCTX(); { pg8::EpiBL<2> E{(pg8::bf16_t*)(ws + WS_U), DFF, ldsl + EST_OFF}; GEMM_PHASE(pg8::EpiBL<2>, E, WS_XN, WS_WUP, DFF, DM); }
#endif
#endif
#if REP_UP > 2
#ifdef PROBE_NOEPI
  MKCTX(); { pg8::EpiNone E{}; GEMM_PHASE(pg8::EpiNone, E, WS_XN, WS_WUP, DFF, DM); }
#else
  MKCTX(); { pg8::EpiBL<2> E{(pg8::bf16_t*)(ws + WS_U), DFF, ldsl + EST_OFF}; GEMM_PHASE(pg8::EpiBL<2>, E, WS_XN, WS_WUP, DFF, DM); }
#endif
#endif
  SEAM();
#ifdef REP_DN
  { pg8::EpiB<0> E{(pg8::bf16_t*)(ws + AB + 256 * MiB), DM, nullptr, 0.f, 0.f}; GEMM_PHASE(pg8::EpiB<0>, E, WS_U, WS_WDN, DM, DFF); } MKCTX();
#endif
  { pg8::EpiResN<true> E{ws + WS_XN, (pg8::bf16_t*)(ws + WS_XN), RSS + T, DM, RSS, 1.f / DM, EPS}; GEMM_PHASE(pg8::EpiResN<true>, E, WS_U, WS_WDN, DM, DFF); }
  SEAM();
  { pg8::EpiQKV E{(pg8::bf16_t*)(ws + WS_SQ), (long)((WS_SK - WS_SQ) / 2), (long)((WS_SV - WS_SQ) / 2), RSS + T, 1.f / DM, EPS, a.in[15], a.in[16], (const float*)(ws + WS_TSWA), 13};
    GEMM_PHASE(pg8::EpiQKV, E, WS_XN, WS_WQKV, ODD_IN, DM); }
#ifndef NO_PRO
  MKCTX(); convert_dynamic<2>((unsigned*)(ws + WS_CNT) + 64, c.wave, c.lane, a, ws, ldsl);
#endif
  SEAM();
  {
    constexpr float L2E = 1.4426950408889634f; const float sc = 0.125f;
    const int nper = (1024 + c.G - 1) / c.G;
    for (int rep = 0; rep < REP_SWA; ++rep)
    for (int i = 0; i < nper; ++i) {
      const int u = c.vcu * nper + i; if (u >= 1024) break;
      int tid = threadIdx.x; asm volatile("" : "+v"(tid)); const int wid = tid >> 6, lane = tid & 63, r32 = lane & 31;
      const int b = u >> 9, kvh = (u >> 7) & 3, rb = u & 127, h = kvh * 8 + wid;
      const att::bf16* Q = (const att::bf16*)(ws + WS_SQ) + ((size_t)(b * 32 + h) * SEQ + rb * 64 + r32) * 64;
      const att::bf16* K = (const att::bf16*)(ws + WS_SK) + (size_t)(b * 4 + kvh) * SEQ * 64;
      const att::bf16* V = (const att::bf16*)(ws + WS_SV) + (size_t)(b * 4 + kvh) * SEQ * 64;
      att::bf16* O = (att::bf16*)(ws + WS_MRG) + ((size_t)b * SEQ + rb * 64) * 2048 + h * 64;
      const float sink = a.in[17][h];
#ifndef NO_A64
      att::swa_unit<5, 2>(Q, K, V, O, 2048, rb * 64 - 128, rb * 64 + r32, SEQ, 128, sink / sc, sc * L2E, 8.f / sc, (char*)lds);
#endif
    }
  }
  SEAM();
  { pg8::EpiResN<true> E{ws + WS_XN, (pg8::bf16_t*)(ws + WS_XN), RSS + 2 * T, DM, nullptr, 0.f, 0.f}; GEMM_PHASE(pg8::EpiResN<true>, E, WS_MRG, WS_WOO, DM, DM); }
  SEAM();
  STAGGER();
  { pg8::EpiBL<2> E{(pg8::bf16_t*)(ws + WS_U), DFF, ldsl + EST_OFF}; GEMM_PHASE(pg8::EpiBL<2>, E, WS_XN, WS_WUP, DFF, DM); }
#if REP_UP > 1
#ifdef PROBE_NOEPI
  MKCTX(); { pg8::EpiNone E{}; GEMM_PHASE(pg8::EpiNone, E, WS_XN, WS_WUP, DFF, DM); }
#else
  MKCTX(); { pg8::EpiBL<2> E{(pg8::bf16_t*)(ws + WS_U), DFF, ldsl + EST_OFF}; GEMM_PHASE(pg8::EpiBL<2>, E, WS_XN, WS_WUP, DFF, DM); }
#endif
#endif
#if REP_UP > 2
#ifdef PROBE_NOEPI
  MKCTX(); { pg8::EpiNone E{}; GEMM_PHASE(pg8::EpiNone, E, WS_XN, WS_WUP, DFF, DM); }
#else
  MKCTX(); { pg8::EpiBL<2> E{(pg8::bf16_t*)(ws + WS_U), DFF, ldsl + EST_OFF}; GEMM_PHASE(pg8::EpiBL<2>, E, WS_XN, WS_WUP, DFF, DM); }
#endif
#endif
  SEAM();
#ifdef REP_DN
  { pg8::EpiB<0> E{(pg8::bf16_t*)(ws + AB + 256 * MiB), DM, nullptr, 0.f, 0.f}; GEMM_PHASE(pg8::EpiB<0>, E, WS_U, WS_WDN, DM, DFF); } MKCTX();
#endif
  { pg8::EpiRes<true> E{ws + WS_XN, X, DM, RSS + 2 * T, 1.f / DM, EPS}; GEMM_PHASE(pg8::EpiRes<true>, E, WS_U, WS_WDN, DM, DFF); }
}

#ifdef PROBE_PRO_KERNEL
__global__ void __launch_bounds__(NWAVES * 64, 2) probe_prologue(Args a) {
  extern __shared__ __attribute__((aligned(16))) unsigned char lds[];
  LAS unsigned char* ldsl = (LAS unsigned char*)lds;
  Ctx c; { int t_ = threadIdx.x; c.lane = t_ & 63; c.wave = __builtin_amdgcn_readfirstlane(t_ >> 6); c.G = gridDim.x; c.vcu = blockIdx.x; c.gw = blockIdx.x * NWAVES + c.wave; c.NGW = c.G * NWAVES; c.ws = a.ws; }
  prologue(c, a, ldsl);
}
#endif
extern "C" void kernel_launch(void* const* d_in, const int* in_sizes, int n_in, void* d_out, int out_size, void* d_ws, size_t ws_size, hipStream_t stream) {
  static int grid = 0;
  if (grid == 0) {
    if (n_in != 22 || out_size != T * DM || ws_size < WS_NEED) { fprintf(stderr, "kernel_launch: unexpected shapes: n_in %d out %d ws %zu (need %zu)\n", n_in, out_size, ws_size, (size_t)WS_NEED); grid = -1; return; }
    int dev = 0, cus = 0, per_cu = 0;
    (void)hipGetDevice(&dev); (void)hipDeviceGetAttribute(&cus, hipDeviceAttributeMultiprocessorCount, dev);
    if (LDS_BYTES > 0 && hipFuncSetAttribute((const void*)fwd_megakernel, hipFuncAttributeMaxDynamicSharedMemorySize, LDS_BYTES) != hipSuccess) { fprintf(stderr, "kernel_launch: hipFuncSetAttribute failed\n"); grid = -1; return; }
    if (hipOccupancyMaxActiveBlocksPerMultiprocessor(&per_cu, (const void*)fwd_megakernel, NWAVES * 64, LDS_BYTES) != hipSuccess || per_cu < 1) { fprintf(stderr, "kernel_launch: occupancy query says %d\n", per_cu); per_cu = 1; }
    (void)hipGetLastError();
    grid = cus * 1;
    fprintf(stderr, "kernel_launch: grid %d (cus %d, per_cu %d)\n", grid, cus, per_cu);
  }
  if (grid < 0) return;
  Args a; memset(&a, 0, sizeof(a));
  for (int i = 0; i < 22; ++i) a.in[i] = (const float*)d_in[i];
  a.out = (float*)d_out; a.ws = (unsigned char*)d_ws;
  for (int f = 0; f < 32; ++f) { a.inv_mla[f] = (float)pow((double)500000.0f, -(double)(2 * f) / 64.0); a.inv_ax[f] = (float)pow((double)10000.0f, -(double)(2 * f) / 64.0); }
  for (int f = 0; f < 8; ++f) a.inv_swa[f] = (float)pow((double)500000.0f, -(double)(2 * f) / 16.0);
  if (hipMemsetAsync(d_ws, 0, 512 * 1024, stream) != hipSuccess) { fprintf(stderr, "kernel_launch: memset failed\n"); return; }
#ifdef PROBE_PRO_KERNEL
  (void)hipFuncSetAttribute((const void*)probe_prologue, hipFuncAttributeMaxDynamicSharedMemorySize, LDS_BYTES);
  hipLaunchKernelGGL(probe_prologue, dim3(grid), dim3(NWAVES * 64), LDS_BYTES, stream, a);
#endif
  void* args[] = {&a};
#ifdef PROBE_PLAIN
  hipLaunchKernelGGL(fwd_megakernel, dim3(grid), dim3(NWAVES * 64), LDS_BYTES, stream, a); hipError_t e = hipPeekAtLastError();
#else
  hipError_t e = hipLaunchCooperativeKernel((const void*)fwd_megakernel, dim3(grid), dim3(NWAVES * 64), args, LDS_BYTES, stream);
#endif
  if (e != hipSuccess) fprintf(stderr, "kernel_launch: cooperative launch failed: %s (grid %d)\n", hipGetErrorString(e), grid);
}
```
